# Optimizing an MI355X kernel written in HIP

```python
import jax
import jax.numpy as jnp
from jax import lax
import numpy as np

D_MODEL = 1024
BATCH = 8
SEQ = 2048
DEPTH = 2

D_MIX = D_MODEL
HEAD_DIM = 64
A_WIDTH = D_MIX // 4
A_BLOCKS = A_WIDTH // HEAD_DIM
A_BLOCK = HEAD_DIM
CONV_W = 4
LRU_C = 8.0
B_WIDTH = 3 * D_MIX // 8
B_HEADS = B_WIDTH // HEAD_DIM
B_DK = HEAD_DIM
B_DV = HEAD_DIM
B_FDIM = B_HEADS * B_DK
CHUNK = 64
C_WIDTH = D_MIX - A_WIDTH - B_WIDTH
C_HEADS = C_WIDTH // HEAD_DIM
C_HEAD = HEAD_DIM
C_LORA_W = 64
C_LORA_A = 64
C_LORA_G = 128
C_COLS = 3 * C_WIDTH + C_LORA_W + C_LORA_A + C_LORA_G
P_SIZES = (A_WIDTH, A_WIDTH, B_FDIM, B_FDIM, B_WIDTH, B_WIDTH, C_COLS)
P_WIDTH = 2 * A_WIDTH + 2 * B_FDIM + 2 * B_WIDTH + C_COLS
D_FF = -(-8 * D_MODEL // (3 * 256)) * 256
NORM_EPS = 1e-6
GN_EPS = 64e-5

kernel_name = 'hybrid_rglru_hgrn2_rwkv7_block'


def rmsnorm(x, gain=None, eps=NORM_EPS):
    xf = x.astype(jnp.float32)
    y = xf * lax.rsqrt(jnp.mean(xf * xf, axis=-1, keepdims=True) + eps)
    if gain is not None:
        y = y * gain.astype(jnp.float32)
    return y.astype(x.dtype)


def _causal_conv(u, w, b):
    T = u.shape[1]
    up = jnp.pad(u, ((0, 0), (CONV_W - 1, 0), (0, 0)))
    out = b
    for j in range(CONV_W):
        out = out + w[j] * up[:, j:j + T]
    return out


def _lin_combine(left, right):
    a1, b1 = left
    a2, b2 = right
    return a1 * a2, a2 * b1 + b2


def rglru_mixer(xa, ya, conv_w, conv_b, rg_w, rg_b, ig_w, ig_b, lam):
    dt = xa.dtype
    Bn, T, _ = xa.shape
    u = _causal_conv(xa, conv_w, conv_b)
    ub = u.reshape(Bn, T, A_BLOCKS, A_BLOCK)
    r = jax.nn.sigmoid(jnp.einsum('btgi,gij->btgj', ub, rg_w).reshape(Bn, T, A_WIDTH) + rg_b)
    i = jax.nn.sigmoid(jnp.einsum('btgi,gij->btgj', ub, ig_w).reshape(Bn, T, A_WIDTH) + ig_b)
    log_a = -LRU_C * r.astype(jnp.float32) * jax.nn.softplus(-lam.astype(jnp.float32))
    a = jnp.exp(log_a)
    mult = jnp.sqrt(-jnp.expm1(2.0 * log_a))
    mult = mult.at[:, 0].set(1.0)
    b = mult * (i * u).astype(jnp.float32)
    _, h = lax.associative_scan(_lin_combine, (a, b), axis=1)
    y = h.astype(dt) * jax.nn.gelu(ya)
    return rmsnorm(y.reshape(Bn, T, A_BLOCKS, A_BLOCK)).reshape(Bn, T, A_WIDTH)


def hgrn2_mixer(q, f_logit, v, g, lb):
    dt = q.dtype
    Bn, T, _ = q.shape
    nC = T // CHUNK
    lb = lb.astype(jnp.float32)
    log_f = jnp.logaddexp(jnp.log(lb), jnp.log1p(-lb) + jax.nn.log_sigmoid(f_logit.astype(jnp.float32)))
    k = -jnp.expm1(log_f)

    def to_chunks(z, dh):
        return z.reshape(Bn, nC, CHUNK, B_HEADS, dh).transpose(1, 0, 3, 2, 4)

    qc = to_chunks(q.astype(jnp.float32) * (B_DK ** -0.5), B_DK)
    kc = to_chunks(k, B_DK)
    vc = to_chunks(v.astype(jnp.float32), B_DV)
    lfc = to_chunks(log_f, B_DK)
    mask = jnp.tril(jnp.ones((CHUNK, CHUNK), dtype=bool))[:, :, None]

    def step(S, inp):
        qb, kb, vb, lfb = inp
        bcum = jnp.cumsum(lfb, axis=2)
        o_inter = jnp.einsum('bhtk,bhkv->bhtv', qb * jnp.exp(bcum), S)
        diff = bcum[:, :, :, None, :] - bcum[:, :, None, :, :]
        decay = jnp.exp(jnp.where(mask, diff, -jnp.inf))
        A = jnp.einsum('bhtk,bhsk,bhtsk->bhts', qb, kb, decay)
        o_intra = jnp.einsum('bhts,bhsv->bhtv', A, vb)
        blast = bcum[:, :, -1:, :]
        k_dec = kb * jnp.exp(blast - bcum)
        S = jnp.exp(blast[:, :, 0, :])[..., None] * S + jnp.einsum('bhsk,bhsv->bhkv', k_dec, vb)
        return S, o_inter + o_intra

    S0 = jnp.zeros((Bn, B_HEADS, B_DK, B_DV), jnp.float32)
    _, o = lax.scan(step, S0, (qc, kc, vc, lfc))
    o = o.transpose(1, 0, 3, 2, 4).reshape(Bn, T, B_HEADS, B_DV)
    o = rmsnorm(o).reshape(Bn, T, B_WIDTH)
    return (o * jax.nn.silu(g.astype(jnp.float32))).astype(dt)


def rwkv7_mixer(pc, mu, w0, w_up, a0, a_up, g_up, k_k, k_a, r_k, lnx_w, lnx_b):
    dt = pc.dtype
    Bn, T, _ = pc.shape
    prev = jnp.pad(pc[:, :-1], ((0, 0), (1, 0), (0, 0)))
    ps = (pc + (prev - pc) * mu).astype(jnp.float32)
    r, k, v, wl, al, gl = jnp.split(
        ps, [C_WIDTH, 2 * C_WIDTH, 3 * C_WIDTH, 3 * C_WIDTH + C_LORA_W,
             3 * C_WIDTH + C_LORA_W + C_LORA_A], axis=-1)
    w = -jax.nn.softplus(-(w0 + jnp.tanh(wl) @ w_up)) - 0.5
    decay = jnp.exp(-jnp.exp(w))
    a = jax.nn.sigmoid(a0 + al @ a_up)
    g = jax.nn.sigmoid(gl) @ g_up

    def heads(z):
        return z.reshape(Bn, T, C_HEADS, C_HEAD)

    kk = heads(k * k_k)
    kk = kk * lax.rsqrt(jnp.sum(kk * kk, axis=-1, keepdims=True) + 1e-12)
    k = k * (1.0 + (a - 1.0) * k_a)
    rh, kh, vh, wh, ah = heads(r), heads(k), heads(v), heads(decay), heads(a)

    def step(S, inp):
        rt, wt, kt, vt, kkt, at = inp
        sa = jnp.einsum('bhvk,bhk->bhv', S, -kkt)
        S = S * wt[:, :, None, :] + sa[..., None] * (kkt * at)[:, :, None, :] + vt[..., None] * kt[:, :, None, :]
        return S, jnp.einsum('bhvk,bhk->bhv', S, rt)

    xs = tuple(jnp.moveaxis(z, 1, 0) for z in (rh, wh, kh, vh, kk, ah))
    S0 = jnp.zeros((Bn, C_HEADS, C_HEAD, C_HEAD), jnp.float32)
    _, y = lax.scan(step, S0, xs)
    y = jnp.moveaxis(y, 0, 1)
    mean = jnp.mean(y, axis=-1, keepdims=True)
    var = jnp.mean(jnp.square(y - mean), axis=-1, keepdims=True)
    y = ((y - mean) * lax.rsqrt(var + GN_EPS)).reshape(Bn, T, C_WIDTH) * lnx_w + lnx_b
    bonus = (jnp.sum(rh * kh * r_k, axis=-1, keepdims=True) * vh).reshape(Bn, T, C_WIDTH)
    return ((y + bonus) * g).astype(dt)


def swiglu(h, w_gate, w_up, w_down):
    return (jax.nn.silu(h @ w_gate) * (h @ w_up)) @ w_down


def setup_inputs(seed: int = 0) -> dict:
    key = jax.random.key(seed)
    ks = jax.random.split(key, 32)
    f32 = jnp.float32
    nrm = lambda k, shape, s: jax.random.normal(k, shape, f32) * s
    L = DEPTH
    u = jax.random.uniform(ks[10], (L, A_WIDTH), f32, 0.9, 0.999)
    s = u ** (1.0 / LRU_C)
    return {
        'x': nrm(ks[0], (BATCH, SEQ, D_MODEL), 1.0),
        'c': nrm(ks[1], (BATCH, D_MODEL), 1.0),
        'norm1_g': 1.0 + nrm(ks[2], (L, D_MODEL), 0.02),
        'norm2_g': 1.0 + nrm(ks[3], (L, D_MODEL), 0.02),
        'ada_w': nrm(ks[4], (L, D_MODEL, 6 * D_MODEL), 0.5 * D_MODEL ** -0.5),
        'ada_b': nrm(ks[5], (L, 6 * D_MODEL), 0.02),
        'w_in': nrm(ks[6], (L, D_MODEL, P_WIDTH), D_MODEL ** -0.5),
        'conv_w': nrm(ks[7], (L, CONV_W, A_WIDTH), CONV_W ** -0.5),
        'conv_b': nrm(ks[8], (L, A_WIDTH), 0.02),
        'rg_w': nrm(ks[9], (L, A_BLOCKS, A_BLOCK, A_BLOCK), A_BLOCK ** -0.5),
        'rg_b': nrm(ks[11], (L, A_WIDTH), 0.02),
        'ig_w': nrm(ks[12], (L, A_BLOCKS, A_BLOCK, A_BLOCK), A_BLOCK ** -0.5),
        'ig_b': nrm(ks[13], (L, A_WIDTH), 0.02),
        'lru_lam': jnp.log(s) - jnp.log1p(-s),
        'hgrn_lb': nrm(ks[14], (L, B_FDIM), 0.5),
        'rwkv_mu': jax.random.uniform(ks[15], (L, C_COLS), f32, 0.0, 1.0),
        'rwkv_w0': jax.random.uniform(ks[16], (L, C_WIDTH), f32, -6.0, -1.0),
        'rwkv_w_up': nrm(ks[17], (L, C_LORA_W, C_WIDTH), 0.1),
        'rwkv_a0': nrm(ks[18], (L, C_WIDTH), 0.1),
        'rwkv_a_up': nrm(ks[19], (L, C_LORA_A, C_WIDTH), C_LORA_A ** -0.5),
        'rwkv_g_up': nrm(ks[20], (L, C_LORA_G, C_WIDTH), C_LORA_G ** -0.5),
        'rwkv_k_k': 0.85 + nrm(ks[21], (L, C_WIDTH), 0.05),
        'rwkv_k_a': 1.0 + nrm(ks[22], (L, C_WIDTH), 0.05),
        'rwkv_r_k': nrm(ks[23], (L, C_HEADS, C_HEAD), 0.1),
        'rwkv_lnx_w': 1.0 + nrm(ks[24], (L, C_WIDTH), 0.02),
        'rwkv_lnx_b': nrm(ks[25], (L, C_WIDTH), 0.02),
        'mix_beta': 1.0 + nrm(ks[26], (L, D_MIX), 0.02),
        'w_out': nrm(ks[27], (L, D_MIX, D_MODEL), D_MIX ** -0.5),
        'ffn_w_gate': nrm(ks[28], (L, D_MODEL, D_FF), D_MODEL ** -0.5),
        'ffn_w_up': nrm(ks[29], (L, D_MODEL, D_FF), D_MODEL ** -0.5),
        'ffn_w_down': nrm(ks[30], (L, D_FF, D_MODEL), D_FF ** -0.5),
        'final_g': 1.0 + nrm(ks[31], (D_MODEL,), 0.02),
    }


def reference(x, c, norm1_g, norm2_g, ada_w, ada_b, w_in, conv_w, conv_b, rg_w, rg_b,
              ig_w, ig_b, lru_lam, hgrn_lb, rwkv_mu, rwkv_w0, rwkv_w_up, rwkv_a0, rwkv_a_up,
              rwkv_g_up, rwkv_k_k, rwkv_k_a, rwkv_r_k, rwkv_lnx_w, rwkv_lnx_b, mix_beta, w_out,
              ffn_w_gate, ffn_w_up, ffn_w_down, final_g):
    lb_all = jnp.cumsum(jax.nn.softmax(hgrn_lb.astype(jnp.float32), axis=0), axis=0)
    lb_all = lb_all - lb_all[0]
    cs = jax.nn.silu(c)
    offsets = []
    acc = 0
    for sz in P_SIZES[:-1]:
        acc += sz
        offsets.append(acc)
    for l in range(DEPTH):
        mod = (cs @ ada_w[l] + ada_b[l])[:, None, :]
        sh1, sc1, g1, sh2, sc2, g2 = jnp.split(mod, 6, axis=-1)
        h = rmsnorm(x, norm1_g[l]) * (1.0 + sc1) + sh1
        p = h @ w_in[l]
        pa_x, pa_y, pb_q, pb_f, pb_v, pb_g, pc = jnp.split(p, offsets, axis=-1)
        ya = rglru_mixer(pa_x, pa_y, conv_w[l], conv_b[l], rg_w[l], rg_b[l], ig_w[l], ig_b[l], lru_lam[l])
        yb = hgrn2_mixer(pb_q, pb_f, pb_v, pb_g, lb_all[l])
        yc = rwkv7_mixer(pc, rwkv_mu[l], rwkv_w0[l], rwkv_w_up[l], rwkv_a0[l], rwkv_a_up[l],
                         rwkv_g_up[l], rwkv_k_k[l], rwkv_k_a[l], rwkv_r_k[l], rwkv_lnx_w[l], rwkv_lnx_b[l])
        y = jnp.concatenate([ya, yb, yc], axis=-1) * mix_beta[l]
        x = x + g1 * (y @ w_out[l])
        h = rmsnorm(x, norm2_g[l]) * (1.0 + sc2) + sh2
        x = x + g2 * swiglu(h, ffn_w_gate[l], ffn_w_up[l], ffn_w_down[l])
    return rmsnorm(x, final_g)
```

```cpp
#include <hip/hip_runtime.h>
#include <hip/hip_cooperative_groups.h>
#include <cstdio>
#include <cstdint>
namespace cg = cooperative_groups;
__device__ __forceinline__ int otid() { int t = threadIdx.x; asm volatile("" : "+v"(t)); return t; }
namespace pg8 {
#define PG8_LAS __attribute__((address_space(3)))
typedef unsigned short bf16_t;
typedef short bf16x8 __attribute__((ext_vector_type(8)));
typedef float f32x4 __attribute__((ext_vector_type(4)));
typedef unsigned u32x4 __attribute__((ext_vector_type(4)));
constexpr int BM = 256, BK = 64, HALF = 128, HTB = HALF * BK * 2  , STAGE_BYTES = 8 * HTB, NXCD = 8, WGM = 8;

__host__ __device__ __forceinline__ int lds_byte(int r, int c) { const int st = (r >> 4) * 2 + (c >> 5), rr = r & 15, cc = c & 31, ob = rr * 64 + cc * 2; return st * 1024 + (ob ^ (((ob >> 9) & 1) << 5)); }
__host__ __device__ __forceinline__ void stage_rc(int b, int& R, int& C) { const int st = b / 1024, sb = b % 1024, swz = sb ^ (((sb >> 9) & 1) << 5); R = (st >> 1) * 16 + swz / 64; C = (st & 1) * 32 + (swz % 64) / 2; }
__host__ __device__ __forceinline__ int perm32(int rho) { const int n = rho >> 4, i = rho & 15; return 8 * (i >> 2) + 4 * n + (i & 3); }

struct Unit { int pm, pn; };
struct Gemm { const bf16_t* A; const bf16_t* Bt; int M, N, K; };

struct StaticOrder {
    int nM, nN, nwg, G, c;
    __host__ __device__ void init(int M, int N, int G_, int c_) { nM = M / BM; nN = N / BM; nwg = nM * nN; G = G_; c = c_; }
    __host__ __device__ bool next(int i, Unit& u) const {
        const long L = (long)i * G + c; if (L >= nwg) return false;
        int wgid = (int)L; { const int q = nwg / NXCD, r = nwg % NXCD, xcd = wgid % NXCD, off = wgid / NXCD; wgid = (xcd < r ? xcd * (q + 1) : r * (q + 1) + (xcd - r) * q) + off; }
        const int nig = WGM * nN, gid = wgid / nig, fm = gid * WGM, gsz = (nM - fm) < WGM ? (nM - fm) : WGM;
        u.pm = fm + ((wgid % nig) % gsz); u.pn = (wgid % nig) / gsz; return true;
    }
    __device__ __forceinline__ void a_ready(const Unit&) const {}
    __device__ __forceinline__ void done(const Unit&) const {}
};
__device__ __forceinline__ unsigned cvt_pk_bf16(float lo, float hi) { unsigned r; asm volatile("v_cvt_pk_bf16_f32 %0, %1, %2" : "=v"(r) : "v"(lo), "v"(hi)); return r; }
template <class Epi, class Sched, bool STAMP = false>
__device__ __forceinline__ void gemm_phase(PG8_LAS unsigned char* lds, const Gemm g, const Sched& S, const Epi& E, unsigned long long* stamps) {
    const int tid = otid(), wid = __builtin_amdgcn_readfirstlane(tid >> 6), lane = tid & 63, wr = wid >> 2, wc = wid & 3, fr = lane & 15, fq = lane >> 4;
    const int K = g.K, nt = K / BK;
    unsigned voffA[2], voffB[2];
#pragma unroll
    for (int i = 0; i < 2; ++i) { int R, C; stage_rc(tid * 16 + i * 8192, R, C); const int Rb = Epi::PERM ? ((R & ~31) + perm32(R & 31)) : R;
        voffA[i] = (unsigned)(R * K + C) * 2u; voffB[i] = (unsigned)(Rb * K + C) * 2u; }
    const size_t kstep = (size_t)(BK * 2);
    const size_t hstep = (size_t)HALF * K * 2;
    const size_t tstep = 2 * hstep;
    const unsigned ldsw = (unsigned)wid * 1024u;
    const int aoff = lds_byte(wr * 64 + fr, fq * 8), boff = lds_byte(wc * 32 + fr, fq * 8);
#define PG8_SA(b, h) (((b) * 2 + (h)) * HTB)
#define PG8_SB(b, h) ((4 + (b) * 2 + (h)) * HTB)
#define PG8_STAGE(bufoff, gbase, voff) do { _Pragma("unroll") for (int _i = 0; _i < 2; ++_i) \
        __builtin_amdgcn_global_load_lds((const unsigned*)((const char*)(gbase) + (voff)[_i]), (PG8_LAS unsigned*)(lds + (bufoff) + ldsw + _i * 8192), 16, 0, 0); } while (0)
#define PG8_LDA(dst, b, h) do { _Pragma("unroll") for (int m = 0; m < 4; ++m) _Pragma("unroll") for (int k = 0; k < 2; ++k) dst[m][k] = *(const PG8_LAS bf16x8*)(lds + PG8_SA(b, h) + aoff + m * 2048 + k * 1024); } while (0)
#define PG8_LDB(dst, b, h) do { _Pragma("unroll") for (int n = 0; n < 2; ++n) _Pragma("unroll") for (int k = 0; k < 2; ++k) dst[n][k] = *(const PG8_LAS bf16x8*)(lds + PG8_SB(b, h) + boff + n * 2048 + k * 1024); } while (0)
#define PG8_MMA(ai, bj, At, Bt) do { __builtin_amdgcn_s_setprio(1); _Pragma("unroll") for (int m = 0; m < 4; ++m) _Pragma("unroll") for (int n = 0; n < 2; ++n) _Pragma("unroll") for (int k = 0; k < 2; ++k) \
        acc[ai][bj][m][n] = __builtin_amdgcn_mfma_f32_16x16x32_bf16(Bt[n][k], At[m][k], acc[ai][bj][m][n], 0, 0, 0); __builtin_amdgcn_s_setprio(0); } while (0)
#define PG8_WAIT_V(n) asm volatile("s_waitcnt vmcnt(" #n ")" ::: "memory")
#define PG8_WAIT_L(n) asm volatile("s_waitcnt lgkmcnt(" #n ")" ::: "memory")
#define PG8_BAR __builtin_amdgcn_s_barrier()
#define PG8_SCHED __builtin_amdgcn_sched_barrier(0)
    Unit cur, nxt; int ui = 0;
    if (!S.next(0, cur)) return;
    f32x4 acc[2][2][4][2];
#pragma unroll
    for (int a = 0; a < 2; ++a)
#pragma unroll
        for (int b = 0; b < 2; ++b)
#pragma unroll
            for (int m = 0; m < 4; ++m)
#pragma unroll
                for (int n = 0; n < 2; ++n) acc[a][b][m][n] = (f32x4){0.f, 0.f, 0.f, 0.f};
    bf16x8 At[4][2], B0[2][2], B1[2][2];
    const char* cA = (const char*)g.A + (size_t)cur.pm * tstep; const char* cB = (const char*)g.Bt + (size_t)cur.pn * tstep;
    S.a_ready(cur);
    PG8_STAGE(PG8_SB(0, 0), cB, voffB); PG8_STAGE(PG8_SA(0, 0), cA, voffA); PG8_STAGE(PG8_SB(0, 1), cB + hstep, voffB); PG8_STAGE(PG8_SA(0, 1), cA + hstep, voffA);
    if (wr == 1) PG8_BAR;
    PG8_WAIT_V(4); PG8_BAR;
    PG8_STAGE(PG8_SB(1, 0), cB + kstep, voffB); PG8_STAGE(PG8_SA(1, 0), cA + kstep, voffA); PG8_STAGE(PG8_SB(1, 1), cB + hstep + kstep, voffB);
    PG8_WAIT_V(6); PG8_BAR;
    for (;;) {
        const bool has_next = S.next(ui + 1, nxt);
        const char* nA = has_next ? (const char*)g.A + (size_t)nxt.pm * tstep : cA; const char* nB = has_next ? (const char*)g.Bt + (size_t)nxt.pn * tstep : cB;
        for (int t = 0; t < nt; t += 2) {
            const bool last = (t == nt - 2);
            const char* a1 = cA + (size_t)(t + 1) * kstep;
            const char* a2 = last ? nA : cA + (size_t)(t + 2) * kstep; const char* b2 = last ? nB : cB + (size_t)(t + 2) * kstep;
            const char* a3 = a2 + kstep; const char* b3 = b2 + kstep;
            if (last && has_next) S.a_ready(nxt);
            PG8_LDB(B0, 0, 0); PG8_SCHED; PG8_LDA(At, 0, 0); PG8_STAGE(PG8_SA(1, 1), a1 + hstep, voffA);
            PG8_WAIT_L(8); PG8_BAR; PG8_WAIT_L(0); PG8_MMA(0, 0, At, B0); PG8_BAR; PG8_SCHED;
            PG8_LDB(B1, 0, 1); PG8_STAGE(PG8_SB(0, 0), b2, voffB);
            PG8_BAR; PG8_WAIT_L(0); PG8_MMA(0, 1, At, B1); PG8_BAR;
            PG8_LDA(At, 0, 1); PG8_STAGE(PG8_SA(0, 0), a2, voffA);
            PG8_BAR; PG8_WAIT_L(0); PG8_MMA(1, 0, At, B0); PG8_BAR; PG8_SCHED;
            PG8_STAGE(PG8_SB(0, 1), b2 + hstep, voffB);
            PG8_WAIT_V(6); PG8_BAR; PG8_MMA(1, 1, At, B1); PG8_BAR;
            PG8_LDB(B0, 1, 0); PG8_SCHED; PG8_LDA(At, 1, 0); PG8_STAGE(PG8_SA(0, 1), a2 + hstep, voffA);
            PG8_WAIT_L(8); PG8_BAR; PG8_WAIT_L(0); PG8_MMA(0, 0, At, B0); PG8_BAR; PG8_SCHED;
            PG8_LDB(B1, 1, 1); PG8_STAGE(PG8_SB(1, 0), b3, voffB);
            PG8_BAR; PG8_WAIT_L(0); PG8_MMA(0, 1, At, B1); PG8_BAR;
            PG8_LDA(At, 1, 1); PG8_STAGE(PG8_SA(1, 0), a3, voffA);
            PG8_BAR; PG8_WAIT_L(0); PG8_MMA(1, 0, At, B0); PG8_BAR; PG8_SCHED;
            PG8_STAGE(PG8_SB(1, 1), b3 + hstep, voffB);
            PG8_WAIT_V(6); PG8_BAR; PG8_MMA(1, 1, At, B1); PG8_BAR;
        }
        if constexpr (!Epi::AFTER_DRAIN) { E(acc, cur, wr, wc, fr, fq); S.done(cur); }
        if (!has_next) break;
#pragma unroll
        for (int a = 0; a < 2; ++a)
#pragma unroll
            for (int b = 0; b < 2; ++b)
#pragma unroll
                for (int m = 0; m < 4; ++m)
#pragma unroll
                    for (int n = 0; n < 2; ++n) acc[a][b][m][n] = (f32x4){0.f, 0.f, 0.f, 0.f};
        cur = nxt; cA = nA; cB = nB; ++ui;
    }
    PG8_WAIT_V(0);
    if (wr == 0) PG8_BAR;
    PG8_BAR;
    if constexpr (Epi::AFTER_DRAIN) { E.fused(acc, cur, wr, wc, fr, fq, lds, wid, lane); S.done(cur); }
#undef PG8_SA
#undef PG8_SB
#undef PG8_STAGE
#undef PG8_LDA
#undef PG8_LDB
#undef PG8_MMA
#undef PG8_WAIT_V
#undef PG8_WAIT_L
#undef PG8_BAR
#undef PG8_SCHED
}
}
using pg8::bf16_t; using pg8::bf16x8; using pg8::f32x4; using pg8::u32x4;
#define LAS __attribute__((address_space(3)))
typedef float f32x2 __attribute__((ext_vector_type(2)));
typedef unsigned u32x2 __attribute__((ext_vector_type(2)));
typedef short s16x4 __attribute__((ext_vector_type(4)));

constexpr int M_ = 16384, D_ = 1024, T_ = 2048, NB_ = 8, PS_ = 3584, PW_ = 3456, FF_ = 2816, NGU_ = 5632;
constexpr int PAX = 0, PAY = 256, PBQ = 512, PBF = 896, PBV = 1280, PBG = 1664, PC = 2048;
constexpr int LDS_BYTES = 144 * 1024;
constexpr size_t SZ_WIN = (size_t)PS_ * D_ * 2, SZ_WOUT = (size_t)D_ * D_ * 2, SZ_WGU = (size_t)NGU_ * D_ * 2, SZ_WD = (size_t)D_ * FF_ * 2;
constexpr size_t WS_WIN = 0, WS_WOUT = WS_WIN + 2 * SZ_WIN, WS_WGU = WS_WOUT + 2 * SZ_WOUT, WS_WD = WS_WGU + 2 * SZ_WGU;
constexpr size_t WS_MOD = WS_WD + 2 * SZ_WD;
constexpr size_t WS_P = WS_MOD + 2 * 8 * 6144 * 4;
constexpr size_t WS_HY = WS_P + (size_t)M_ * PS_ * 2;
constexpr size_t WS_RGA = WS_HY + (size_t)M_ * D_ * 2;
constexpr size_t WS_HKV = WS_RGA + 3 * 8 * 32 * 256 * 4;
constexpr size_t WS_HDEC = WS_HKV + (size_t)1536 * 4096 * 2;
constexpr size_t WS_END = WS_HDEC + (size_t)1536 * 64 * 4;

struct Args { const float* in[32]; float* out; unsigned char* ws; int ph_lo, ph_hi; };

__device__ __forceinline__ unsigned f2bf(float f) { unsigned u = __builtin_bit_cast(unsigned, f); return (u + 0x7fffu + ((u >> 16) & 1u)) >> 16; }
__device__ __forceinline__ unsigned pk2(float lo, float hi) { return f2bf(lo) | (f2bf(hi) << 16); }
__device__ __forceinline__ float bf2f(unsigned short b) { return __builtin_bit_cast(float, ((unsigned)b) << 16); }
__device__ __forceinline__ float bflo(unsigned w) { return __builtin_bit_cast(float, w << 16); }
__device__ __forceinline__ float bfhi(unsigned w) { return __builtin_bit_cast(float, w & 0xffff0000u); }
__device__ __forceinline__ float wave_sum(float v) {
#pragma unroll
    for (int o = 1; o < 64; o <<= 1) v += __shfl_xor(v, o);
    return v;
}
__device__ __forceinline__ float sigmoidf_(float x) { return 1.0f / (1.0f + __expf(-x)); }
#define LDS_WAIT() asm volatile("s_waitcnt lgkmcnt(0)" ::: "memory")

struct EpiP {
    static constexpr bool PERM = true, AFTER_DRAIN = false;
    bf16_t* O; int ldc;
    __device__ __forceinline__ void operator()(const f32x4 (&acc)[2][2][4][2], const pg8::Unit& u, int wr, int wc, int fr, int fq) const {
        const int row0 = u.pm * 256 + wr * 64 + fr, col0 = u.pn * 256 + wc * 32 + 8 * fq;
#pragma unroll
        for (int ai = 0; ai < 2; ++ai)
#pragma unroll
            for (int m = 0; m < 4; ++m) { bf16_t* rowp = O + (size_t)(row0 + ai * 128 + m * 16) * ldc + col0;
#pragma unroll
                for (int bj = 0; bj < 2; ++bj) { const f32x4 v0 = acc[ai][bj][m][0], v1 = acc[ai][bj][m][1]; u32x4 w;
                    w.x = pg8::cvt_pk_bf16(v0[0], v0[1]); w.y = pg8::cvt_pk_bf16(v0[2], v0[3]); w.z = pg8::cvt_pk_bf16(v1[0], v1[1]); w.w = pg8::cvt_pk_bf16(v1[2], v1[3]);
                    *(u32x4*)(rowp + bj * 128) = w; } }
    }
};
struct EpiRes {
    static constexpr bool PERM = false, AFTER_DRAIN = false;
    const float* base; float* out; const float* gate;
    __device__ __forceinline__ void operator()(const f32x4 (&acc)[2][2][4][2], const pg8::Unit& u, int wr, int wc, int fr, int fq) const {
        const int row0 = u.pm * 256 + wr * 64 + fr, col0 = u.pn * 256 + wc * 32 + 4 * fq, b = u.pm >> 3;
        f32x4 gv[2][2];
#pragma unroll
        for (int bj = 0; bj < 2; ++bj)
#pragma unroll
            for (int n = 0; n < 2; ++n) gv[bj][n] = *(const f32x4*)(gate + (size_t)b * 6144 + col0 + bj * 128 + n * 16);
#pragma unroll
        for (int ai = 0; ai < 2; ++ai)
#pragma unroll
            for (int m = 0; m < 4; ++m) { const size_t ro = (size_t)(row0 + ai * 128 + m * 16) * 1024 + col0;
#pragma unroll
                for (int bj = 0; bj < 2; ++bj)
#pragma unroll
                    for (int n = 0; n < 2; ++n) { const f32x4 bv = *(const f32x4*)(base + ro + bj * 128 + n * 16);
                        *(f32x4*)(out + ro + bj * 128 + n * 16) = bv + gv[bj][n] * acc[ai][bj][m][n]; } }
    }
};
struct EpiSwi {
    static constexpr bool PERM = true, AFTER_DRAIN = false;
    bf16_t* O;
    __device__ __forceinline__ void operator()(const f32x4 (&acc)[2][2][4][2], const pg8::Unit& u, int wr, int wc, int fr, int fq) const {
        const int row0 = u.pm * 256 + wr * 64 + fr, col0 = u.pn * 128 + wc * 32 + 8 * fq;
#pragma unroll
        for (int ai = 0; ai < 2; ++ai)
#pragma unroll
            for (int m = 0; m < 4; ++m) { bf16_t* rowp = O + (size_t)(row0 + ai * 128 + m * 16) * FF_ + col0; float o[8];
#pragma unroll
                for (int n = 0; n < 2; ++n)
#pragma unroll
                    for (int i = 0; i < 4; ++i) { const float g = acc[ai][0][m][n][i], up = acc[ai][1][m][n][i]; o[4 * n + i] = g * sigmoidf_(g) * up; }
                u32x4 w; w.x = pg8::cvt_pk_bf16(o[0], o[1]); w.y = pg8::cvt_pk_bf16(o[2], o[3]); w.z = pg8::cvt_pk_bf16(o[4], o[5]); w.w = pg8::cvt_pk_bf16(o[6], o[7]);
                *(u32x4*)rowp = w; }
    }
};

__device__ __forceinline__ void transpose_item(const float* W, int K, int N, bf16_t* WT, int mode, LAS float* scr, int item, int lane) {
    const int nblk = N / 32, kb = item / nblk, nb = item % nblk, k0 = 64 * kb, n0 = 32 * nb;
#pragma unroll 8
    for (int i = 0; i < 32; ++i) { const int kk = 2 * i + (lane >> 5); scr[kk * 33 + (lane & 31)] = W[(size_t)(k0 + kk) * N + n0 + (lane & 31)]; }
    LDS_WAIT(); asm volatile("" ::: "memory");
    const int c = lane & 7;
#pragma unroll
    for (int j = 0; j < 4; ++j) { const int nl = (lane >> 3) + 8 * j, n = n0 + nl; const LAS float* s = scr + (8 * c) * 33 + nl;
        const int row = (mode == 0) ? n : (256 * (n >> 7) + (n & 127) + (mode == 2 ? 128 : 0));
        u32x4 o; o.x = pk2(s[0 * 33], s[1 * 33]); o.y = pk2(s[2 * 33], s[3 * 33]); o.z = pk2(s[4 * 33], s[5 * 33]); o.w = pk2(s[6 * 33], s[7 * 33]);
        *(u32x4*)(WT + (size_t)row * K + k0 + 8 * c) = o; }
    LDS_WAIT(); asm volatile("" ::: "memory");
}
__device__ __forceinline__ void phase_pro(const Args& a, LAS unsigned char* lds) {
    const int tid = otid(), wid = tid >> 6, lane = tid & 63;
    unsigned char* ws = a.ws;
    LAS float* CS = (LAS float*)lds;
    LAS float* RED = (LAS float*)(lds + 32768);
    if ((int)blockIdx.x < 192) {
        for (int i = tid; i < 8192; i += 512) { const float cv = a.in[1][i]; CS[i] = cv * sigmoidf_(cv); }
        __syncthreads();
    }
    for (int item = blockIdx.x; item < 192; item += gridDim.x) {
        const int l = item / 96, cgp = item % 96, col = cgp * 64 + lane;
        const float* aw = a.in[4] + (size_t)l * 1024 * 6144;
        float acc[8];
#pragma unroll
        for (int b = 0; b < 8; ++b) acc[b] = 0.f;
        for (int k = wid * 128; k < wid * 128 + 128; ++k) { const float w = aw[(size_t)k * 6144 + col];
#pragma unroll
            for (int b = 0; b < 8; ++b) acc[b] += CS[b * 1024 + k] * w; }
#pragma unroll
        for (int b = 0; b < 8; ++b) RED[(wid * 8 + b) * 64 + lane] = acc[b];
        __syncthreads();
        { const int b = wid; float s = 0.f;
#pragma unroll
          for (int w = 0; w < 8; ++w) s += RED[(w * 8 + b) * 64 + lane];
          ((float*)(ws + WS_MOD))[(size_t)(l * 8 + b) * 6144 + col] = s + a.in[5][l * 6144 + col]; }
        __syncthreads();
    }
    LAS float* scr = (LAS float*)(lds + 65536 + wid * 8448);
    const int gw = blockIdx.x * 8 + wid, NGW = gridDim.x * 8;
    constexpr int I_IN = 16 * (PW_ / 32), I_OUT = 16 * 32, I_G = 16 * (FF_ / 32), I_D = (FF_ / 64) * 32, I_L = I_IN + I_OUT + 2 * I_G + I_D;
    for (int it = gw; it < 2 * I_L; it += NGW) {
        const int l = it / I_L; int r = it % I_L;
        if (r < I_IN) { transpose_item(a.in[6] + (size_t)l * D_ * PW_, D_, PW_, (bf16_t*)(ws + WS_WIN + l * SZ_WIN), 0, scr, r, lane); continue; } r -= I_IN;
        if (r < I_OUT) { transpose_item(a.in[27] + (size_t)l * D_ * D_, D_, D_, (bf16_t*)(ws + WS_WOUT + l * SZ_WOUT), 0, scr, r, lane); continue; } r -= I_OUT;
        if (r < I_G) { transpose_item(a.in[28] + (size_t)l * D_ * FF_, D_, FF_, (bf16_t*)(ws + WS_WGU + l * SZ_WGU), 1, scr, r, lane); continue; } r -= I_G;
        if (r < I_G) { transpose_item(a.in[29] + (size_t)l * D_ * FF_, D_, FF_, (bf16_t*)(ws + WS_WGU + l * SZ_WGU), 2, scr, r, lane); continue; } r -= I_G;
        transpose_item(a.in[30] + (size_t)l * FF_ * D_, FF_, D_, (bf16_t*)(ws + WS_WD + l * SZ_WD), 0, scr, r, lane);
    }
    for (int i = blockIdx.x * 512 + tid; i < 2 * 16384; i += gridDim.x * 512) { const int l = i >> 14, e = i & 16383;
        *(u32x4*)(ws + WS_WIN + l * SZ_WIN + (size_t)PW_ * D_ * 2 + (size_t)e * 16) = (u32x4){0u, 0u, 0u, 0u}; }
}
__device__ __forceinline__ void phase_norm(const float* xin, const float* gain, const float* sh, const float* sc, bf16_t* H) {
    const int tid = otid(), wid = tid >> 6, lane = tid & 63, gw = blockIdx.x * 8 + wid, NGW = gridDim.x * 8;
    for (int row = gw; row < M_; row += NGW) { const int b = row >> 11;
        const f32x4* xr = (const f32x4*)(xin + (size_t)row * D_) + lane; f32x4 v[4]; float ss = 0.f;
#pragma unroll
        for (int j = 0; j < 4; ++j) { v[j] = xr[64 * j]; ss += (v[j].x * v[j].x + v[j].y * v[j].y) + (v[j].z * v[j].z + v[j].w * v[j].w); }
        const float rs = 1.0f / sqrtf(wave_sum(ss) * (1.0f / D_) + 1e-6f);
#pragma unroll
        for (int j = 0; j < 4; ++j) { const int col = 4 * lane + 256 * j;
            const f32x4 g = *(const f32x4*)(gain + col), s1 = *(const f32x4*)(sc + (size_t)b * 6144 + col), s0 = *(const f32x4*)(sh + (size_t)b * 6144 + col);
            const f32x4 h = v[j] * rs * g * (s1 + 1.0f) + s0;
            u32x2 w; w.x = pk2(h.x, h.y); w.y = pk2(h.z, h.w); *(u32x2*)(H + (size_t)row * D_ + col) = w; }
    }
}
__device__ __forceinline__ void phase_final(float* x, const float* gain) {
    const int tid = otid(), wid = tid >> 6, lane = tid & 63, gw = blockIdx.x * 8 + wid, NGW = gridDim.x * 8;
    for (int row = gw; row < M_; row += NGW) {
        f32x4* xr = (f32x4*)(x + (size_t)row * D_) + lane; f32x4 v[4]; float ss = 0.f;
#pragma unroll
        for (int j = 0; j < 4; ++j) { v[j] = xr[64 * j]; ss += (v[j].x * v[j].x + v[j].y * v[j].y) + (v[j].z * v[j].z + v[j].w * v[j].w); }
        const float rs = 1.0f / sqrtf(wave_sum(ss) * (1.0f / D_) + 1e-6f);
#pragma unroll
        for (int j = 0; j < 4; ++j) { const f32x4 g = *(const f32x4*)(gain + 4 * lane + 256 * j); xr[64 * j] = v[j] * rs * g; }
    }
}
__device__ __forceinline__ float gelu_tanh(float x) { const float u = 0.7978845608f * (x + 0.044715f * x * x * x); const float e = __expf(2.0f * u); const float th = 1.0f - 2.0f / (e + 1.0f); return 0.5f * x * (1.0f + th); }
template <int MODE>
__device__ __forceinline__ void rg_item(const Args& a, int l, int item, int lane) {
    const int g = item & 3, c = (item >> 2) & 31, b = item >> 7, ch = 64 * g + lane, row0 = b * T_ + 64 * c;
    const bf16_t* P = (const bf16_t*)(a.ws + WS_P);
    float* AGG = (float*)(a.ws + WS_RGA);
    float Wr[64], Wi[64];
#pragma unroll
    for (int i = 0; i < 64; ++i) { Wr[i] = a.in[9][((size_t)(l * 4 + g) * 64 + i) * 64 + lane]; Wi[i] = a.in[11][((size_t)(l * 4 + g) * 64 + i) * 64 + lane]; }
    const float cw0 = a.in[7][(l * 4 + 0) * 256 + ch], cw1 = a.in[7][(l * 4 + 1) * 256 + ch], cw2 = a.in[7][(l * 4 + 2) * 256 + ch], cw3 = a.in[7][(l * 4 + 3) * 256 + ch];
    const float cb = a.in[8][l * 256 + ch], rb = a.in[10][l * 256 + ch], ib = a.in[12][l * 256 + ch], lam = a.in[13][l * 256 + ch];
    const float sp = log1pf(__expf(-lam));
    float xm3 = 0.f, xm2 = 0.f, xm1 = 0.f;
    if (c > 0) { xm3 = bf2f(P[(size_t)(row0 - 3) * PS_ + PAX + ch]); xm2 = bf2f(P[(size_t)(row0 - 2) * PS_ + PAX + ch]); xm1 = bf2f(P[(size_t)(row0 - 1) * PS_ + PAX + ch]); }
    float h = 0.f, Ap = 1.f, beta = 0.f;
    if (MODE == 1) { h = AGG[2 * 65536 + (b * 32 + c) * 256 + ch]; beta = a.in[26][l * 1024 + ch]; }
    bf16_t* Y = (bf16_t*)(a.ws + WS_HY);
    for (int t = 0; t < 64; ++t) {
        const float xc = bf2f(P[(size_t)(row0 + t) * PS_ + PAX + ch]);
        const float u = cb + cw0 * xm3 + cw1 * xm2 + cw2 * xm1 + cw3 * xc;
        xm3 = xm2; xm2 = xm1; xm1 = xc;
        float rp = rb, ip = ib;
#pragma unroll
        for (int i = 0; i < 64; ++i) { const float ui = __builtin_bit_cast(float, __builtin_amdgcn_readlane(__builtin_bit_cast(int, u), i)); rp += ui * Wr[i]; ip += ui * Wi[i]; }
        const float r = sigmoidf_(rp), ig = sigmoidf_(ip);
        const float log_a = -8.0f * r * sp, av = __expf(log_a);
        float mult = sqrtf(-expm1f(2.0f * log_a)); if (c == 0 && t == 0) mult = 1.0f;
        const float bv = mult * ig * u;
        h = av * h + bv;
        if (MODE == 0) Ap *= av;
        else { const float ya = bf2f(P[(size_t)(row0 + t) * PS_ + PAY + ch]); const float y = h * gelu_tanh(ya);
            const float ss = wave_sum(y * y); const float o = y * (1.0f / sqrtf(ss * (1.0f / 64.0f) + 1e-6f)) * beta;
            Y[(size_t)(row0 + t) * D_ + ch] = (bf16_t)f2bf(o); }
    }
    if (MODE == 0) { AGG[(b * 32 + c) * 256 + ch] = Ap; AGG[65536 + (b * 32 + c) * 256 + ch] = h; }
}
__device__ __forceinline__ void rg_carry(const Args& a, int gid) {
    float* AGG = (float*)(a.ws + WS_RGA); const int b = gid >> 8, ch = gid & 255; float H = 0.f;
    for (int c = 0; c < 32; ++c) { const int i = (b * 32 + c) * 256 + ch; AGG[2 * 65536 + i] = H; H = AGG[i] * H + AGG[65536 + i]; }
}
__device__ __forceinline__ f32x4 mfma16(bf16x8 x, bf16x8 y, f32x4 c) { return __builtin_amdgcn_mfma_f32_16x16x32_bf16(x, y, c, 0, 0, 0); }
constexpr int LST = 72;
template <int MODE>
__device__ __forceinline__ void hgrn_item(const Args& a, int l, int item, LAS unsigned char* lds) {
    const int tid = otid(), wid = tid >> 6, lane = tid & 63, fr = lane & 15, fq = lane >> 4;
    const int c = item & 31, bh = item >> 5, h = bh % 6, b = bh / 6, row0 = b * T_ + 64 * c;
    const bf16_t* P = (const bf16_t*)(a.ws + WS_P);
    bf16_t* KVT = (bf16_t*)(a.ws + WS_HKV) + (size_t)item * 4096;
    LAS float* PART = (LAS float*)lds;
    LAS float* RHO = (LAS float*)(lds + 2048);
    LAS float* BC = (LAS float*)(lds + 4096);
    LAS bf16_t* L0 = (LAS bf16_t*)(lds + 20480);
    LAS bf16_t* L1 = (LAS bf16_t*)(lds + 29696);
    LAS bf16_t* L2 = (LAS bf16_t*)(lds + 38912);
    LAS bf16_t* VT = (LAS bf16_t*)(lds + 48128);
    LAS bf16_t* AM = (LAS bf16_t*)(lds + 57344);
    LAS float* SS = (LAS float*)(lds + 66560);
    const int k = lane, pt = wid;
    const float* hl = a.in[14];
    float lbv = 0.f; if (l == 1) lbv = 1.0f / (1.0f + __expf(hl[64 * h + k] - hl[384 + 64 * h + k]));
    float bc[8], kvv[8]; float s = 0.f;
#pragma unroll
    for (int i = 0; i < 8; ++i) { const float z = bf2f(P[(size_t)(row0 + 8 * pt + i) * PS_ + PBF + 64 * h + k]);
        const float sg = 1.0f / (1.0f + __expf(-z)); const float f = fmaxf(lbv + (1.0f - lbv) * sg, 1e-37f);
        s += __logf(f); bc[i] = s; kvv[i] = (1.0f - lbv) / (1.0f + __expf(z)); }
    PART[pt * 64 + k] = s;
    { unsigned short vv[8];
#pragma unroll
      for (int i = 0; i < 8; ++i) vv[i] = P[(size_t)(row0 + 8 * pt + i) * PS_ + PBV + 64 * h + k];
      u32x4 w; w.x = vv[0] | ((unsigned)vv[1] << 16); w.y = vv[2] | ((unsigned)vv[3] << 16); w.z = vv[4] | ((unsigned)vv[5] << 16); w.w = vv[6] | ((unsigned)vv[7] << 16);
      *(LAS u32x4*)(VT + k * LST + 8 * pt) = w; }
    __syncthreads();
    float off = 0.f, tot = 0.f, rho = 0.f;
#pragma unroll
    for (int p = 0; p < 8; ++p) { const float v = PART[p * 64 + k]; if (p < pt) off += v; if (p < 4) rho += v; tot += v; }
#pragma unroll
    for (int i = 0; i < 8; ++i) bc[i] += off;
    if (MODE == 0) {
        u32x4 w; float e[8];
#pragma unroll
        for (int i = 0; i < 8; ++i) e[i] = kvv[i] * __expf(tot - bc[i]);
        w.x = pk2(e[0], e[1]); w.y = pk2(e[2], e[3]); w.z = pk2(e[4], e[5]); w.w = pk2(e[6], e[7]);
        *(LAS u32x4*)(L0 + k * LST + 8 * pt) = w;
        if (pt == 0) ((float*)(a.ws + WS_HDEC))[(size_t)item * 64 + k] = __expf(tot);
        __syncthreads();
        const int kt = wid >> 1;
#pragma unroll
        for (int q = 0; q < 2; ++q) { const int vt = 2 * (wid & 1) + q; f32x4 acc = {0.f, 0.f, 0.f, 0.f};
#pragma unroll
            for (int ks = 0; ks < 2; ++ks) { const bf16x8 x = *(const LAS bf16x8*)(L0 + (16 * kt + fr) * LST + 32 * ks + 8 * fq), y = *(const LAS bf16x8*)(VT + (16 * vt + fr) * LST + 32 * ks + 8 * fq);
                acc = mfma16(x, y, acc); }
            u32x2 w2; w2.x = pk2(acc[0], acc[1]); w2.y = pk2(acc[2], acc[3]);
            *(u32x2*)(KVT + (16 * vt + fr) * 64 + 16 * kt + 4 * fq) = w2; }
        __syncthreads();
    } else {
#pragma unroll
        for (int i = 0; i < 8; ++i) BC[(8 * pt + i) * 64 + k] = bc[i];
        if (pt == 0) RHO[k] = rho;
        __syncthreads();
        { const int t2 = tid >> 3, kg = tid & 7;
          const u32x4 qw = *(const u32x4*)(P + (size_t)(row0 + t2) * PS_ + PBQ + 64 * h + 8 * kg), zw = *(const u32x4*)(P + (size_t)(row0 + t2) * PS_ + PBF + 64 * h + 8 * kg);
          float q[8], z[8], qp[8], qt[8], kt_[8];
          q[0] = bflo(qw.x); q[1] = bfhi(qw.x); q[2] = bflo(qw.y); q[3] = bfhi(qw.y); q[4] = bflo(qw.z); q[5] = bfhi(qw.z); q[6] = bflo(qw.w); q[7] = bfhi(qw.w);
          z[0] = bflo(zw.x); z[1] = bfhi(zw.x); z[2] = bflo(zw.y); z[3] = bfhi(zw.y); z[4] = bflo(zw.z); z[5] = bfhi(zw.z); z[6] = bflo(zw.w); z[7] = bfhi(zw.w);
#pragma unroll
          for (int i = 0; i < 8; ++i) { const int kk = 8 * kg + i; float lb2 = 0.f; if (l == 1) lb2 = 1.0f / (1.0f + __expf(hl[64 * h + kk] - hl[384 + 64 * h + kk]));
              const float kvl = (1.0f - lb2) / (1.0f + __expf(z[i])); const float bcv = BC[t2 * 64 + kk], rh = RHO[kk]; const float qs = q[i] * 0.125f;
              qp[i] = qs * __expf(bcv); qt[i] = qs * __expf(bcv - rh); kt_[i] = kvl * __expf(rh - bcv); }
          u32x4 w; w.x = pk2(qp[0], qp[1]); w.y = pk2(qp[2], qp[3]); w.z = pk2(qp[4], qp[5]); w.w = pk2(qp[6], qp[7]); *(LAS u32x4*)(L0 + t2 * LST + 8 * kg) = w;
          w.x = pk2(qt[0], qt[1]); w.y = pk2(qt[2], qt[3]); w.z = pk2(qt[4], qt[5]); w.w = pk2(qt[6], qt[7]); *(LAS u32x4*)(L1 + t2 * LST + 8 * kg) = w;
          w.x = pk2(kt_[0], kt_[1]); w.y = pk2(kt_[2], kt_[3]); w.z = pk2(kt_[4], kt_[5]); w.w = pk2(kt_[6], kt_[7]); *(LAS u32x4*)(L2 + t2 * LST + 8 * kg) = w; }
        __syncthreads();
        const int tt = wid >> 1;
#pragma unroll
        for (int q = 0; q < 2; ++q) { const int st = 2 * (wid & 1) + q; f32x4 acc = {0.f, 0.f, 0.f, 0.f};
            if (st <= tt) {
#pragma unroll
                for (int ks = 0; ks < 2; ++ks) { const bf16x8 x = *(const LAS bf16x8*)(L2 + (16 * st + fr) * LST + 32 * ks + 8 * fq), y = *(const LAS bf16x8*)(L1 + (16 * tt + fr) * LST + 32 * ks + 8 * fq);
                    acc = mfma16(x, y, acc); }
                const int t = 16 * tt + fr;
#pragma unroll
                for (int j = 0; j < 4; ++j) { const int sidx = 16 * st + 4 * fq + j; if (sidx > t) acc[j] = 0.f; }
            }
            u32x2 w2; w2.x = pk2(acc[0], acc[1]); w2.y = pk2(acc[2], acc[3]);
            *(LAS u32x2*)(AM + (16 * tt + fr) * LST + 16 * st + 4 * fq) = w2; }
        __syncthreads();
        f32x4 o[2]; float ss = 0.f;
#pragma unroll
        for (int q = 0; q < 2; ++q) { const int vt = 2 * (wid & 1) + q; f32x4 acc = {0.f, 0.f, 0.f, 0.f};
#pragma unroll
            for (int ks = 0; ks < 2; ++ks) { const bf16x8 x = *(const bf16x8*)(KVT + (16 * vt + fr) * 64 + 32 * ks + 8 * fq), y = *(const LAS bf16x8*)(L0 + (16 * tt + fr) * LST + 32 * ks + 8 * fq);
                acc = mfma16(x, y, acc); }
#pragma unroll
            for (int ks = 0; ks < 2; ++ks) { const bf16x8 x = *(const LAS bf16x8*)(VT + (16 * vt + fr) * LST + 32 * ks + 8 * fq), y = *(const LAS bf16x8*)(AM + (16 * tt + fr) * LST + 32 * ks + 8 * fq);
                acc = mfma16(x, y, acc); }
            o[q] = acc; ss += (acc[0] * acc[0] + acc[1] * acc[1]) + (acc[2] * acc[2] + acc[3] * acc[3]); }
        ss += __shfl_xor(ss, 16); ss += __shfl_xor(ss, 32);
        if (fq == 0) SS[wid * 16 + fr] = ss;
        __syncthreads();
        const float tot2 = SS[wid * 16 + fr] + SS[(wid ^ 1) * 16 + fr];
        const float rs = 1.0f / sqrtf(tot2 * (1.0f / 64.0f) + 1e-6f);
        bf16_t* Y = (bf16_t*)(a.ws + WS_HY);
#pragma unroll
        for (int q = 0; q < 2; ++q) { const int vt = 2 * (wid & 1) + q, t = 16 * tt + fr, cv = 64 * h + 16 * vt + 4 * fq;
            const u32x2 gw2 = *(const u32x2*)(P + (size_t)(row0 + t) * PS_ + PBG + cv);
            const f32x4 be = *(const f32x4*)(a.in[26] + l * 1024 + 256 + cv);
            float gg[4] = {bflo(gw2.x), bfhi(gw2.x), bflo(gw2.y), bfhi(gw2.y)}; float r[4];
#pragma unroll
            for (int j = 0; j < 4; ++j) r[j] = o[q][j] * rs * (gg[j] * sigmoidf_(gg[j])) * be[j];
            u32x2 w2; w2.x = pk2(r[0], r[1]); w2.y = pk2(r[2], r[3]);
            *(u32x2*)(Y + (size_t)(row0 + t) * D_ + 256 + cv) = w2; }
        __syncthreads();
    }
}
__device__ __forceinline__ void hgrn_scan(const Args& a, int e) {
    bf16_t* KVT = (bf16_t*)(a.ws + WS_HKV); const float* DEC = (const float*)(a.ws + WS_HDEC);
    const int bh = e >> 12, vk = e & 4095, k = vk & 63; float S = 0.f;
    for (int c = 0; c < 32; ++c) { const size_t idx = ((size_t)(bh * 32 + c) << 12) + vk; const float kv = bf2f(KVT[idx]); KVT[idx] = (bf16_t)f2bf(S);
        S = DEC[(bh * 32 + c) * 64 + k] * S + kv; }
}
__device__ __forceinline__ float shiftmix(const bf16_t* P, size_t row, int tglob, int col, float mu) {
    const float cur = bf2f(P[row * PS_ + PC + col]); const float prev = (tglob > 0) ? bf2f(P[(row - 1) * PS_ + PC + col]) : 0.f; return cur + (prev - cur) * mu; }
__device__ __forceinline__ void rwkv_seq(const Args& a, int l, int bh, LAS unsigned char* lds) {
    const int tid = otid(), wid = tid >> 6, lane = tid & 63, h = bh % 6, b = bh / 6;
    const bf16_t* P = (const bf16_t*)(a.ws + WS_P); bf16_t* Y = (bf16_t*)(a.ws + WS_HY);
    LAS float* LIN = (LAS float*)lds;
    LAS float* VEC = (LAS float*)(lds + 32768);
    LAS float* YL = (LAS float*)(lds + 90112);
    const float* mu = a.in[15] + l * 1408;
    float S[64];
#pragma unroll
    for (int k = 0; k < 64; ++k) S[k] = 0.f;
    const int t = tid >> 4, jg = tid & 15;
#pragma unroll 1
    for (int tb = 0; tb < T_; tb += 32) {
        const size_t row = (size_t)b * T_ + tb + t; const int tglob = tb + t;
#pragma unroll 4
        for (int i = 0; i < 16; ++i) { const int col = 16 * jg + i; const float ps = shiftmix(P, row, tglob, 1152 + col, mu[1152 + col]);
            float v; if (col < 64) { const float e = __expf(2.0f * ps); v = 1.0f - 2.0f / (e + 1.0f); } else if (col < 128) v = ps; else v = sigmoidf_(ps);
            LIN[t * 256 + col] = v; }
        __syncthreads();
        { const int cb = l * 384 + 64 * h + 4 * jg;
          f32x4 wacc = *(const f32x4*)(a.in[16] + cb), aacc = *(const f32x4*)(a.in[18] + cb), gacc = {0.f, 0.f, 0.f, 0.f};
          const float* wu = a.in[17] + (size_t)l * 64 * 384 + 64 * h + 4 * jg; const float* au = a.in[19] + (size_t)l * 64 * 384 + 64 * h + 4 * jg; const float* gu = a.in[20] + (size_t)l * 128 * 384 + 64 * h + 4 * jg;
#pragma unroll 4
          for (int i = 0; i < 64; ++i) { const float x = LIN[t * 256 + i]; wacc += x * *(const f32x4*)(wu + (size_t)i * 384); }
#pragma unroll 4
          for (int i = 0; i < 64; ++i) { const float x = LIN[t * 256 + 64 + i]; aacc += x * *(const f32x4*)(au + (size_t)i * 384); }
#pragma unroll 4
          for (int i = 0; i < 128; ++i) { const float x = LIN[t * 256 + 128 + i]; gacc += x * *(const f32x4*)(gu + (size_t)i * 384); }
          float kk[4], kp[4], aa[4], dec[4], rr[4], vv[4]; float ssq = 0.f;
#pragma unroll
          for (int j = 0; j < 4; ++j) { const int hc = 64 * h + 4 * jg + j;
              const float wp = wacc[j]; const float w = -log1pf(__expf(-wp)) - 0.5f; dec[j] = __expf(-__expf(w));
              aa[j] = sigmoidf_(aacc[j]);
              rr[j] = shiftmix(P, row, tglob, hc, mu[hc]); const float kx = shiftmix(P, row, tglob, 384 + hc, mu[384 + hc]); vv[j] = shiftmix(P, row, tglob, 768 + hc, mu[768 + hc]);
              kk[j] = kx * a.in[21][l * 384 + hc]; ssq += kk[j] * kk[j];
              kp[j] = kx * (1.0f + (aa[j] - 1.0f) * a.in[22][l * 384 + hc]); }
          ssq += __shfl_xor(ssq, 1); ssq += __shfl_xor(ssq, 2); ssq += __shfl_xor(ssq, 4); ssq += __shfl_xor(ssq, 8);
          const float rn = 1.0f / sqrtf(ssq + 1e-12f);
#pragma unroll
          for (int j = 0; j < 4; ++j) { const int jj = 4 * jg + j; const float kn = kk[j] * rn;
              VEC[(t * 7 + 0) * 64 + jj] = kn; VEC[(t * 7 + 1) * 64 + jj] = dec[j]; VEC[(t * 7 + 2) * 64 + jj] = kp[j]; VEC[(t * 7 + 3) * 64 + jj] = kn * aa[j];
              VEC[(t * 7 + 4) * 64 + jj] = rr[j]; VEC[(t * 7 + 5) * 64 + jj] = vv[j]; VEC[(t * 7 + 6) * 64 + jj] = gacc[j]; } }
        __syncthreads();
        if (wid == 0) {
#pragma unroll 1
            for (int ts = 0; ts < 32; ++ts) { const LAS f32x4* V4 = (const LAS f32x4*)(VEC + ts * 7 * 64);
                const float vv = VEC[(ts * 7 + 5) * 64 + lane]; float sa = 0.f;
#pragma unroll
                for (int k4 = 0; k4 < 16; ++k4) { const f32x4 q = V4[k4]; sa += S[4 * k4] * q.x; sa += S[4 * k4 + 1] * q.y; sa += S[4 * k4 + 2] * q.z; sa += S[4 * k4 + 3] * q.w; }
                sa = -sa; float y = 0.f;
#pragma unroll
                for (int k4 = 0; k4 < 16; ++k4) { const f32x4 w = V4[16 + k4], kp = V4[32 + k4], ka = V4[48 + k4], r = V4[64 + k4];
                    S[4 * k4] = S[4 * k4] * w.x + sa * ka.x + vv * kp.x; S[4 * k4 + 1] = S[4 * k4 + 1] * w.y + sa * ka.y + vv * kp.y;
                    S[4 * k4 + 2] = S[4 * k4 + 2] * w.z + sa * ka.z + vv * kp.z; S[4 * k4 + 3] = S[4 * k4 + 3] * w.w + sa * ka.w + vv * kp.w;
                    y += S[4 * k4] * r.x; y += S[4 * k4 + 1] * r.y; y += S[4 * k4 + 2] * r.z; y += S[4 * k4 + 3] * r.w; }
                YL[ts * 64 + lane] = y; }
        }
        __syncthreads();
        { const int cb = l * 384 + 64 * h + 4 * jg; const f32x4 y4 = *(const LAS f32x4*)(YL + t * 64 + 4 * jg);
          float sm = (y4.x + y4.y) + (y4.z + y4.w); sm += __shfl_xor(sm, 1); sm += __shfl_xor(sm, 2); sm += __shfl_xor(sm, 4); sm += __shfl_xor(sm, 8);
          const float mean = sm * (1.0f / 64.0f); const f32x4 d = y4 - mean;
          float vr = (d.x * d.x + d.y * d.y) + (d.z * d.z + d.w * d.w); vr += __shfl_xor(vr, 1); vr += __shfl_xor(vr, 2); vr += __shfl_xor(vr, 4); vr += __shfl_xor(vr, 8);
          const float rs = 1.0f / sqrtf(vr * (1.0f / 64.0f) + 64e-5f);
          const f32x4 rk = *(const f32x4*)(a.in[23] + cb), lw = *(const f32x4*)(a.in[24] + cb), lb = *(const f32x4*)(a.in[25] + cb), be = *(const f32x4*)(a.in[26] + l * 1024 + 640 + 64 * h + 4 * jg);
          float bs = 0.f; float r4[4], v4[4], g4[4];
#pragma unroll
          for (int j = 0; j < 4; ++j) { const int jj = 4 * jg + j; r4[j] = VEC[(t * 7 + 4) * 64 + jj]; v4[j] = VEC[(t * 7 + 5) * 64 + jj]; g4[j] = VEC[(t * 7 + 6) * 64 + jj]; bs += r4[j] * VEC[(t * 7 + 2) * 64 + jj] * rk[j]; }
          bs += __shfl_xor(bs, 1); bs += __shfl_xor(bs, 2); bs += __shfl_xor(bs, 4); bs += __shfl_xor(bs, 8);
          float o[4];
#pragma unroll
          for (int j = 0; j < 4; ++j) o[j] = ((d[j] * rs * lw[j] + lb[j]) + bs * v4[j]) * g4[j] * be[j];
          u32x2 w2; w2.x = pk2(o[0], o[1]); w2.y = pk2(o[2], o[3]);
          *(u32x2*)(Y + row * D_ + 640 + 64 * h + 4 * jg) = w2; }
        __syncthreads();
    }
}
__global__ void __launch_bounds__(512, 2) mk_fwd(Args a) {
    extern __shared__ __attribute__((aligned(16))) unsigned char shm[];
    LAS unsigned char* lds = (LAS unsigned char*)shm;
    cg::grid_group grid = cg::this_grid();
    const int tid = otid(), wid = tid >> 6, lane = tid & 63, G = gridDim.x;
    unsigned char* ws = a.ws;
    bf16_t* Pb = (bf16_t*)(ws + WS_P); bf16_t* HY = (bf16_t*)(ws + WS_HY); float* MOD = (float*)(ws + WS_MOD);
#define PH_BEGIN(n) if (a.ph_lo <= (n) && (n) < a.ph_hi) { if ((n) > a.ph_lo) grid.sync();
#define PH_END }
    PH_BEGIN(0) phase_pro(a, lds); PH_END
#pragma unroll
    for (int l = 0; l < 2; ++l) {
        const int p0 = 1 + 9 * l;
        const float* xin = (l == 0) ? a.in[0] : a.out;
        const float* modl = MOD + (size_t)l * 8 * 6144;
        PH_BEGIN(p0 + 0) phase_norm(xin, a.in[2] + l * D_, modl + 0, modl + 1024, HY); PH_END
        PH_BEGIN(p0 + 1) { pg8::Gemm g{HY, (const bf16_t*)(ws + WS_WIN + l * SZ_WIN), M_, PS_, D_}; pg8::StaticOrder S; S.init(M_, PS_, G, blockIdx.x); EpiP E{Pb, PS_};
                  pg8::gemm_phase<EpiP, pg8::StaticOrder>(lds, g, S, E, nullptr); } PH_END
        PH_BEGIN(p0 + 2) { for (int it = blockIdx.x; it < 1536; it += G) hgrn_item<0>(a, l, it, lds);
                  for (int it = blockIdx.x * 8 + (otid() >> 6); it < 1024; it += G * 8) rg_item<0>(a, l, it, otid() & 63); } PH_END
        PH_BEGIN(p0 + 3) { if ((int)blockIdx.x < 48) rwkv_seq(a, l, blockIdx.x, lds);
                  else { const int nb = G - 48, bi = blockIdx.x - 48;
                      for (int e = bi * 512 + otid(); e < 48 * 4096; e += nb * 512) hgrn_scan(a, e);
                      for (int e = bi * 512 + otid(); e < 2048; e += nb * 512) rg_carry(a, e); } } PH_END
        PH_BEGIN(p0 + 4) { for (int it = blockIdx.x; it < 1536; it += G) hgrn_item<1>(a, l, it, lds);
                  for (int it = blockIdx.x * 8 + (otid() >> 6); it < 1024; it += G * 8) rg_item<1>(a, l, it, otid() & 63); } PH_END
        PH_BEGIN(p0 + 5) { pg8::Gemm g{HY, (const bf16_t*)(ws + WS_WOUT + l * SZ_WOUT), M_, D_, D_}; pg8::StaticOrder S; S.init(M_, D_, G, blockIdx.x); EpiRes E{xin, a.out, modl + 2048};
                  pg8::gemm_phase<EpiRes, pg8::StaticOrder>(lds, g, S, E, nullptr); } PH_END
        PH_BEGIN(p0 + 6) phase_norm(a.out, a.in[3] + l * D_, modl + 3072, modl + 4096, HY); PH_END
        PH_BEGIN(p0 + 7) { pg8::Gemm g{HY, (const bf16_t*)(ws + WS_WGU + l * SZ_WGU), M_, NGU_, D_}; pg8::StaticOrder S; S.init(M_, NGU_, G, blockIdx.x); EpiSwi E{Pb};
                  pg8::gemm_phase<EpiSwi, pg8::StaticOrder>(lds, g, S, E, nullptr); } PH_END
        PH_BEGIN(p0 + 8) { pg8::Gemm g{Pb, (const bf16_t*)(ws + WS_WD + l * SZ_WD), M_, D_, FF_}; pg8::StaticOrder S; S.init(M_, D_, G, blockIdx.x); EpiRes E{a.out, a.out, modl + 5120};
                  pg8::gemm_phase<EpiRes, pg8::StaticOrder>(lds, g, S, E, nullptr); } PH_END
    }
    PH_BEGIN(19) phase_final(a.out, a.in[31]); PH_END
}
#ifndef MK_MULTI
#define MK_MULTI 0
#endif
extern "C" void kernel_launch(void* const* d_in, const int* in_sizes, int n_in, void* d_out, int out_size, void* d_ws, size_t ws_size, hipStream_t stream) {
    static int grid = 0;
    if (!grid) {
        if (n_in != 32 || ws_size < WS_END) { fprintf(stderr, "kernel_launch: bad args n_in %d ws %zu need %zu\n", n_in, ws_size, (size_t)WS_END); return; }
        hipFuncSetAttribute((const void*)mk_fwd, hipFuncAttributeMaxDynamicSharedMemorySize, LDS_BYTES);
        int dev = 0, cus = 0, per_cu = 0; hipGetDevice(&dev); hipDeviceGetAttribute(&cus, hipDeviceAttributeMultiprocessorCount, dev);
        hipOccupancyMaxActiveBlocksPerMultiprocessor(&per_cu, mk_fwd, 512, LDS_BYTES);
        if (per_cu < 1) { fprintf(stderr, "kernel_launch: occupancy 0\n"); per_cu = 1; }
        grid = cus;
    }
    Args a{}; for (int i = 0; i < 32; ++i) a.in[i] = (const float*)d_in[i];
    a.out = (float*)d_out; a.ws = (unsigned char*)d_ws;
#if MK_MULTI
    for (int ph = 0; ph < 20; ++ph) { a.ph_lo = ph; a.ph_hi = ph + 1; hipLaunchKernelGGL(mk_fwd, dim3(grid), dim3(512), LDS_BYTES, stream, a); }
#else
    a.ph_lo = 0; a.ph_hi = 20; void* args[] = {&a};
    hipError_t e = hipLaunchCooperativeKernel((const void*)mk_fwd, dim3(grid), dim3(512), args, LDS_BYTES, stream);
    if (e != hipSuccess) fprintf(stderr, "cooperative launch failed: %s (grid %d)\n", hipGetErrorString(e), grid);
#endif
}
```

```cpp
#include <hip/hip_runtime.h>
#include <hip/hip_cooperative_groups.h>
#include <cstdio>
#include <cstdint>
namespace cg = cooperative_groups;
__device__ __forceinline__ int otid() { int t = threadIdx.x; asm volatile("" : "+v"(t)); return t; }
namespace pg8 {
#define PG8_LAS __attribute__((address_space(3)))
typedef unsigned short bf16_t;
typedef short bf16x8 __attribute__((ext_vector_type(8)));
typedef float f32x4 __attribute__((ext_vector_type(4)));
typedef unsigned u32x4 __attribute__((ext_vector_type(4)));
constexpr int BM = 256, BK = 64, HALF = 128, HTB = HALF * BK * 2  , STAGE_BYTES = 8 * HTB, NXCD = 8, WGM = 8;

__host__ __device__ __forceinline__ int lds_byte(int r, int c) { const int st = (r >> 4) * 2 + (c >> 5), rr = r & 15, cc = c & 31, ob = rr * 64 + cc * 2; return st * 1024 + (ob ^ (((ob >> 9) & 1) << 5)); }
__host__ __device__ __forceinline__ void stage_rc(int b, int& R, int& C) { const int st = b / 1024, sb = b % 1024, swz = sb ^ (((sb >> 9) & 1) << 5); R = (st >> 1) * 16 + swz / 64; C = (st & 1) * 32 + (swz % 64) / 2; }
__host__ __device__ __forceinline__ int perm32(int rho) { const int n = rho >> 4, i = rho & 15; return 8 * (i >> 2) + 4 * n + (i & 3); }

struct Unit { int pm, pn; };
struct Gemm { const bf16_t* A; const bf16_t* Bt; int M, N, K; };

struct StaticOrder {
    int nM, nN, nwg, G, c;
    __host__ __device__ void init(int M, int N, int G_, int c_) { nM = M / BM; nN = N / BM; nwg = nM * nN; G = G_; c = c_; }
    __host__ __device__ bool next(int i, Unit& u) const {
        const long L = (long)i * G + c; if (L >= nwg) return false;
        int wgid = (int)L; { const int q = nwg / NXCD, r = nwg % NXCD, xcd = wgid % NXCD, off = wgid / NXCD; wgid = (xcd < r ? xcd * (q + 1) : r * (q + 1) + (xcd - r) * q) + off; }
        const int nig = WGM * nN, gid = wgid / nig, fm = gid * WGM, gsz = (nM - fm) < WGM ? (nM - fm) : WGM;
        u.pm = fm + ((wgid % nig) % gsz); u.pn = (wgid % nig) / gsz; return true;
    }
    __device__ __forceinline__ void a_ready(const Unit&) const {}
    __device__ __forceinline__ void done(const Unit&) const {}
};
__device__ __forceinline__ unsigned cvt_pk_bf16(float lo, float hi) { unsigned r; asm volatile("v_cvt_pk_bf16_f32 %0, %1, %2" : "=v"(r) : "v"(lo), "v"(hi)); return r; }
template <class Epi, class Sched, bool STAMP = false>
__device__ __forceinline__ void gemm_phase(PG8_LAS unsigned char* lds, const Gemm g, const Sched& S, const Epi& E, unsigned long long* stamps) {
    const int tid = otid(), wid = __builtin_amdgcn_readfirstlane(tid >> 6), lane = tid & 63, wr = wid >> 2, wc = wid & 3, fr = lane & 15, fq = lane >> 4;
    const int K = g.K, nt = K / BK;
    unsigned voffA[2], voffB[2];
#pragma unroll
    for (int i = 0; i < 2; ++i) { int R, C; stage_rc(tid * 16 + i * 8192, R, C); const int Rb = Epi::PERM ? ((R & ~31) + perm32(R & 31)) : R;
        voffA[i] = (unsigned)(R * K + C) * 2u; voffB[i] = (unsigned)(Rb * K + C) * 2u; }
    const size_t kstep = (size_t)(BK * 2);
    const size_t hstep = (size_t)HALF * K * 2;
    const size_t tstep = 2 * hstep;
    const unsigned ldsw = (unsigned)wid * 1024u;
    const int aoff = lds_byte(wr * 64 + fr, fq * 8), boff = lds_byte(wc * 32 + fr, fq * 8);
#define PG8_SA(b, h) (((b) * 2 + (h)) * HTB)
#define PG8_SB(b, h) ((4 + (b) * 2 + (h)) * HTB)
#define PG8_STAGE(bufoff, gbase, voff) do { _Pragma("unroll") for (int _i = 0; _i < 2; ++_i) \
        __builtin_amdgcn_global_load_lds((const unsigned*)((const char*)(gbase) + (voff)[_i]), (PG8_LAS unsigned*)(lds + (bufoff) + ldsw + _i * 8192), 16, 0, 0); } while (0)
#define PG8_LDA(dst, b, h) do { _Pragma("unroll") for (int m = 0; m < 4; ++m) _Pragma("unroll") for (int k = 0; k < 2; ++k) dst[m][k] = *(const PG8_LAS bf16x8*)(lds + PG8_SA(b, h) + aoff + m * 2048 + k * 1024); } while (0)
#define PG8_LDB(dst, b, h) do { _Pragma("unroll") for (int n = 0; n < 2; ++n) _Pragma("unroll") for (int k = 0; k < 2; ++k) dst[n][k] = *(const PG8_LAS bf16x8*)(lds + PG8_SB(b, h) + boff + n * 2048 + k * 1024); } while (0)
#define PG8_MMA(ai, bj, At, Bt) do { __builtin_amdgcn_s_setprio(1); _Pragma("unroll") for (int m = 0; m < 4; ++m) _Pragma("unroll") for (int n = 0; n < 2; ++n) _Pragma("unroll") for (int k = 0; k < 2; ++k) \
        acc[ai][bj][m][n] = __builtin_amdgcn_mfma_f32_16x16x32_bf16(Bt[n][k], At[m][k], acc[ai][bj][m][n], 0, 0, 0); __builtin_amdgcn_s_setprio(0); } while (0)
#define PG8_WAIT_V(n) asm volatile("s_waitcnt vmcnt(" #n ")" ::: "memory")
#define PG8_WAIT_L(n) asm volatile("s_waitcnt lgkmcnt(" #n ")" ::: "memory")
#define PG8_BAR __builtin_amdgcn_s_barrier()
#define PG8_SCHED __builtin_amdgcn_sched_barrier(0)
    Unit cur, nxt; int ui = 0;
    if (!S.next(0, cur)) return;
    f32x4 acc[2][2][4][2];
#pragma unroll
    for (int a = 0; a < 2; ++a)
#pragma unroll
        for (int b = 0; b < 2; ++b)
#pragma unroll
            for (int m = 0; m < 4; ++m)
#pragma unroll
                for (int n = 0; n < 2; ++n) acc[a][b][m][n] = (f32x4){0.f, 0.f, 0.f, 0.f};
    bf16x8 At[4][2], B0[2][2], B1[2][2];
    const char* cA = (const char*)g.A + (size_t)cur.pm * tstep; const char* cB = (const char*)g.Bt + (size_t)cur.pn * tstep;
    S.a_ready(cur);
    PG8_STAGE(PG8_SB(0, 0), cB, voffB); PG8_STAGE(PG8_SA(0, 0), cA, voffA); PG8_STAGE(PG8_SB(0, 1), cB + hstep, voffB); PG8_STAGE(PG8_SA(0, 1), cA + hstep, voffA);
    if (wr == 1) PG8_BAR;
    PG8_WAIT_V(4); PG8_BAR;
    PG8_STAGE(PG8_SB(1, 0), cB + kstep, voffB); PG8_STAGE(PG8_SA(1, 0), cA + kstep, voffA); PG8_STAGE(PG8_SB(1, 1), cB + hstep + kstep, voffB);
    PG8_WAIT_V(6); PG8_BAR;
    for (;;) {
        const bool has_next = S.next(ui + 1, nxt);
        const char* nA = has_next ? (const char*)g.A + (size_t)nxt.pm * tstep : cA; const char* nB = has_next ? (const char*)g.Bt + (size_t)nxt.pn * tstep : cB;
        for (int t = 0; t < nt; t += 2) {
            const bool last = (t == nt - 2);
            const char* a1 = cA + (size_t)(t + 1) * kstep;
            const char* a2 = last ? nA : cA + (size_t)(t + 2) * kstep; const char* b2 = last ? nB : cB + (size_t)(t + 2) * kstep;
            const char* a3 = a2 + kstep; const char* b3 = b2 + kstep;
            if (last && has_next) S.a_ready(nxt);
            PG8_LDB(B0, 0, 0); PG8_SCHED; PG8_LDA(At, 0, 0); PG8_STAGE(PG8_SA(1, 1), a1 + hstep, voffA);
            PG8_WAIT_L(8); PG8_BAR; PG8_WAIT_L(0); PG8_MMA(0, 0, At, B0); PG8_BAR; PG8_SCHED;
            PG8_LDB(B1, 0, 1); PG8_STAGE(PG8_SB(0, 0), b2, voffB);
            PG8_BAR; PG8_WAIT_L(0); PG8_MMA(0, 1, At, B1); PG8_BAR;
            PG8_LDA(At, 0, 1); PG8_STAGE(PG8_SA(0, 0), a2, voffA);
            PG8_BAR; PG8_WAIT_L(0); PG8_MMA(1, 0, At, B0); PG8_BAR; PG8_SCHED;
            PG8_STAGE(PG8_SB(0, 1), b2 + hstep, voffB);
            PG8_WAIT_V(6); PG8_BAR; PG8_MMA(1, 1, At, B1); PG8_BAR;
            PG8_LDB(B0, 1, 0); PG8_SCHED; PG8_LDA(At, 1, 0); PG8_STAGE(PG8_SA(0, 1), a2 + hstep, voffA);
            PG8_WAIT_L(8); PG8_BAR; PG8_WAIT_L(0); PG8_MMA(0, 0, At, B0); PG8_BAR; PG8_SCHED;
            PG8_LDB(B1, 1, 1); PG8_STAGE(PG8_SB(1, 0), b3, voffB);
            PG8_BAR; PG8_WAIT_L(0); PG8_MMA(0, 1, At, B1); PG8_BAR;
            PG8_LDA(At, 1, 1); PG8_STAGE(PG8_SA(1, 0), a3, voffA);
            PG8_BAR; PG8_WAIT_L(0); PG8_MMA(1, 0, At, B0); PG8_BAR; PG8_SCHED;
            PG8_STAGE(PG8_SB(1, 1), b3 + hstep, voffB);
            PG8_WAIT_V(6); PG8_BAR; PG8_MMA(1, 1, At, B1); PG8_BAR;
        }
        if constexpr (!Epi::AFTER_DRAIN) { E(acc, cur, wr, wc, fr, fq); S.done(cur); }
        if (!has_next) break;
#pragma unroll
        for (int a = 0; a < 2; ++a)
#pragma unroll
            for (int b = 0; b < 2; ++b)
#pragma unroll
                for (int m = 0; m < 4; ++m)
#pragma unroll
                    for (int n = 0; n < 2; ++n) acc[a][b][m][n] = (f32x4){0.f, 0.f, 0.f, 0.f};
        cur = nxt; cA = nA; cB = nB; ++ui;
    }
    PG8_WAIT_V(0);
    if (wr == 0) PG8_BAR;
    PG8_BAR;
    if constexpr (Epi::AFTER_DRAIN) { E.fused(acc, cur, wr, wc, fr, fq, lds, wid, lane); S.done(cur); }
#undef PG8_SA
#undef PG8_SB
#undef PG8_STAGE
#undef PG8_LDA
#undef PG8_LDB
#undef PG8_MMA
#undef PG8_WAIT_V
#undef PG8_WAIT_L
#undef PG8_BAR
#undef PG8_SCHED
}
}
using pg8::bf16_t; using pg8::bf16x8; using pg8::f32x4; using pg8::u32x4;
#define LAS __attribute__((address_space(3)))
typedef float f32x2 __attribute__((ext_vector_type(2)));
typedef unsigned u32x2 __attribute__((ext_vector_type(2)));
typedef short s16x4 __attribute__((ext_vector_type(4)));

constexpr int M_ = 16384, D_ = 1024, T_ = 2048, NB_ = 8, PS_ = 3584, PW_ = 3456, FF_ = 2816, NGU_ = 5632;
constexpr int PAX = 0, PAY = 256, PBQ = 512, PBF = 896, PBV = 1280, PBG = 1664, PC = 2048;
constexpr int LDS_BYTES = 144 * 1024;
constexpr size_t SZ_WIN = (size_t)PS_ * D_ * 2, SZ_WOUT = (size_t)D_ * D_ * 2, SZ_WGU = (size_t)NGU_ * D_ * 2, SZ_WD = (size_t)D_ * FF_ * 2;
constexpr size_t WS_WIN = 0, WS_WOUT = WS_WIN + 2 * SZ_WIN, WS_WGU = WS_WOUT + 2 * SZ_WOUT, WS_WD = WS_WGU + 2 * SZ_WGU;
constexpr size_t WS_MOD = WS_WD + 2 * SZ_WD;
constexpr size_t WS_P = WS_MOD + 2 * 8 * 6144 * 4;
constexpr size_t WS_HY = WS_P + (size_t)M_ * PS_ * 2;
constexpr size_t WS_RGA = WS_HY + (size_t)M_ * D_ * 2;
constexpr size_t WS_HKV = WS_RGA + 3 * 8 * 32 * 256 * 4;
constexpr size_t WS_HDEC = WS_HKV + (size_t)1536 * 4096 * 2;
constexpr size_t WS_RM = WS_HDEC + (size_t)1536 * 64 * 4;
constexpr size_t WS_RN = WS_RM + (size_t)1536 * 4096 * 2;
constexpr size_t WS_RGAM = WS_RN + (size_t)1536 * 4096 * 2;
constexpr size_t WS_LORA = WS_RGAM + (size_t)1536 * 64 * 4;
constexpr size_t WS_END = WS_LORA + (size_t)2 * 98304 * 2;

struct Args { const float* in[32]; float* out; unsigned char* ws; int ph_lo, ph_hi; };

__device__ __forceinline__ unsigned f2bf(float f) { unsigned u = __builtin_bit_cast(unsigned, f); return (u + 0x7fffu + ((u >> 16) & 1u)) >> 16; }
__device__ __forceinline__ unsigned pk2(float lo, float hi) { return f2bf(lo) | (f2bf(hi) << 16); }
__device__ __forceinline__ float bf2f(unsigned short b) { return __builtin_bit_cast(float, ((unsigned)b) << 16); }
__device__ __forceinline__ float bflo(unsigned w) { return __builtin_bit_cast(float, w << 16); }
__device__ __forceinline__ float bfhi(unsigned w) { return __builtin_bit_cast(float, w & 0xffff0000u); }
__device__ __forceinline__ float wave_sum(float v) {
#pragma unroll
    for (int o = 1; o < 64; o <<= 1) v += __shfl_xor(v, o);
    return v;
}
__device__ __forceinline__ float sigmoidf_(float x) { return 1.0f / (1.0f + __expf(-x)); }
#define LDS_WAIT() asm volatile("s_waitcnt lgkmcnt(0)" ::: "memory")

struct EpiP {
    static constexpr bool PERM = true, AFTER_DRAIN = false;
    bf16_t* O; int ldc;
    __device__ __forceinline__ void operator()(const f32x4 (&acc)[2][2][4][2], const pg8::Unit& u, int wr, int wc, int fr, int fq) const {
        const int row0 = u.pm * 256 + wr * 64 + fr, col0 = u.pn * 256 + wc * 32 + 8 * fq;
#pragma unroll
        for (int ai = 0; ai < 2; ++ai)
#pragma unroll
            for (int m = 0; m < 4; ++m) { bf16_t* rowp = O + (size_t)(row0 + ai * 128 + m * 16) * ldc + col0;
#pragma unroll
                for (int bj = 0; bj < 2; ++bj) { const f32x4 v0 = acc[ai][bj][m][0], v1 = acc[ai][bj][m][1]; u32x4 w;
                    w.x = pg8::cvt_pk_bf16(v0[0], v0[1]); w.y = pg8::cvt_pk_bf16(v0[2], v0[3]); w.z = pg8::cvt_pk_bf16(v1[0], v1[1]); w.w = pg8::cvt_pk_bf16(v1[2], v1[3]);
                    *(u32x4*)(rowp + bj * 128) = w; } }
    }
};
struct EpiRes {
    static constexpr bool PERM = false, AFTER_DRAIN = false;
    const float* base; float* out; const float* gate;
    __device__ __forceinline__ void operator()(const f32x4 (&acc)[2][2][4][2], const pg8::Unit& u, int wr, int wc, int fr, int fq) const {
        const int row0 = u.pm * 256 + wr * 64 + fr, col0 = u.pn * 256 + wc * 32 + 4 * fq, b = u.pm >> 3;
        f32x4 gv[2][2];
#pragma unroll
        for (int bj = 0; bj < 2; ++bj)
#pragma unroll
            for (int n = 0; n < 2; ++n) gv[bj][n] = *(const f32x4*)(gate + (size_t)b * 6144 + col0 + bj * 128 + n * 16);
#pragma unroll
        for (int ai = 0; ai < 2; ++ai)
#pragma unroll
            for (int m = 0; m < 4; ++m) { const size_t ro = (size_t)(row0 + ai * 128 + m * 16) * 1024 + col0;
#pragma unroll
                for (int bj = 0; bj < 2; ++bj)
#pragma unroll
                    for (int n = 0; n < 2; ++n) { const f32x4 bv = *(const f32x4*)(base + ro + bj * 128 + n * 16);
                        *(f32x4*)(out + ro + bj * 128 + n * 16) = bv + gv[bj][n] * acc[ai][bj][m][n]; } }
    }
};
struct EpiSwi {
    static constexpr bool PERM = true, AFTER_DRAIN = false;
    bf16_t* O;
    __device__ __forceinline__ void operator()(const f32x4 (&acc)[2][2][4][2], const pg8::Unit& u, int wr, int wc, int fr, int fq) const {
        const int row0 = u.pm * 256 + wr * 64 + fr, col0 = u.pn * 128 + wc * 32 + 8 * fq;
#pragma unroll
        for (int ai = 0; ai < 2; ++ai)
#pragma unroll
            for (int m = 0; m < 4; ++m) { bf16_t* rowp = O + (size_t)(row0 + ai * 128 + m * 16) * FF_ + col0; float o[8];
#pragma unroll
                for (int n = 0; n < 2; ++n)
#pragma unroll
                    for (int i = 0; i < 4; ++i) { const float g = acc[ai][0][m][n][i], up = acc[ai][1][m][n][i]; o[4 * n + i] = g * sigmoidf_(g) * up; }
                u32x4 w; w.x = pg8::cvt_pk_bf16(o[0], o[1]); w.y = pg8::cvt_pk_bf16(o[2], o[3]); w.z = pg8::cvt_pk_bf16(o[4], o[5]); w.w = pg8::cvt_pk_bf16(o[6], o[7]);
                *(u32x4*)rowp = w; }
    }
};

__device__ __forceinline__ void transpose_item(const float* W, int K, int N, bf16_t* WT, int mode, LAS float* scr, int item, int lane) {
    const int nblk = N / 32, kb = item / nblk, nb = item % nblk, k0 = 64 * kb, n0 = 32 * nb;
#pragma unroll 8
    for (int i = 0; i < 32; ++i) { const int kk = 2 * i + (lane >> 5); scr[kk * 33 + (lane & 31)] = W[(size_t)(k0 + kk) * N + n0 + (lane & 31)]; }
    LDS_WAIT(); asm volatile("" ::: "memory");
    const int c = lane & 7;
#pragma unroll
    for (int j = 0; j < 4; ++j) { const int nl = (lane >> 3) + 8 * j, n = n0 + nl; const LAS float* s = scr + (8 * c) * 33 + nl;
        const int row = (mode == 0) ? n : (256 * (n >> 7) + (n & 127) + (mode == 2 ? 128 : 0));
        u32x4 o; o.x = pk2(s[0 * 33], s[1 * 33]); o.y = pk2(s[2 * 33], s[3 * 33]); o.z = pk2(s[4 * 33], s[5 * 33]); o.w = pk2(s[6 * 33], s[7 * 33]);
        *(u32x4*)(WT + (size_t)row * K + k0 + 8 * c) = o; }
    LDS_WAIT(); asm volatile("" ::: "memory");
}
__device__ __forceinline__ void phase_pro(const Args& a, LAS unsigned char* lds) {
    const int tid = otid(), wid = tid >> 6, lane = tid & 63;
    unsigned char* ws = a.ws;
    LAS float* CS = (LAS float*)lds;
    LAS float* RED = (LAS float*)(lds + 32768);
    if ((int)blockIdx.x < 192) {
        for (int i = tid; i < 8192; i += 512) { const float cv = a.in[1][i]; CS[i] = cv * sigmoidf_(cv); }
        __syncthreads();
    }
    for (int item = blockIdx.x; item < 192; item += gridDim.x) {
        const int l = item / 96, cgp = item % 96, col = cgp * 64 + lane;
        const float* aw = a.in[4] + (size_t)l * 1024 * 6144;
        float acc[8];
#pragma unroll
        for (int b = 0; b < 8; ++b) acc[b] = 0.f;
        for (int k = wid * 128; k < wid * 128 + 128; ++k) { const float w = aw[(size_t)k * 6144 + col];
#pragma unroll
            for (int b = 0; b < 8; ++b) acc[b] += CS[b * 1024 + k] * w; }
#pragma unroll
        for (int b = 0; b < 8; ++b) RED[(wid * 8 + b) * 64 + lane] = acc[b];
        __syncthreads();
        { const int b = wid; float s = 0.f;
#pragma unroll
          for (int w = 0; w < 8; ++w) s += RED[(w * 8 + b) * 64 + lane];
          ((float*)(ws + WS_MOD))[(size_t)(l * 8 + b) * 6144 + col] = s + a.in[5][l * 6144 + col]; }
        __syncthreads();
    }
    LAS float* scr = (LAS float*)(lds + 65536 + wid * 8448);
    const int gw = blockIdx.x * 8 + wid, NGW = gridDim.x * 8;
    constexpr int I_IN = 16 * (PW_ / 32), I_OUT = 16 * 32, I_G = 16 * (FF_ / 32), I_D = (FF_ / 64) * 32, I_L = I_IN + I_OUT + 2 * I_G + I_D;
    for (int it = gw; it < 2 * I_L; it += NGW) {
        const int l = it / I_L; int r = it % I_L;
        if (r < I_IN) { transpose_item(a.in[6] + (size_t)l * D_ * PW_, D_, PW_, (bf16_t*)(ws + WS_WIN + l * SZ_WIN), 0, scr, r, lane); continue; } r -= I_IN;
        if (r < I_OUT) { transpose_item(a.in[27] + (size_t)l * D_ * D_, D_, D_, (bf16_t*)(ws + WS_WOUT + l * SZ_WOUT), 0, scr, r, lane); continue; } r -= I_OUT;
        if (r < I_G) { transpose_item(a.in[28] + (size_t)l * D_ * FF_, D_, FF_, (bf16_t*)(ws + WS_WGU + l * SZ_WGU), 1, scr, r, lane); continue; } r -= I_G;
        if (r < I_G) { transpose_item(a.in[29] + (size_t)l * D_ * FF_, D_, FF_, (bf16_t*)(ws + WS_WGU + l * SZ_WGU), 2, scr, r, lane); continue; } r -= I_G;
        transpose_item(a.in[30] + (size_t)l * FF_ * D_, FF_, D_, (bf16_t*)(ws + WS_WD + l * SZ_WD), 0, scr, r, lane);
    }
    for (int e = blockIdx.x * 512 + tid; e < 2 * 98304; e += gridDim.x * 512) { const int l = e / 98304; int r = e % 98304; float v;
        if (r < 24576) { const int cidx = r >> 6, i = r & 63; v = a.in[17][((size_t)l * 64 + i) * 384 + cidx]; }
        else if (r < 49152) { const int r2 = r - 24576, cidx = r2 >> 6, i = r2 & 63; v = a.in[19][((size_t)l * 64 + i) * 384 + cidx]; }
        else { const int r2 = r - 49152, cidx = r2 >> 7, i = r2 & 127; v = a.in[20][((size_t)l * 128 + i) * 384 + cidx]; }
        ((bf16_t*)(ws + WS_LORA))[e] = (bf16_t)f2bf(v); }
    for (int i = blockIdx.x * 512 + tid; i < 2 * 16384; i += gridDim.x * 512) { const int l = i >> 14, e = i & 16383;
        *(u32x4*)(ws + WS_WIN + l * SZ_WIN + (size_t)PW_ * D_ * 2 + (size_t)e * 16) = (u32x4){0u, 0u, 0u, 0u}; }
}
__device__ __forceinline__ void phase_norm(const float* xin, const float* gain, const float* sh, const float* sc, bf16_t* H) {
    const int tid = otid(), wid = tid >> 6, lane = tid & 63, gw = blockIdx.x * 8 + wid, NGW = gridDim.x * 8;
    for (int row = gw; row < M_; row += NGW) { const int b = row >> 11;
        const f32x4* xr = (const f32x4*)(xin + (size_t)row * D_) + lane; f32x4 v[4]; float ss = 0.f;
#pragma unroll
        for (int j = 0; j < 4; ++j) { v[j] = xr[64 * j]; ss += (v[j].x * v[j].x + v[j].y * v[j].y) + (v[j].z * v[j].z + v[j].w * v[j].w); }
        const float rs = 1.0f / sqrtf(wave_sum(ss) * (1.0f / D_) + 1e-6f);
#pragma unroll
        for (int j = 0; j < 4; ++j) { const int col = 4 * lane + 256 * j;
            const f32x4 g = *(const f32x4*)(gain + col), s1 = *(const f32x4*)(sc + (size_t)b * 6144 + col), s0 = *(const f32x4*)(sh + (size_t)b * 6144 + col);
            const f32x4 h = v[j] * rs * g * (s1 + 1.0f) + s0;
            u32x2 w; w.x = pk2(h.x, h.y); w.y = pk2(h.z, h.w); *(u32x2*)(H + (size_t)row * D_ + col) = w; }
    }
}
__device__ __forceinline__ void phase_final(float* x, const float* gain) {
    const int tid = otid(), wid = tid >> 6, lane = tid & 63, gw = blockIdx.x * 8 + wid, NGW = gridDim.x * 8;
    for (int row = gw; row < M_; row += NGW) {
        f32x4* xr = (f32x4*)(x + (size_t)row * D_) + lane; f32x4 v[4]; float ss = 0.f;
#pragma unroll
        for (int j = 0; j < 4; ++j) { v[j] = xr[64 * j]; ss += (v[j].x * v[j].x + v[j].y * v[j].y) + (v[j].z * v[j].z + v[j].w * v[j].w); }
        const float rs = 1.0f / sqrtf(wave_sum(ss) * (1.0f / D_) + 1e-6f);
#pragma unroll
        for (int j = 0; j < 4; ++j) { const f32x4 g = *(const f32x4*)(gain + 4 * lane + 256 * j); xr[64 * j] = v[j] * rs * g; }
    }
}
__device__ __forceinline__ float gelu_tanh(float x) { const float u = 0.7978845608f * (x + 0.044715f * x * x * x); const float e = __expf(2.0f * u); const float th = 1.0f - 2.0f / (e + 1.0f); return 0.5f * x * (1.0f + th); }
template <int MODE>
__device__ __forceinline__ void rg_item(const Args& a, int l, int item, int lane) {
    const int g = item & 3, c = (item >> 2) & 31, b = item >> 7, ch = 64 * g + lane, row0 = b * T_ + 64 * c;
    const bf16_t* P = (const bf16_t*)(a.ws + WS_P);
    float* AGG = (float*)(a.ws + WS_RGA);
    float Wr[64], Wi[64];
#pragma unroll
    for (int i = 0; i < 64; ++i) { Wr[i] = a.in[9][((size_t)(l * 4 + g) * 64 + i) * 64 + lane]; Wi[i] = a.in[11][((size_t)(l * 4 + g) * 64 + i) * 64 + lane]; }
    const float cw0 = a.in[7][(l * 4 + 0) * 256 + ch], cw1 = a.in[7][(l * 4 + 1) * 256 + ch], cw2 = a.in[7][(l * 4 + 2) * 256 + ch], cw3 = a.in[7][(l * 4 + 3) * 256 + ch];
    const float cb = a.in[8][l * 256 + ch], rb = a.in[10][l * 256 + ch], ib = a.in[12][l * 256 + ch], lam = a.in[13][l * 256 + ch];
    const float sp = log1pf(__expf(-lam));
    float xm3 = 0.f, xm2 = 0.f, xm1 = 0.f;
    if (c > 0) { xm3 = bf2f(P[(size_t)(row0 - 3) * PS_ + PAX + ch]); xm2 = bf2f(P[(size_t)(row0 - 2) * PS_ + PAX + ch]); xm1 = bf2f(P[(size_t)(row0 - 1) * PS_ + PAX + ch]); }
    float h = 0.f, Ap = 1.f, beta = 0.f;
    if (MODE == 1) { h = AGG[2 * 65536 + (b * 32 + c) * 256 + ch]; beta = a.in[26][l * 1024 + ch]; }
    bf16_t* Y = (bf16_t*)(a.ws + WS_HY);
    for (int t = 0; t < 64; ++t) {
        const float xc = bf2f(P[(size_t)(row0 + t) * PS_ + PAX + ch]);
        const float u = cb + cw0 * xm3 + cw1 * xm2 + cw2 * xm1 + cw3 * xc;
        xm3 = xm2; xm2 = xm1; xm1 = xc;
        float rp = rb, ip = ib;
#pragma unroll
        for (int i = 0; i < 64; ++i) { const float ui = __builtin_bit_cast(float, __builtin_amdgcn_readlane(__builtin_bit_cast(int, u), i)); rp += ui * Wr[i]; ip += ui * Wi[i]; }
        const float r = sigmoidf_(rp), ig = sigmoidf_(ip);
        const float log_a = -8.0f * r * sp, av = __expf(log_a);
        float mult = sqrtf(-expm1f(2.0f * log_a)); if (c == 0 && t == 0) mult = 1.0f;
        const float bv = mult * ig * u;
        h = av * h + bv;
        if (MODE == 0) Ap *= av;
        else { const float ya = bf2f(P[(size_t)(row0 + t) * PS_ + PAY + ch]); const float y = h * gelu_tanh(ya);
            const float ss = wave_sum(y * y); const float o = y * (1.0f / sqrtf(ss * (1.0f / 64.0f) + 1e-6f)) * beta;
            Y[(size_t)(row0 + t) * D_ + ch] = (bf16_t)f2bf(o); }
    }
    if (MODE == 0) { AGG[(b * 32 + c) * 256 + ch] = Ap; AGG[65536 + (b * 32 + c) * 256 + ch] = h; }
}
__device__ __forceinline__ void rg_carry(const Args& a, int gid) {
    float* AGG = (float*)(a.ws + WS_RGA); const int b = gid >> 8, ch = gid & 255; float H = 0.f;
    for (int c = 0; c < 32; ++c) { const int i = (b * 32 + c) * 256 + ch; AGG[2 * 65536 + i] = H; H = AGG[i] * H + AGG[65536 + i]; }
}
__device__ __forceinline__ f32x4 mfma16(bf16x8 x, bf16x8 y, f32x4 c) { return __builtin_amdgcn_mfma_f32_16x16x32_bf16(x, y, c, 0, 0, 0); }
constexpr int LST = 72;
template <int MODE>
__device__ __forceinline__ void hgrn_item(const Args& a, int l, int item, LAS unsigned char* lds) {
    const int tid = otid(), wid = tid >> 6, lane = tid & 63, fr = lane & 15, fq = lane >> 4;
    const int c = item & 31, bh = item >> 5, h = bh % 6, b = bh / 6, row0 = b * T_ + 64 * c;
    const bf16_t* P = (const bf16_t*)(a.ws + WS_P);
    bf16_t* KVT = (bf16_t*)(a.ws + WS_HKV) + (size_t)item * 4096;
    LAS float* PART = (LAS float*)lds;
    LAS float* RHO = (LAS float*)(lds + 2048);
    LAS float* BC = (LAS float*)(lds + 4096);
    LAS bf16_t* L0 = (LAS bf16_t*)(lds + 20480);
    LAS bf16_t* L1 = (LAS bf16_t*)(lds + 29696);
    LAS bf16_t* L2 = (LAS bf16_t*)(lds + 38912);
    LAS bf16_t* VT = (LAS bf16_t*)(lds + 48128);
    LAS bf16_t* AM = (LAS bf16_t*)(lds + 57344);
    LAS float* SS = (LAS float*)(lds + 66560);
    const int k = lane, pt = wid;
    const float* hl = a.in[14];
    float lbv = 0.f; if (l == 1) lbv = 1.0f / (1.0f + __expf(hl[64 * h + k] - hl[384 + 64 * h + k]));
    float bc[8], kvv[8]; float s = 0.f;
#pragma unroll
    for (int i = 0; i < 8; ++i) { const float z = bf2f(P[(size_t)(row0 + 8 * pt + i) * PS_ + PBF + 64 * h + k]);
        const float sg = 1.0f / (1.0f + __expf(-z)); const float f = fmaxf(lbv + (1.0f - lbv) * sg, 1e-37f);
        s += __logf(f); bc[i] = s; kvv[i] = (1.0f - lbv) / (1.0f + __expf(z)); }
    PART[pt * 64 + k] = s;
    { unsigned short vv[8];
#pragma unroll
      for (int i = 0; i < 8; ++i) vv[i] = P[(size_t)(row0 + 8 * pt + i) * PS_ + PBV + 64 * h + k];
      u32x4 w; w.x = vv[0] | ((unsigned)vv[1] << 16); w.y = vv[2] | ((unsigned)vv[3] << 16); w.z = vv[4] | ((unsigned)vv[5] << 16); w.w = vv[6] | ((unsigned)vv[7] << 16);
      *(LAS u32x4*)(VT + k * LST + 8 * pt) = w; }
    __syncthreads();
    float off = 0.f, tot = 0.f, rho = 0.f;
#pragma unroll
    for (int p = 0; p < 8; ++p) { const float v = PART[p * 64 + k]; if (p < pt) off += v; if (p < 4) rho += v; tot += v; }
#pragma unroll
    for (int i = 0; i < 8; ++i) bc[i] += off;
    if (MODE == 0) {
        u32x4 w; float e[8];
#pragma unroll
        for (int i = 0; i < 8; ++i) e[i] = kvv[i] * __expf(tot - bc[i]);
        w.x = pk2(e[0], e[1]); w.y = pk2(e[2], e[3]); w.z = pk2(e[4], e[5]); w.w = pk2(e[6], e[7]);
        *(LAS u32x4*)(L0 + k * LST + 8 * pt) = w;
        if (pt == 0) ((float*)(a.ws + WS_HDEC))[(size_t)item * 64 + k] = __expf(tot);
        __syncthreads();
        const int kt = wid >> 1;
#pragma unroll
        for (int q = 0; q < 2; ++q) { const int vt = 2 * (wid & 1) + q; f32x4 acc = {0.f, 0.f, 0.f, 0.f};
#pragma unroll
            for (int ks = 0; ks < 2; ++ks) { const bf16x8 x = *(const LAS bf16x8*)(L0 + (16 * kt + fr) * LST + 32 * ks + 8 * fq), y = *(const LAS bf16x8*)(VT + (16 * vt + fr) * LST + 32 * ks + 8 * fq);
                acc = mfma16(x, y, acc); }
            u32x2 w2; w2.x = pk2(acc[0], acc[1]); w2.y = pk2(acc[2], acc[3]);
            *(u32x2*)(KVT + (16 * vt + fr) * 64 + 16 * kt + 4 * fq) = w2; }
        __syncthreads();
    } else {
#pragma unroll
        for (int i = 0; i < 8; ++i) BC[(8 * pt + i) * 64 + k] = bc[i];
        if (pt == 0) RHO[k] = rho;
        __syncthreads();
        { const int t2 = tid >> 3, kg = tid & 7;
          const u32x4 qw = *(const u32x4*)(P + (size_t)(row0 + t2) * PS_ + PBQ + 64 * h + 8 * kg), zw = *(const u32x4*)(P + (size_t)(row0 + t2) * PS_ + PBF + 64 * h + 8 * kg);
          float q[8], z[8], qp[8], qt[8], kt_[8];
          q[0] = bflo(qw.x); q[1] = bfhi(qw.x); q[2] = bflo(qw.y); q[3] = bfhi(qw.y); q[4] = bflo(qw.z); q[5] = bfhi(qw.z); q[6] = bflo(qw.w); q[7] = bfhi(qw.w);
          z[0] = bflo(zw.x); z[1] = bfhi(zw.x); z[2] = bflo(zw.y); z[3] = bfhi(zw.y); z[4] = bflo(zw.z); z[5] = bfhi(zw.z); z[6] = bflo(zw.w); z[7] = bfhi(zw.w);
#pragma unroll
          for (int i = 0; i < 8; ++i) { const int kk = 8 * kg + i; float lb2 = 0.f; if (l == 1) lb2 = 1.0f / (1.0f + __expf(hl[64 * h + kk] - hl[384 + 64 * h + kk]));
              const float kvl = (1.0f - lb2) / (1.0f + __expf(z[i])); const float bcv = BC[t2 * 64 + kk], rh = RHO[kk]; const float qs = q[i] * 0.125f;
              qp[i] = qs * __expf(bcv); qt[i] = qs * __expf(bcv - rh); kt_[i] = kvl * __expf(rh - bcv); }
          u32x4 w; w.x = pk2(qp[0], qp[1]); w.y = pk2(qp[2], qp[3]); w.z = pk2(qp[4], qp[5]); w.w = pk2(qp[6], qp[7]); *(LAS u32x4*)(L0 + t2 * LST + 8 * kg) = w;
          w.x = pk2(qt[0], qt[1]); w.y = pk2(qt[2], qt[3]); w.z = pk2(qt[4], qt[5]); w.w = pk2(qt[6], qt[7]); *(LAS u32x4*)(L1 + t2 * LST + 8 * kg) = w;
          w.x = pk2(kt_[0], kt_[1]); w.y = pk2(kt_[2], kt_[3]); w.z = pk2(kt_[4], kt_[5]); w.w = pk2(kt_[6], kt_[7]); *(LAS u32x4*)(L2 + t2 * LST + 8 * kg) = w; }
        __syncthreads();
        const int tt = wid >> 1;
#pragma unroll
        for (int q = 0; q < 2; ++q) { const int st = 2 * (wid & 1) + q; f32x4 acc = {0.f, 0.f, 0.f, 0.f};
            if (st <= tt) {
#pragma unroll
                for (int ks = 0; ks < 2; ++ks) { const bf16x8 x = *(const LAS bf16x8*)(L2 + (16 * st + fr) * LST + 32 * ks + 8 * fq), y = *(const LAS bf16x8*)(L1 + (16 * tt + fr) * LST + 32 * ks + 8 * fq);
                    acc = mfma16(x, y, acc); }
                const int t = 16 * tt + fr;
#pragma unroll
                for (int j = 0; j < 4; ++j) { const int sidx = 16 * st + 4 * fq + j; if (sidx > t) acc[j] = 0.f; }
            }
            u32x2 w2; w2.x = pk2(acc[0], acc[1]); w2.y = pk2(acc[2], acc[3]);
            *(LAS u32x2*)(AM + (16 * tt + fr) * LST + 16 * st + 4 * fq) = w2; }
        __syncthreads();
        f32x4 o[2]; float ss = 0.f;
#pragma unroll
        for (int q = 0; q < 2; ++q) { const int vt = 2 * (wid & 1) + q; f32x4 acc = {0.f, 0.f, 0.f, 0.f};
#pragma unroll
            for (int ks = 0; ks < 2; ++ks) { const bf16x8 x = *(const bf16x8*)(KVT + (16 * vt + fr) * 64 + 32 * ks + 8 * fq), y = *(const LAS bf16x8*)(L0 + (16 * tt + fr) * LST + 32 * ks + 8 * fq);
                acc = mfma16(x, y, acc); }
#pragma unroll
            for (int ks = 0; ks < 2; ++ks) { const bf16x8 x = *(const LAS bf16x8*)(VT + (16 * vt + fr) * LST + 32 * ks + 8 * fq), y = *(const LAS bf16x8*)(AM + (16 * tt + fr) * LST + 32 * ks + 8 * fq);
                acc = mfma16(x, y, acc); }
            o[q] = acc; ss += (acc[0] * acc[0] + acc[1] * acc[1]) + (acc[2] * acc[2] + acc[3] * acc[3]); }
        ss += __shfl_xor(ss, 16); ss += __shfl_xor(ss, 32);
        if (fq == 0) SS[wid * 16 + fr] = ss;
        __syncthreads();
        const float tot2 = SS[wid * 16 + fr] + SS[(wid ^ 1) * 16 + fr];
        const float rs = 1.0f / sqrtf(tot2 * (1.0f / 64.0f) + 1e-6f);
        bf16_t* Y = (bf16_t*)(a.ws + WS_HY);
#pragma unroll
        for (int q = 0; q < 2; ++q) { const int vt = 2 * (wid & 1) + q, t = 16 * tt + fr, cv = 64 * h + 16 * vt + 4 * fq;
            const u32x2 gw2 = *(const u32x2*)(P + (size_t)(row0 + t) * PS_ + PBG + cv);
            const f32x4 be = *(const f32x4*)(a.in[26] + l * 1024 + 256 + cv);
            float gg[4] = {bflo(gw2.x), bfhi(gw2.x), bflo(gw2.y), bfhi(gw2.y)}; float r[4];
#pragma unroll
            for (int j = 0; j < 4; ++j) r[j] = o[q][j] * rs * (gg[j] * sigmoidf_(gg[j])) * be[j];
            u32x2 w2; w2.x = pk2(r[0], r[1]); w2.y = pk2(r[2], r[3]);
            *(u32x2*)(Y + (size_t)(row0 + t) * D_ + 256 + cv) = w2; }
        __syncthreads();
    }
}
__device__ __forceinline__ void hgrn_scan(const Args& a, int e) {
    bf16_t* KVT = (bf16_t*)(a.ws + WS_HKV); const float* DEC = (const float*)(a.ws + WS_HDEC);
    const int bh = e >> 12, vk = e & 4095, k = vk & 63; float S = 0.f;
    for (int c = 0; c < 32; ++c) { const size_t idx = ((size_t)(bh * 32 + c) << 12) + vk; const float kv = bf2f(KVT[idx]); KVT[idx] = (bf16_t)f2bf(S);
        S = DEC[(bh * 32 + c) * 64 + k] * S + kv; }
}
__device__ __forceinline__ f32x4 mfma16k16(s16x4 x, s16x4 y, f32x4 c) { return __builtin_amdgcn_mfma_f32_16x16x16bf16_1k(x, y, c, 0, 0, 0); }
__device__ __forceinline__ s16x4 pack4(f32x4 v) { u32x2 w; w.x = pk2(v[0], v[1]); w.y = pk2(v[2], v[3]); return __builtin_bit_cast(s16x4, w); }
__device__ __forceinline__ void unpack8(const u32x4 w, float* o) { o[0] = bflo(w.x); o[1] = bfhi(w.x); o[2] = bflo(w.y); o[3] = bfhi(w.y); o[4] = bflo(w.z); o[5] = bfhi(w.z); o[6] = bflo(w.w); o[7] = bfhi(w.w); }
__device__ __forceinline__ u32x4 pack8(const float* e) { u32x4 w; w.x = pk2(e[0], e[1]); w.y = pk2(e[2], e[3]); w.z = pk2(e[4], e[5]); w.w = pk2(e[6], e[7]); return w; }
__device__ __forceinline__ void shift8(const bf16_t* P, size_t row, bool has_prev, int col, const float* mu, float* o) {
    const u32x4 cw = *(const u32x4*)(P + row * PS_ + PC + col); u32x4 pw = {0u, 0u, 0u, 0u}; if (has_prev) pw = *(const u32x4*)(P + (row - 1) * PS_ + PC + col);
    float c[8], p[8]; unpack8(cw, c); unpack8(pw, p); const f32x4 m0 = *(const f32x4*)(mu + col), m1 = *(const f32x4*)(mu + col + 4);
#pragma unroll
    for (int i = 0; i < 8; ++i) o[i] = c[i] + (p[i] - c[i]) * (i < 4 ? m0[i] : m1[i - 4]);
}
constexpr int RW_LIN = 0, RW_LINS = 264;
constexpr int RW_RH = 0, RW_YL = 18432, RW_YLS = 68;
constexpr int RW_CUM = 33792, RW_PART = 50176;
constexpr int RW_LO = 52224, RW_LOS = 68;
constexpr int RW_AT = 52224, RW_BD = 61440, RW_KD = 70656, RW_RT = 79872, RW_BTT = 89088, RW_KTT = 98304, RW_VT = 107520, RW_NAB = 116736, RW_AK = 125952;
constexpr int RW_ARB = RW_BTT, RW_ARK = RW_KTT;
constexpr int RW_NABF = 135168, RW_TII = 139264;
template <int MODE>
__device__ __forceinline__ void rwkv_chunk(const Args& a, int l, int item, LAS unsigned char* lds) {
    const int tid = otid(), wid = tid >> 6, lane = tid & 63, fr = lane & 15, fq = lane >> 4;
    const int c = item & 31, bh = item >> 5, h = bh % 6, b = bh / 6;
    const size_t row0 = (size_t)b * T_ + 64 * c;
    const bf16_t* P = (const bf16_t*)(a.ws + WS_P);
    const bf16_t* LW = (const bf16_t*)(a.ws + WS_LORA) + (size_t)l * 98304;
    const float* mu = a.in[15] + l * 1408;
    LAS bf16_t* LIN = (LAS bf16_t*)(lds + RW_LIN);
    LAS float* CUM = (LAS float*)(lds + RW_CUM); LAS float* PART = (LAS float*)(lds + RW_PART); LAS float* LO = (LAS float*)(lds + RW_LO);
    LAS bf16_t* AT = (LAS bf16_t*)(lds + RW_AT); LAS bf16_t* BD = (LAS bf16_t*)(lds + RW_BD); LAS bf16_t* KD = (LAS bf16_t*)(lds + RW_KD); LAS bf16_t* RT = (LAS bf16_t*)(lds + RW_RT);
    LAS bf16_t* BTT = (LAS bf16_t*)(lds + RW_BTT); LAS bf16_t* KTT = (LAS bf16_t*)(lds + RW_KTT); LAS bf16_t* VT = (LAS bf16_t*)(lds + RW_VT);
    LAS bf16_t* NAB = (LAS bf16_t*)(lds + RW_NAB); LAS bf16_t* AK = (LAS bf16_t*)(lds + RW_AK); LAS bf16_t* ARB = (LAS bf16_t*)(lds + RW_ARB); LAS bf16_t* ARK = (LAS bf16_t*)(lds + RW_ARK);
    LAS float* NABF = (LAS float*)(lds + RW_NABF); LAS bf16_t* TII = (LAS bf16_t*)(lds + RW_TII);
    const int t2 = tid >> 3, kg = tid & 7; const size_t row = row0 + t2; const bool has_prev = (c > 0) || (t2 > 0);
    {
#pragma unroll
        for (int q = 0; q < 4; ++q) { float ps[8]; const int col = 32 * kg + 8 * q; shift8(P, row, has_prev, 1152 + col, mu, ps);
#pragma unroll
            for (int i = 0; i < 8; ++i) { if (kg < 2) { const float e = __expf(2.0f * ps[i]); ps[i] = 1.0f - 2.0f / (e + 1.0f); } else if (kg >= 4) ps[i] = sigmoidf_(ps[i]); }
            *(LAS u32x4*)(LIN + t2 * RW_LINS + col) = pack8(ps); }
    }
    float rr[8], kx[8], vx[8];
    shift8(P, row, has_prev, 64 * h + 8 * kg, mu, rr); shift8(P, row, has_prev, 384 + 64 * h + 8 * kg, mu, kx); shift8(P, row, has_prev, 768 + 64 * h + 8 * kg, mu, vx);
    __syncthreads();
    { const int tt = wid >> 1;
#pragma unroll
      for (int q = 0; q < 2; ++q) { const int ct = 2 * (wid & 1) + q; const int crow = 64 * h + 16 * ct + fr;
          f32x4 aw = {0.f, 0.f, 0.f, 0.f}, aa = {0.f, 0.f, 0.f, 0.f}, ag = {0.f, 0.f, 0.f, 0.f};
#pragma unroll
          for (int ks = 0; ks < 2; ++ks) { const bf16x8 x = *(const LAS bf16x8*)(LIN + (16 * tt + fr) * RW_LINS + 32 * ks + 8 * fq), y = *(const bf16x8*)(LW + (size_t)crow * 64 + 32 * ks + 8 * fq); aw = mfma16(x, y, aw); }
#pragma unroll
          for (int ks = 0; ks < 2; ++ks) { const bf16x8 x = *(const LAS bf16x8*)(LIN + (16 * tt + fr) * RW_LINS + 64 + 32 * ks + 8 * fq), y = *(const bf16x8*)(LW + 24576 + (size_t)crow * 64 + 32 * ks + 8 * fq); aa = mfma16(x, y, aa); }
#pragma unroll
          for (int ks = 0; ks < 4; ++ks) { const bf16x8 x = *(const LAS bf16x8*)(LIN + (16 * tt + fr) * RW_LINS + 128 + 32 * ks + 8 * fq), y = *(const bf16x8*)(LW + 49152 + (size_t)crow * 128 + 32 * ks + 8 * fq); ag = mfma16(x, y, ag); }
#pragma unroll
          for (int j = 0; j < 4; ++j) { const int o = (16 * tt + 4 * fq + j) * RW_LOS + 16 * ct + fr; LO[o] = aw[j]; LO[64 * RW_LOS + o] = aa[j]; LO[2 * 64 * RW_LOS + o] = ag[j]; } }
    }
    __syncthreads();
    float gg[8], lw[8], be[8], al[8], kp[8]; float rkt = 0.f;
    { const int cb = l * 384 + 64 * h + 8 * kg; float wa[8], av[8];
      *(f32x4*)&wa[0] = *(const LAS f32x4*)(LO + t2 * RW_LOS + 8 * kg); *(f32x4*)&wa[4] = *(const LAS f32x4*)(LO + t2 * RW_LOS + 8 * kg + 4);
      *(f32x4*)&av[0] = *(const LAS f32x4*)(LO + 64 * RW_LOS + t2 * RW_LOS + 8 * kg); *(f32x4*)&av[4] = *(const LAS f32x4*)(LO + 64 * RW_LOS + t2 * RW_LOS + 8 * kg + 4);
      *(f32x4*)&gg[0] = *(const LAS f32x4*)(LO + 128 * RW_LOS + t2 * RW_LOS + 8 * kg); *(f32x4*)&gg[4] = *(const LAS f32x4*)(LO + 128 * RW_LOS + t2 * RW_LOS + 8 * kg + 4);
      float ssq = 0.f, kkr[8];
#pragma unroll
      for (int i = 0; i < 8; ++i) { const float wp = wa[i] + a.in[16][cb + i]; const float w = -log1pf(__expf(-wp)) - 0.5f; lw[i] = -__expf(w);
          const float aa = sigmoidf_(av[i] + a.in[18][cb + i]);
          kkr[i] = kx[i] * a.in[21][cb + i]; ssq += kkr[i] * kkr[i];
          kp[i] = kx[i] * (1.0f + (aa - 1.0f) * a.in[22][cb + i]); be[i] = aa;
          rkt += rr[i] * kp[i] * a.in[23][cb + i]; }
      ssq += __shfl_xor(ssq, 1); ssq += __shfl_xor(ssq, 2); ssq += __shfl_xor(ssq, 4);
      rkt += __shfl_xor(rkt, 1); rkt += __shfl_xor(rkt, 2); rkt += __shfl_xor(rkt, 4);
      const float rn = 1.0f / sqrtf(ssq + 1e-12f);
#pragma unroll
      for (int i = 0; i < 8; ++i) { const float kk = kkr[i] * rn; al[i] = -kk; be[i] = kk * be[i]; }
#pragma unroll
      for (int i = 0; i < 8; ++i) CUM[t2 * 64 + 8 * kg + i] = lw[i];
    }
    __syncthreads();
    { const int k = lane, pt = wid; float s = 0.f; float cv[8];
#pragma unroll
      for (int i = 0; i < 8; ++i) { s += CUM[(8 * pt + i) * 64 + k]; cv[i] = s; }
      PART[pt * 64 + k] = s;
      __syncthreads();
      float off = 0.f;
#pragma unroll
      for (int p = 0; p < 8; ++p) { const float v = PART[p * 64 + k]; if (p < pt) off += v; }
#pragma unroll
      for (int i = 0; i < 8; ++i) CUM[(8 * pt + i) * 64 + k] = cv[i] + off;
    }
    __syncthreads();
    { float cu[8], cl[8], e[8];
      *(f32x4*)&cu[0] = *(const LAS f32x4*)(CUM + t2 * 64 + 8 * kg); *(f32x4*)&cu[4] = *(const LAS f32x4*)(CUM + t2 * 64 + 8 * kg + 4);
      *(f32x4*)&cl[0] = *(const LAS f32x4*)(CUM + 63 * 64 + 8 * kg); *(f32x4*)&cl[4] = *(const LAS f32x4*)(CUM + 63 * 64 + 8 * kg + 4);
#pragma unroll
      for (int i = 0; i < 8; ++i) e[i] = al[i] * __expf(cu[i] - lw[i]);
      *(LAS u32x4*)(AT + t2 * LST + 8 * kg) = pack8(e);
      float en[8];
#pragma unroll
      for (int i = 0; i < 8; ++i) en[i] = __expf(-cu[i]);
#pragma unroll
      for (int i = 0; i < 8; ++i) e[i] = be[i] * en[i];
      *(LAS u32x4*)(BD + t2 * LST + 8 * kg) = pack8(e);
#pragma unroll
      for (int i = 0; i < 8; ++i) e[i] = kp[i] * en[i];
      *(LAS u32x4*)(KD + t2 * LST + 8 * kg) = pack8(e);
      if (MODE == 1) {
#pragma unroll
          for (int i = 0; i < 8; ++i) e[i] = rr[i] * __expf(cu[i]);
          *(LAS u32x4*)(RT + t2 * LST + 8 * kg) = pack8(e);
      } else {
#pragma unroll
          for (int i = 0; i < 8; ++i) { const float ed = __expf(cl[i] - cu[i]); BTT[(8 * kg + i) * LST + t2] = (bf16_t)f2bf(be[i] * ed); KTT[(8 * kg + i) * LST + t2] = (bf16_t)f2bf(kp[i] * ed); }
          if (t2 == 63) {
#pragma unroll
              for (int i = 0; i < 8; ++i) ((float*)(a.ws + WS_RGAM))[(size_t)item * 64 + 8 * kg + i] = __expf(cl[i]); }
      }
#pragma unroll
      for (int i = 0; i < 8; ++i) VT[(8 * kg + i) * LST + t2] = (bf16_t)f2bf(vx[i]);
    }
    __syncthreads();
    { const int tt = wid >> 1;
#pragma unroll
      for (int q = 0; q < 2; ++q) { const int st = 2 * (wid & 1) + q;
          f32x4 ab = {0.f, 0.f, 0.f, 0.f}, ak = {0.f, 0.f, 0.f, 0.f}, rb = {0.f, 0.f, 0.f, 0.f}, rk = {0.f, 0.f, 0.f, 0.f};
          if (st <= tt) {
#pragma unroll
              for (int ks = 0; ks < 2; ++ks) { const int ao = (16 * st + fr) * LST + 32 * ks + 8 * fq, bo = (16 * tt + fr) * LST + 32 * ks + 8 * fq;
                  const bf16x8 xb = *(const LAS bf16x8*)(BD + ao), xk = *(const LAS bf16x8*)(KD + ao), ya = *(const LAS bf16x8*)(AT + bo);
                  ab = mfma16(xb, ya, ab); ak = mfma16(xk, ya, ak);
                  if (MODE == 1) { const bf16x8 yr = *(const LAS bf16x8*)(RT + bo); rb = mfma16(xb, yr, rb); rk = mfma16(xk, yr, rk); } }
              const int t = 16 * tt + fr;
#pragma unroll
              for (int j = 0; j < 4; ++j) { const int s = 16 * st + 4 * fq + j; if (s >= t) { ab[j] = 0.f; ak[j] = 0.f; } if (s > t) { rb[j] = 0.f; rk[j] = 0.f; } }
              if (st == tt) *(LAS f32x4*)(NABF + tt * 256 + fr * 16 + 4 * fq) = ab;
          }
          const int o = (16 * tt + fr) * LST + 16 * st + 4 * fq;
          *(LAS s16x4*)(NAB + o) = pack4(ab); *(LAS s16x4*)(AK + o) = pack4(ak);
          if (MODE == 1) { *(LAS s16x4*)(ARB + o) = pack4(rb); *(LAS s16x4*)(ARK + o) = pack4(rk); } }
    }
    __syncthreads();
    f32x4 R[4];
    if (wid == 0) { const int blk = fq, j = fr; float Tc[16];
#pragma unroll
        for (int i = 0; i < 16; ++i) { float acc = (i == j) ? 1.0f : 0.0f;
#pragma unroll
            for (int m = 0; m < 16; ++m) if (m < i) acc += NABF[blk * 256 + i * 16 + m] * Tc[m];
            Tc[i] = acc; TII[blk * 256 + i * 16 + j] = (bf16_t)f2bf(acc); }
    }
    if (wid >= 4) { const int vt = wid - 4;
#pragma unroll
        for (int I = 0; I < 4; ++I) { f32x4 acc = {0.f, 0.f, 0.f, 0.f};
#pragma unroll
            for (int ks = 0; ks < 2; ++ks) { const bf16x8 x = *(const LAS bf16x8*)(AK + (16 * I + fr) * LST + 32 * ks + 8 * fq), y = *(const LAS bf16x8*)(VT + (16 * vt + fr) * LST + 32 * ks + 8 * fq); acc = mfma16(x, y, acc); }
            R[I] = acc; }
    } else {
#pragma unroll
        for (int I = 0; I < 4; ++I)
#pragma unroll
            for (int j = 0; j < 4; ++j) R[I][j] = bf2f(AT[(16 * I + 4 * fq + j) * LST + 16 * wid + fr]);
    }
    __syncthreads();
    s16x4 Xb[4];
#pragma unroll
    for (int I = 0; I < 4; ++I) { f32x4 acc = R[I];
#pragma unroll
        for (int J = 0; J < 4; ++J) if (J < I) acc = mfma16k16(*(const LAS s16x4*)(NAB + (16 * I + fr) * LST + 16 * J + 4 * fq), Xb[J], acc);
        const f32x4 z = {0.f, 0.f, 0.f, 0.f};
        const f32x4 x = mfma16k16(*(const LAS s16x4*)(TII + I * 256 + fr * 16 + 4 * fq), pack4(acc), z);
        Xb[I] = pack4(x); }
    s16x4 Vf[4];
    if (wid >= 4) {
#pragma unroll
        for (int J = 0; J < 4; ++J) Vf[J] = *(const LAS s16x4*)(VT + (16 * (wid - 4) + fr) * LST + 16 * J + 4 * fq); }
    if (MODE == 0) {
#pragma unroll
        for (int kt = 0; kt < 4; ++kt) { f32x4 acc = {0.f, 0.f, 0.f, 0.f};
#pragma unroll
            for (int J = 0; J < 4; ++J) acc = mfma16k16(*(const LAS s16x4*)(BTT + (16 * kt + fr) * LST + 16 * J + 4 * fq), Xb[J], acc);
            if (wid >= 4) {
#pragma unroll
                for (int J = 0; J < 4; ++J) acc = mfma16k16(*(const LAS s16x4*)(KTT + (16 * kt + fr) * LST + 16 * J + 4 * fq), Vf[J], acc);
                *(s16x4*)((bf16_t*)(a.ws + WS_RN) + (size_t)item * 4096 + ((kt * 4 + (wid - 4)) * 64 + lane) * 4) = pack4(acc);
            } else { bf16_t* RM = (bf16_t*)(a.ws + WS_RM) + (size_t)item * 4096;
#pragma unroll
                for (int j = 0; j < 4; ++j) RM[(16 * kt + 4 * fq + j) * 64 + 16 * wid + fr] = (bf16_t)f2bf(acc[j]); } }
        __syncthreads();
    } else {
        LAS bf16_t* RH = (LAS bf16_t*)(lds + RW_RH); LAS float* YL = (LAS float*)(lds + RW_YL);
        f32x4 yh[4];
#pragma unroll
        for (int tt = 0; tt < 4; ++tt) { f32x4 acc = {0.f, 0.f, 0.f, 0.f};
            if (wid < 4) {
#pragma unroll
                for (int j = 0; j < 4; ++j) acc[j] = bf2f(RT[(16 * tt + 4 * fq + j) * LST + 16 * wid + fr]); }
#pragma unroll
            for (int J = 0; J < 4; ++J) if (J <= tt) acc = mfma16k16(*(const LAS s16x4*)(ARB + (16 * tt + fr) * LST + 16 * J + 4 * fq), Xb[J], acc);
            if (wid >= 4) {
#pragma unroll
                for (int J = 0; J < 4; ++J) if (J <= tt) acc = mfma16k16(*(const LAS s16x4*)(ARK + (16 * tt + fr) * LST + 16 * J + 4 * fq), Vf[J], acc);
                yh[tt] = acc;
            } else {
#pragma unroll
                for (int j = 0; j < 4; ++j) RH[(16 * tt + 4 * fq + j) * LST + 16 * wid + fr] = (bf16_t)f2bf(acc[j]); } }
        __syncthreads();
        if (wid >= 4) { const int vt = wid - 4; s16x4 S0[4];
#pragma unroll
            for (int kt = 0; kt < 4; ++kt) S0[kt] = *(const s16x4*)((const bf16_t*)(a.ws + WS_RN) + (size_t)item * 4096 + ((kt * 4 + vt) * 64 + lane) * 4);
#pragma unroll
            for (int tt = 0; tt < 4; ++tt) { f32x4 acc = yh[tt];
#pragma unroll
                for (int kt = 0; kt < 4; ++kt) acc = mfma16k16(*(const LAS s16x4*)(RH + (16 * tt + fr) * LST + 16 * kt + 4 * fq), S0[kt], acc);
#pragma unroll
                for (int j = 0; j < 4; ++j) YL[(16 * tt + 4 * fq + j) * RW_YLS + 16 * vt + fr] = acc[j]; } }
        __syncthreads();
        { const int cb = l * 384 + 64 * h + 8 * kg; float y[8];
          *(f32x4*)&y[0] = *(const LAS f32x4*)(YL + t2 * RW_YLS + 8 * kg); *(f32x4*)&y[4] = *(const LAS f32x4*)(YL + t2 * RW_YLS + 8 * kg + 4);
          float sm = 0.f;
#pragma unroll
          for (int i = 0; i < 8; ++i) sm += y[i];
          sm += __shfl_xor(sm, 1); sm += __shfl_xor(sm, 2); sm += __shfl_xor(sm, 4);
          const float mean = sm * (1.0f / 64.0f); float vr = 0.f;
#pragma unroll
          for (int i = 0; i < 8; ++i) { y[i] -= mean; vr += y[i] * y[i]; }
          vr += __shfl_xor(vr, 1); vr += __shfl_xor(vr, 2); vr += __shfl_xor(vr, 4);
          const float rs = 1.0f / sqrtf(vr * (1.0f / 64.0f) + 64e-5f); float o[8];
#pragma unroll
          for (int i = 0; i < 8; ++i) o[i] = ((y[i] * rs * a.in[24][cb + i] + a.in[25][cb + i]) + rkt * vx[i]) * gg[i] * a.in[26][l * 1024 + 640 + 64 * h + 8 * kg + i];
          *(u32x4*)((bf16_t*)(a.ws + WS_HY) + row * D_ + 640 + 64 * h + 8 * kg) = pack8(o); }
        __syncthreads();
    }
}
__device__ __forceinline__ void rwkv_scan(const Args& a, int bh, int vt, int lane) {
    const int fr = lane & 15, fq = lane >> 4;
    const bf16_t* RM = (const bf16_t*)(a.ws + WS_RM); bf16_t* RN = (bf16_t*)(a.ws + WS_RN); const float* GAM = (const float*)(a.ws + WS_RGAM);
    f32x4 S[4];
#pragma unroll
    for (int k = 0; k < 4; ++k) S[k] = (f32x4){0.f, 0.f, 0.f, 0.f};
#pragma unroll 1
    for (int c = 0; c < 32; ++c) { const size_t item = (size_t)bh * 32 + c;
        s16x4 Mf[4][4]; s16x4 Nf[4]; f32x4 gam[4];
#pragma unroll
        for (int kt = 0; kt < 4; ++kt) {
#pragma unroll
            for (int k2 = 0; k2 < 4; ++k2) Mf[kt][k2] = *(const s16x4*)(RM + item * 4096 + (16 * kt + fr) * 64 + 16 * k2 + 4 * fq);
            Nf[kt] = *(const s16x4*)(RN + item * 4096 + ((kt * 4 + vt) * 64 + lane) * 4);
            gam[kt] = *(const f32x4*)(GAM + item * 64 + 16 * kt + 4 * fq); }
        s16x4 Sb[4];
#pragma unroll
        for (int k = 0; k < 4; ++k) { Sb[k] = pack4(S[k]); *(s16x4*)(RN + item * 4096 + ((k * 4 + vt) * 64 + lane) * 4) = Sb[k]; }
#pragma unroll
        for (int kt = 0; kt < 4; ++kt) { const u32x2 nw = __builtin_bit_cast(u32x2, Nf[kt]);
            f32x4 acc = gam[kt] * S[kt] + (f32x4){bflo(nw.x), bfhi(nw.x), bflo(nw.y), bfhi(nw.y)};
#pragma unroll
            for (int k2 = 0; k2 < 4; ++k2) acc = mfma16k16(Mf[kt][k2], Sb[k2], acc);
            S[kt] = acc; }
    }
}
__device__ __forceinline__ float shiftmix(const bf16_t* P, size_t row, int tglob, int col, float mu) {
    const float cur = bf2f(P[row * PS_ + PC + col]); const float prev = (tglob > 0) ? bf2f(P[(row - 1) * PS_ + PC + col]) : 0.f; return cur + (prev - cur) * mu; }
__device__ __forceinline__ void rwkv_seq(const Args& a, int l, int bh, LAS unsigned char* lds) {
    const int tid = otid(), wid = tid >> 6, lane = tid & 63, h = bh % 6, b = bh / 6;
    const bf16_t* P = (const bf16_t*)(a.ws + WS_P); bf16_t* Y = (bf16_t*)(a.ws + WS_HY);
    LAS float* LIN = (LAS float*)lds;
    LAS float* VEC = (LAS float*)(lds + 32768);
    LAS float* YL = (LAS float*)(lds + 90112);
    const float* mu = a.in[15] + l * 1408;
    float S[64];
#pragma unroll
    for (int k = 0; k < 64; ++k) S[k] = 0.f;
    const int t = tid >> 4, jg = tid & 15;
#pragma unroll 1
    for (int tb = 0; tb < T_; tb += 32) {
        const size_t row = (size_t)b * T_ + tb + t; const int tglob = tb + t;
#pragma unroll 4
        for (int i = 0; i < 16; ++i) { const int col = 16 * jg + i; const float ps = shiftmix(P, row, tglob, 1152 + col, mu[1152 + col]);
            float v; if (col < 64) { const float e = __expf(2.0f * ps); v = 1.0f - 2.0f / (e + 1.0f); } else if (col < 128) v = ps; else v = sigmoidf_(ps);
            LIN[t * 256 + col] = v; }
        __syncthreads();
        { const int cb = l * 384 + 64 * h + 4 * jg;
          f32x4 wacc = *(const f32x4*)(a.in[16] + cb), aacc = *(const f32x4*)(a.in[18] + cb), gacc = {0.f, 0.f, 0.f, 0.f};
          const float* wu = a.in[17] + (size_t)l * 64 * 384 + 64 * h + 4 * jg; const float* au = a.in[19] + (size_t)l * 64 * 384 + 64 * h + 4 * jg; const float* gu = a.in[20] + (size_t)l * 128 * 384 + 64 * h + 4 * jg;
#pragma unroll 4
          for (int i = 0; i < 64; ++i) { const float x = LIN[t * 256 + i]; wacc += x * *(const f32x4*)(wu + (size_t)i * 384); }
#pragma unroll 4
          for (int i = 0; i < 64; ++i) { const float x = LIN[t * 256 + 64 + i]; aacc += x * *(const f32x4*)(au + (size_t)i * 384); }
#pragma unroll 4
          for (int i = 0; i < 128; ++i) { const float x = LIN[t * 256 + 128 + i]; gacc += x * *(const f32x4*)(gu + (size_t)i * 384); }
          float kk[4], kp[4], aa[4], dec[4], rr[4], vv[4]; float ssq = 0.f;
#pragma unroll
          for (int j = 0; j < 4; ++j) { const int hc = 64 * h + 4 * jg + j;
              const float wp = wacc[j]; const float w = -log1pf(__expf(-wp)) - 0.5f; dec[j] = __expf(-__expf(w));
              aa[j] = sigmoidf_(aacc[j]);
              rr[j] = shiftmix(P, row, tglob, hc, mu[hc]); const float kx = shiftmix(P, row, tglob, 384 + hc, mu[384 + hc]); vv[j] = shiftmix(P, row, tglob, 768 + hc, mu[768 + hc]);
              kk[j] = kx * a.in[21][l * 384 + hc]; ssq += kk[j] * kk[j];
              kp[j] = kx * (1.0f + (aa[j] - 1.0f) * a.in[22][l * 384 + hc]); }
          ssq += __shfl_xor(ssq, 1); ssq += __shfl_xor(ssq, 2); ssq += __shfl_xor(ssq, 4); ssq += __shfl_xor(ssq, 8);
          const float rn = 1.0f / sqrtf(ssq + 1e-12f);
#pragma unroll
          for (int j = 0; j < 4; ++j) { const int jj = 4 * jg + j; const float kn = kk[j] * rn;
              VEC[(t * 7 + 0) * 64 + jj] = kn; VEC[(t * 7 + 1) * 64 + jj] = dec[j]; VEC[(t * 7 + 2) * 64 + jj] = kp[j]; VEC[(t * 7 + 3) * 64 + jj] = kn * aa[j];
              VEC[(t * 7 + 4) * 64 + jj] = rr[j]; VEC[(t * 7 + 5) * 64 + jj] = vv[j]; VEC[(t * 7 + 6) * 64 + jj] = gacc[j]; } }
        __syncthreads();
        if (wid == 0) {
#pragma unroll 1
            for (int ts = 0; ts < 32; ++ts) { const LAS f32x4* V4 = (const LAS f32x4*)(VEC + ts * 7 * 64);
                const float vv = VEC[(ts * 7 + 5) * 64 + lane]; float sa = 0.f;
#pragma unroll
                for (int k4 = 0; k4 < 16; ++k4) { const f32x4 q = V4[k4]; sa += S[4 * k4] * q.x; sa += S[4 * k4 + 1] * q.y; sa += S[4 * k4 + 2] * q.z; sa += S[4 * k4 + 3] * q.w; }
                sa = -sa; float y = 0.f;
#pragma unroll
                for (int k4 = 0; k4 < 16; ++k4) { const f32x4 w = V4[16 + k4], kp = V4[32 + k4], ka = V4[48 + k4], r = V4[64 + k4];
                    S[4 * k4] = S[4 * k4] * w.x + sa * ka.x + vv * kp.x; S[4 * k4 + 1] = S[4 * k4 + 1] * w.y + sa * ka.y + vv * kp.y;
                    S[4 * k4 + 2] = S[4 * k4 + 2] * w.z + sa * ka.z + vv * kp.z; S[4 * k4 + 3] = S[4 * k4 + 3] * w.w + sa * ka.w + vv * kp.w;
                    y += S[4 * k4] * r.x; y += S[4 * k4 + 1] * r.y; y += S[4 * k4 + 2] * r.z; y += S[4 * k4 + 3] * r.w; }
                YL[ts * 64 + lane] = y; }
        }
        __syncthreads();
        { const int cb = l * 384 + 64 * h + 4 * jg; const f32x4 y4 = *(const LAS f32x4*)(YL + t * 64 + 4 * jg);
          float sm = (y4.x + y4.y) + (y4.z + y4.w); sm += __shfl_xor(sm, 1); sm += __shfl_xor(sm, 2); sm += __shfl_xor(sm, 4); sm += __shfl_xor(sm, 8);
          const float mean = sm * (1.0f / 64.0f); const f32x4 d = y4 - mean;
          float vr = (d.x * d.x + d.y * d.y) + (d.z * d.z + d.w * d.w); vr += __shfl_xor(vr, 1); vr += __shfl_xor(vr, 2); vr += __shfl_xor(vr, 4); vr += __shfl_xor(vr, 8);
          const float rs = 1.0f / sqrtf(vr * (1.0f / 64.0f) + 64e-5f);
          const f32x4 rk = *(const f32x4*)(a.in[23] + cb), lw = *(const f32x4*)(a.in[24] + cb), lb = *(const f32x4*)(a.in[25] + cb), be = *(const f32x4*)(a.in[26] + l * 1024 + 640 + 64 * h + 4 * jg);
          float bs = 0.f; float r4[4], v4[4], g4[4];
#pragma unroll
          for (int j = 0; j < 4; ++j) { const int jj = 4 * jg + j; r4[j] = VEC[(t * 7 + 4) * 64 + jj]; v4[j] = VEC[(t * 7 + 5) * 64 + jj]; g4[j] = VEC[(t * 7 + 6) * 64 + jj]; bs += r4[j] * VEC[(t * 7 + 2) * 64 + jj] * rk[j]; }
          bs += __shfl_xor(bs, 1); bs += __shfl_xor(bs, 2); bs += __shfl_xor(bs, 4); bs += __shfl_xor(bs, 8);
          float o[4];
#pragma unroll
          for (int j = 0; j < 4; ++j) o[j] = ((d[j] * rs * lw[j] + lb[j]) + bs * v4[j]) * g4[j] * be[j];
          u32x2 w2; w2.x = pk2(o[0], o[1]); w2.y = pk2(o[2], o[3]);
          *(u32x2*)(Y + row * D_ + 640 + 64 * h + 4 * jg) = w2; }
        __syncthreads();
    }
}
__global__ void __launch_bounds__(512, 2) mk_fwd(Args a) {
    extern __shared__ __attribute__((aligned(16))) unsigned char shm[];
    LAS unsigned char* lds = (LAS unsigned char*)shm;
    cg::grid_group grid = cg::this_grid();
    const int tid = otid(), wid = tid >> 6, lane = tid & 63, G = gridDim.x;
    unsigned char* ws = a.ws;
    bf16_t* Pb = (bf16_t*)(ws + WS_P); bf16_t* HY = (bf16_t*)(ws + WS_HY); float* MOD = (float*)(ws + WS_MOD);
#ifdef MK_PROBE
    unsigned long long t_prev = __builtin_amdgcn_s_memrealtime(), t_acc = 0;
#define PH_STAMP(n) { grid.sync(); const unsigned long long t_now = __builtin_amdgcn_s_memrealtime(); if ((MK_PROBE >> (n)) & 1) t_acc += t_now - t_prev; t_prev = t_now; }
#else
#define PH_STAMP(n)
#endif
#define PH_BEGIN(n) if (a.ph_lo <= (n) && (n) < a.ph_hi) { const int ph_cur = (n); (void)ph_cur; if ((n) > a.ph_lo) grid.sync();
#define PH_END PH_STAMP(ph_cur) }
    PH_BEGIN(0) phase_pro(a, lds); PH_END
#pragma unroll
    for (int l = 0; l < 2; ++l) {
        const int p0 = 1 + 9 * l;
        const float* xin = (l == 0) ? a.in[0] : a.out;
        const float* modl = MOD + (size_t)l * 8 * 6144;
        PH_BEGIN(p0 + 0) phase_norm(xin, a.in[2] + l * D_, modl + 0, modl + 1024, HY); PH_END
        PH_BEGIN(p0 + 1) { pg8::Gemm g{HY, (const bf16_t*)(ws + WS_WIN + l * SZ_WIN), M_, PS_, D_}; pg8::StaticOrder S; S.init(M_, PS_, G, blockIdx.x); EpiP E{Pb, PS_};
                  pg8::gemm_phase<EpiP, pg8::StaticOrder>(lds, g, S, E, nullptr); } PH_END
        PH_BEGIN(p0 + 2) { for (int it = blockIdx.x; it < 1536; it += G) hgrn_item<0>(a, l, it, lds);
                  for (int it = blockIdx.x; it < 1536; it += G) rwkv_chunk<0>(a, l, it, lds);
                  for (int it = blockIdx.x * 8 + (otid() >> 6); it < 1024; it += G * 8) rg_item<0>(a, l, it, otid() & 63); } PH_END
        PH_BEGIN(p0 + 3) { const int t3 = otid();
                  if (t3 < 64) { if ((int)blockIdx.x < 192) rwkv_scan(a, blockIdx.x >> 2, blockIdx.x & 3, t3); }
                  else { for (int e = blockIdx.x * 448 + (t3 - 64); e < 48 * 4096; e += G * 448) hgrn_scan(a, e);
                         for (int e = blockIdx.x * 448 + (t3 - 64); e < 2048; e += G * 448) rg_carry(a, e); } } PH_END
        PH_BEGIN(p0 + 4) { for (int it = blockIdx.x; it < 1536; it += G) hgrn_item<1>(a, l, it, lds);
                  for (int it = blockIdx.x; it < 1536; it += G) rwkv_chunk<1>(a, l, it, lds);
                  for (int it = blockIdx.x * 8 + (otid() >> 6); it < 1024; it += G * 8) rg_item<1>(a, l, it, otid() & 63); } PH_END
        PH_BEGIN(p0 + 5) { pg8::Gemm g{HY, (const bf16_t*)(ws + WS_WOUT + l * SZ_WOUT), M_, D_, D_}; pg8::StaticOrder S; S.init(M_, D_, G, blockIdx.x); EpiRes E{xin, a.out, modl + 2048};
                  pg8::gemm_phase<EpiRes, pg8::StaticOrder>(lds, g, S, E, nullptr); } PH_END
        PH_BEGIN(p0 + 6) phase_norm(a.out, a.in[3] + l * D_, modl + 3072, modl + 4096, HY); PH_END
        PH_BEGIN(p0 + 7) { pg8::Gemm g{HY, (const bf16_t*)(ws + WS_WGU + l * SZ_WGU), M_, NGU_, D_}; pg8::StaticOrder S; S.init(M_, NGU_, G, blockIdx.x); EpiSwi E{Pb};
                  pg8::gemm_phase<EpiSwi, pg8::StaticOrder>(lds, g, S, E, nullptr); } PH_END
        PH_BEGIN(p0 + 8) { pg8::Gemm g{Pb, (const bf16_t*)(ws + WS_WD + l * SZ_WD), M_, D_, FF_}; pg8::StaticOrder S; S.init(M_, D_, G, blockIdx.x); EpiRes E{a.out, a.out, modl + 5120};
                  pg8::gemm_phase<EpiRes, pg8::StaticOrder>(lds, g, S, E, nullptr); } PH_END
    }
    PH_BEGIN(19) phase_final(a.out, a.in[31]); PH_END
#ifdef MK_PROBE
    if (blockIdx.x == 0 && threadIdx.x == 0) a.out[0] = (float)t_acc * 0.01f;
#endif
}
#ifndef MK_MULTI
#define MK_MULTI 0
#endif
extern "C" void kernel_launch(void* const* d_in, const int* in_sizes, int n_in, void* d_out, int out_size, void* d_ws, size_t ws_size, hipStream_t stream) {
    static int grid = 0;
    if (!grid) {
        if (n_in != 32 || ws_size < WS_END) { fprintf(stderr, "kernel_launch: bad args n_in %d ws %zu need %zu\n", n_in, ws_size, (size_t)WS_END); return; }
        hipFuncSetAttribute((const void*)mk_fwd, hipFuncAttributeMaxDynamicSharedMemorySize, LDS_BYTES);
        int dev = 0, cus = 0, per_cu = 0; hipGetDevice(&dev); hipDeviceGetAttribute(&cus, hipDeviceAttributeMultiprocessorCount, dev);
        hipOccupancyMaxActiveBlocksPerMultiprocessor(&per_cu, mk_fwd, 512, LDS_BYTES);
        if (per_cu < 1) { fprintf(stderr, "kernel_launch: occupancy 0\n"); per_cu = 1; }
        grid = cus;
    }
    Args a{}; for (int i = 0; i < 32; ++i) a.in[i] = (const float*)d_in[i];
    a.out = (float*)d_out; a.ws = (unsigned char*)d_ws;
#if MK_MULTI
    for (int ph = 0; ph < 20; ++ph) { a.ph_lo = ph; a.ph_hi = ph + 1; hipLaunchKernelGGL(mk_fwd, dim3(grid), dim3(512), LDS_BYTES, stream, a); }
#else
    a.ph_lo = 0; a.ph_hi = 20; void* args[] = {&a};
    hipError_t e = hipLaunchCooperativeKernel((const void*)mk_fwd, dim3(grid), dim3(512), args, LDS_BYTES, stream);
    if (e != hipSuccess) fprintf(stderr, "cooperative launch failed: %s (grid %d)\n", hipGetErrorString(e), grid);
#endif
}
```

```cpp
#include <hip/hip_runtime.h>
#include <hip/hip_cooperative_groups.h>
#include <cstdio>
#include <cstdint>
namespace cg = cooperative_groups;
__device__ __forceinline__ int otid() { int t = threadIdx.x; asm volatile("" : "+v"(t)); return t; }
namespace pg8 {
#define PG8_LAS __attribute__((address_space(3)))
typedef unsigned short bf16_t;
typedef short bf16x8 __attribute__((ext_vector_type(8)));
typedef float f32x4 __attribute__((ext_vector_type(4)));
typedef unsigned u32x4 __attribute__((ext_vector_type(4)));
constexpr int BM = 256, BK = 64, HALF = 128, HTB = HALF * BK * 2  , STAGE_BYTES = 8 * HTB, NXCD = 8, WGM = 8;

__host__ __device__ __forceinline__ int lds_byte(int r, int c) { const int st = (r >> 4) * 2 + (c >> 5), rr = r & 15, cc = c & 31, ob = rr * 64 + cc * 2; return st * 1024 + (ob ^ (((ob >> 9) & 1) << 5)); }
__host__ __device__ __forceinline__ void stage_rc(int b, int& R, int& C) { const int st = b / 1024, sb = b % 1024, swz = sb ^ (((sb >> 9) & 1) << 5); R = (st >> 1) * 16 + swz / 64; C = (st & 1) * 32 + (swz % 64) / 2; }
__host__ __device__ __forceinline__ int perm32(int rho) { const int n = rho >> 4, i = rho & 15; return 8 * (i >> 2) + 4 * n + (i & 3); }

struct Unit { int pm, pn; };
struct Gemm { const bf16_t* A; const bf16_t* Bt; int M, N, K; };

struct StaticOrder {
    int nM, nN, nwg, G, c;
    __host__ __device__ void init(int M, int N, int G_, int c_) { nM = M / BM; nN = N / BM; nwg = nM * nN; G = G_; c = c_; }
    __host__ __device__ bool next(int i, Unit& u) const {
        const long L = (long)i * G + c; if (L >= nwg) return false;
        int wgid = (int)L; { const int q = nwg / NXCD, r = nwg % NXCD, xcd = wgid % NXCD, off = wgid / NXCD; wgid = (xcd < r ? xcd * (q + 1) : r * (q + 1) + (xcd - r) * q) + off; }
        const int nig = WGM * nN, gid = wgid / nig, fm = gid * WGM, gsz = (nM - fm) < WGM ? (nM - fm) : WGM;
        u.pm = fm + ((wgid % nig) % gsz); u.pn = (wgid % nig) / gsz; return true;
    }
    __device__ __forceinline__ void a_ready(const Unit&) const {}
    __device__ __forceinline__ void done(const Unit&) const {}
};
__device__ __forceinline__ unsigned cvt_pk_bf16(float lo, float hi) { unsigned r; asm volatile("v_cvt_pk_bf16_f32 %0, %1, %2" : "=v"(r) : "v"(lo), "v"(hi)); return r; }
template <class Epi, class Sched, bool STAMP = false>
__device__ __forceinline__ void gemm_phase(PG8_LAS unsigned char* lds, const Gemm g, const Sched& S, const Epi& E, unsigned long long* stamps) {
    const int tid = otid(), wid = __builtin_amdgcn_readfirstlane(tid >> 6), lane = tid & 63, wr = wid >> 2, wc = wid & 3, fr = lane & 15, fq = lane >> 4;
    const int K = g.K, nt = K / BK;
    unsigned voffA[2], voffB[2];
#pragma unroll
    for (int i = 0; i < 2; ++i) { int R, C; stage_rc(tid * 16 + i * 8192, R, C); const int Rb = Epi::PERM ? ((R & ~31) + perm32(R & 31)) : R;
        voffA[i] = (unsigned)(R * K + C) * 2u; voffB[i] = (unsigned)(Rb * K + C) * 2u; }
    const size_t kstep = (size_t)(BK * 2);
    const size_t hstep = (size_t)HALF * K * 2;
    const size_t tstep = 2 * hstep;
    const unsigned ldsw = (unsigned)wid * 1024u;
    const int aoff = lds_byte(wr * 64 + fr, fq * 8), boff = lds_byte(wc * 32 + fr, fq * 8);
#define PG8_SA(b, h) (((b) * 2 + (h)) * HTB)
#define PG8_SB(b, h) ((4 + (b) * 2 + (h)) * HTB)
#define PG8_STAGE(bufoff, gbase, voff) do { _Pragma("unroll") for (int _i = 0; _i < 2; ++_i) \
        __builtin_amdgcn_global_load_lds((const unsigned*)((const char*)(gbase) + (voff)[_i]), (PG8_LAS unsigned*)(lds + (bufoff) + ldsw + _i * 8192), 16, 0, 0); } while (0)
#define PG8_LDA(dst, b, h) do { _Pragma("unroll") for (int m = 0; m < 4; ++m) _Pragma("unroll") for (int k = 0; k < 2; ++k) dst[m][k] = *(const PG8_LAS bf16x8*)(lds + PG8_SA(b, h) + aoff + m * 2048 + k * 1024); } while (0)
#define PG8_LDB(dst, b, h) do { _Pragma("unroll") for (int n = 0; n < 2; ++n) _Pragma("unroll") for (int k = 0; k < 2; ++k) dst[n][k] = *(const PG8_LAS bf16x8*)(lds + PG8_SB(b, h) + boff + n * 2048 + k * 1024); } while (0)
#define PG8_MMA(ai, bj, At, Bt) do { __builtin_amdgcn_s_setprio(1); _Pragma("unroll") for (int m = 0; m < 4; ++m) _Pragma("unroll") for (int n = 0; n < 2; ++n) _Pragma("unroll") for (int k = 0; k < 2; ++k) \
        acc[ai][bj][m][n] = __builtin_amdgcn_mfma_f32_16x16x32_bf16(Bt[n][k], At[m][k], acc[ai][bj][m][n], 0, 0, 0); __builtin_amdgcn_s_setprio(0); } while (0)
#define PG8_WAIT_V(n) asm volatile("s_waitcnt vmcnt(" #n ")" ::: "memory")
#define PG8_WAIT_L(n) asm volatile("s_waitcnt lgkmcnt(" #n ")" ::: "memory")
#define PG8_BAR __builtin_amdgcn_s_barrier()
#define PG8_SCHED __builtin_amdgcn_sched_barrier(0)
    Unit cur, nxt; int ui = 0;
    if (!S.next(0, cur)) return;
    f32x4 acc[2][2][4][2];
#pragma unroll
    for (int a = 0; a < 2; ++a)
#pragma unroll
        for (int b = 0; b < 2; ++b)
#pragma unroll
            for (int m = 0; m < 4; ++m)
#pragma unroll
                for (int n = 0; n < 2; ++n) acc[a][b][m][n] = (f32x4){0.f, 0.f, 0.f, 0.f};
    bf16x8 At[4][2], B0[2][2], B1[2][2];
    const char* cA = (const char*)g.A + (size_t)cur.pm * tstep; const char* cB = (const char*)g.Bt + (size_t)cur.pn * tstep;
    S.a_ready(cur);
    PG8_STAGE(PG8_SB(0, 0), cB, voffB); PG8_STAGE(PG8_SA(0, 0), cA, voffA); PG8_STAGE(PG8_SB(0, 1), cB + hstep, voffB); PG8_STAGE(PG8_SA(0, 1), cA + hstep, voffA);
    if (wr == 1) PG8_BAR;
    PG8_WAIT_V(4); PG8_BAR;
    PG8_STAGE(PG8_SB(1, 0), cB + kstep, voffB); PG8_STAGE(PG8_SA(1, 0), cA + kstep, voffA); PG8_STAGE(PG8_SB(1, 1), cB + hstep + kstep, voffB);
    PG8_WAIT_V(6); PG8_BAR;
    for (;;) {
        const bool has_next = S.next(ui + 1, nxt);
        const char* nA = has_next ? (const char*)g.A + (size_t)nxt.pm * tstep : cA; const char* nB = has_next ? (const char*)g.Bt + (size_t)nxt.pn * tstep : cB;
        for (int t = 0; t < nt; t += 2) {
            const bool last = (t == nt - 2);
            const char* a1 = cA + (size_t)(t + 1) * kstep;
            const char* a2 = last ? nA : cA + (size_t)(t + 2) * kstep; const char* b2 = last ? nB : cB + (size_t)(t + 2) * kstep;
            const char* a3 = a2 + kstep; const char* b3 = b2 + kstep;
            if (last && has_next) S.a_ready(nxt);
            PG8_LDB(B0, 0, 0); PG8_SCHED; PG8_LDA(At, 0, 0); PG8_STAGE(PG8_SA(1, 1), a1 + hstep, voffA);
            PG8_WAIT_L(8); PG8_BAR; PG8_WAIT_L(0); PG8_MMA(0, 0, At, B0); PG8_BAR; PG8_SCHED;
            PG8_LDB(B1, 0, 1); PG8_STAGE(PG8_SB(0, 0), b2, voffB);
            PG8_BAR; PG8_WAIT_L(0); PG8_MMA(0, 1, At, B1); PG8_BAR;
            PG8_LDA(At, 0, 1); PG8_STAGE(PG8_SA(0, 0), a2, voffA);
            PG8_BAR; PG8_WAIT_L(0); PG8_MMA(1, 0, At, B0); PG8_BAR; PG8_SCHED;
            PG8_STAGE(PG8_SB(0, 1), b2 + hstep, voffB);
            PG8_WAIT_V(6); PG8_BAR; PG8_MMA(1, 1, At, B1); PG8_BAR;
            PG8_LDB(B0, 1, 0); PG8_SCHED; PG8_LDA(At, 1, 0); PG8_STAGE(PG8_SA(0, 1), a2 + hstep, voffA);
            PG8_WAIT_L(8); PG8_BAR; PG8_WAIT_L(0); PG8_MMA(0, 0, At, B0); PG8_BAR; PG8_SCHED;
            PG8_LDB(B1, 1, 1); PG8_STAGE(PG8_SB(1, 0), b3, voffB);
            PG8_BAR; PG8_WAIT_L(0); PG8_MMA(0, 1, At, B1); PG8_BAR;
            PG8_LDA(At, 1, 1); PG8_STAGE(PG8_SA(1, 0), a3, voffA);
            PG8_BAR; PG8_WAIT_L(0); PG8_MMA(1, 0, At, B0); PG8_BAR; PG8_SCHED;
            PG8_STAGE(PG8_SB(1, 1), b3 + hstep, voffB);
            PG8_WAIT_V(6); PG8_BAR; PG8_MMA(1, 1, At, B1); PG8_BAR;
        }
        if constexpr (!Epi::AFTER_DRAIN) { E(acc, cur, wr, wc, fr, fq); S.done(cur); }
        if (!has_next) break;
#pragma unroll
        for (int a = 0; a < 2; ++a)
#pragma unroll
            for (int b = 0; b < 2; ++b)
#pragma unroll
                for (int m = 0; m < 4; ++m)
#pragma unroll
                    for (int n = 0; n < 2; ++n) acc[a][b][m][n] = (f32x4){0.f, 0.f, 0.f, 0.f};
        cur = nxt; cA = nA; cB = nB; ++ui;
    }
    PG8_WAIT_V(0);
    if (wr == 0) PG8_BAR;
    PG8_BAR;
    if constexpr (Epi::AFTER_DRAIN) { E.fused(acc, cur, wr, wc, fr, fq, lds, wid, lane); S.done(cur); }
#undef PG8_SA
#undef PG8_SB
#undef PG8_STAGE
#undef PG8_LDA
#undef PG8_LDB
#undef PG8_MMA
#undef PG8_WAIT_V
#undef PG8_WAIT_L
#undef PG8_BAR
#undef PG8_SCHED
}
}
using pg8::bf16_t; using pg8::bf16x8; using pg8::f32x4; using pg8::u32x4;
#define LAS __attribute__((address_space(3)))
typedef float f32x2 __attribute__((ext_vector_type(2)));
typedef unsigned u32x2 __attribute__((ext_vector_type(2)));
typedef short s16x4 __attribute__((ext_vector_type(4)));

constexpr int M_ = 16384, D_ = 1024, T_ = 2048, NB_ = 8, PS_ = 3584, PW_ = 3456, FF_ = 2816, NGU_ = 5632;
constexpr int PAX = 0, PAY = 256, PBQ = 512, PBF = 896, PBV = 1280, PBG = 1664, PC = 2048;
constexpr int LDS_BYTES = 144 * 1024;
constexpr size_t SZ_WIN = (size_t)PS_ * D_ * 2, SZ_WOUT = (size_t)D_ * D_ * 2, SZ_WGU = (size_t)NGU_ * D_ * 2, SZ_WD = (size_t)D_ * FF_ * 2;
constexpr size_t WS_WIN = 0, WS_WOUT = WS_WIN + 2 * SZ_WIN, WS_WGU = WS_WOUT + 2 * SZ_WOUT, WS_WD = WS_WGU + 2 * SZ_WGU;
constexpr size_t WS_MOD = WS_WD + 2 * SZ_WD;
constexpr size_t WS_P = WS_MOD + 2 * 8 * 6144 * 4;
constexpr size_t WS_HY = WS_P + (size_t)M_ * PS_ * 2;
constexpr size_t WS_RGA = WS_HY + (size_t)M_ * D_ * 2;
constexpr size_t WS_HKV = WS_RGA + 3 * 8 * 32 * 256 * 4;
constexpr size_t WS_HDEC = WS_HKV + (size_t)1536 * 4096 * 2;
constexpr size_t WS_RM = WS_HDEC + (size_t)1536 * 64 * 4;
constexpr size_t WS_RN = WS_RM + (size_t)1536 * 4096 * 2;
constexpr size_t WS_RGAM = WS_RN + (size_t)1536 * 4096 * 2;
constexpr size_t WS_LORA = WS_RGAM + (size_t)1536 * 64 * 4;
constexpr size_t WS_BAR = WS_LORA + (size_t)2 * 98304 * 2;
constexpr size_t WS_END = WS_BAR + 16384;

struct Args { const float* in[32]; float* out; unsigned char* ws; int ph_lo, ph_hi; };

__device__ __forceinline__ unsigned f2bf(float f) { unsigned u = __builtin_bit_cast(unsigned, f); return (u + 0x7fffu + ((u >> 16) & 1u)) >> 16; }
__device__ __forceinline__ unsigned pk2(float lo, float hi) { return f2bf(lo) | (f2bf(hi) << 16); }
__device__ __forceinline__ float bf2f(unsigned short b) { return __builtin_bit_cast(float, ((unsigned)b) << 16); }
__device__ __forceinline__ float bflo(unsigned w) { return __builtin_bit_cast(float, w << 16); }
__device__ __forceinline__ float bfhi(unsigned w) { return __builtin_bit_cast(float, w & 0xffff0000u); }
__device__ __forceinline__ float wave_sum(float v) {
#pragma unroll
    for (int o = 1; o < 64; o <<= 1) v += __shfl_xor(v, o);
    return v;
}
__device__ __forceinline__ float sigmoidf_(float x) { return 1.0f / (1.0f + __expf(-x)); }
#define LDS_WAIT() asm volatile("s_waitcnt lgkmcnt(0)" ::: "memory")

struct EpiP {
    static constexpr bool PERM = true, AFTER_DRAIN = false;
    bf16_t* O; int ldc;
    __device__ __forceinline__ void operator()(const f32x4 (&acc)[2][2][4][2], const pg8::Unit& u, int wr, int wc, int fr, int fq) const {
        const int row0 = u.pm * 256 + wr * 64 + fr, col0 = u.pn * 256 + wc * 32 + 8 * fq;
#pragma unroll
        for (int ai = 0; ai < 2; ++ai)
#pragma unroll
            for (int m = 0; m < 4; ++m) { bf16_t* rowp = O + (size_t)(row0 + ai * 128 + m * 16) * ldc + col0;
#pragma unroll
                for (int bj = 0; bj < 2; ++bj) { const f32x4 v0 = acc[ai][bj][m][0], v1 = acc[ai][bj][m][1]; u32x4 w;
                    w.x = pg8::cvt_pk_bf16(v0[0], v0[1]); w.y = pg8::cvt_pk_bf16(v0[2], v0[3]); w.z = pg8::cvt_pk_bf16(v1[0], v1[1]); w.w = pg8::cvt_pk_bf16(v1[2], v1[3]);
                    *(u32x4*)(rowp + bj * 128) = w; } }
    }
};
struct EpiRes {
    static constexpr bool PERM = false, AFTER_DRAIN = false;
    const float* base; float* out; const float* gate;
    __device__ __forceinline__ void operator()(const f32x4 (&acc)[2][2][4][2], const pg8::Unit& u, int wr, int wc, int fr, int fq) const {
        const int row0 = u.pm * 256 + wr * 64 + fr, col0 = u.pn * 256 + wc * 32 + 4 * fq, b = u.pm >> 3;
        f32x4 gv[2][2];
#pragma unroll
        for (int bj = 0; bj < 2; ++bj)
#pragma unroll
            for (int n = 0; n < 2; ++n) gv[bj][n] = *(const f32x4*)(gate + (size_t)b * 6144 + col0 + bj * 128 + n * 16);
#pragma unroll
        for (int ai = 0; ai < 2; ++ai)
#pragma unroll
            for (int m = 0; m < 4; ++m) { const size_t ro = (size_t)(row0 + ai * 128 + m * 16) * 1024 + col0;
#pragma unroll
                for (int bj = 0; bj < 2; ++bj)
#pragma unroll
                    for (int n = 0; n < 2; ++n) { const f32x4 bv = *(const f32x4*)(base + ro + bj * 128 + n * 16);
                        *(f32x4*)(out + ro + bj * 128 + n * 16) = bv + gv[bj][n] * acc[ai][bj][m][n]; } }
    }
};
struct EpiSwi {
    static constexpr bool PERM = true, AFTER_DRAIN = false;
    bf16_t* O;
    __device__ __forceinline__ void operator()(const f32x4 (&acc)[2][2][4][2], const pg8::Unit& u, int wr, int wc, int fr, int fq) const {
        const int row0 = u.pm * 256 + wr * 64 + fr, col0 = u.pn * 128 + wc * 32 + 8 * fq;
#pragma unroll
        for (int ai = 0; ai < 2; ++ai)
#pragma unroll
            for (int m = 0; m < 4; ++m) { bf16_t* rowp = O + (size_t)(row0 + ai * 128 + m * 16) * FF_ + col0; float o[8];
#pragma unroll
                for (int n = 0; n < 2; ++n)
#pragma unroll
                    for (int i = 0; i < 4; ++i) { const float g = acc[ai][0][m][n][i], up = acc[ai][1][m][n][i]; o[4 * n + i] = g * sigmoidf_(g) * up; }
                u32x4 w; w.x = pg8::cvt_pk_bf16(o[0], o[1]); w.y = pg8::cvt_pk_bf16(o[2], o[3]); w.z = pg8::cvt_pk_bf16(o[4], o[5]); w.w = pg8::cvt_pk_bf16(o[6], o[7]);
                *(u32x4*)rowp = w; }
    }
};

__device__ __forceinline__ void transpose_item(const float* W, int K, int N, bf16_t* WT, int mode, LAS float* scr, int item, int lane) {
    const int nblk = N / 32, kb = item / nblk, nb = item % nblk, k0 = 64 * kb, n0 = 32 * nb;
#pragma unroll 8
    for (int i = 0; i < 32; ++i) { const int kk = 2 * i + (lane >> 5); scr[kk * 33 + (lane & 31)] = W[(size_t)(k0 + kk) * N + n0 + (lane & 31)]; }
    LDS_WAIT(); asm volatile("" ::: "memory");
    const int c = lane & 7;
#pragma unroll
    for (int j = 0; j < 4; ++j) { const int nl = (lane >> 3) + 8 * j, n = n0 + nl; const LAS float* s = scr + (8 * c) * 33 + nl;
        const int row = (mode == 0) ? n : (256 * (n >> 7) + (n & 127) + (mode == 2 ? 128 : 0));
        u32x4 o; o.x = pk2(s[0 * 33], s[1 * 33]); o.y = pk2(s[2 * 33], s[3 * 33]); o.z = pk2(s[4 * 33], s[5 * 33]); o.w = pk2(s[6 * 33], s[7 * 33]);
        *(u32x4*)(WT + (size_t)row * K + k0 + 8 * c) = o; }
    LDS_WAIT(); asm volatile("" ::: "memory");
}
__device__ __forceinline__ void phase_pro(const Args& a, LAS unsigned char* lds) {
    const int tid = otid(), wid = tid >> 6, lane = tid & 63;
    unsigned char* ws = a.ws;
    LAS float* CS = (LAS float*)lds;
    LAS float* RED = (LAS float*)(lds + 32768);
    if ((int)blockIdx.x < 192) {
        for (int i = tid; i < 8192; i += 512) { const float cv = a.in[1][i]; CS[i] = cv * sigmoidf_(cv); }
        __syncthreads();
    }
    for (int item = blockIdx.x; item < 192; item += gridDim.x) {
        const int l = item / 96, cgp = item % 96, col = cgp * 64 + lane;
        const float* aw = a.in[4] + (size_t)l * 1024 * 6144;
        float acc[8];
#pragma unroll
        for (int b = 0; b < 8; ++b) acc[b] = 0.f;
        for (int k = wid * 128; k < wid * 128 + 128; ++k) { const float w = aw[(size_t)k * 6144 + col];
#pragma unroll
            for (int b = 0; b < 8; ++b) acc[b] += CS[b * 1024 + k] * w; }
#pragma unroll
        for (int b = 0; b < 8; ++b) RED[(wid * 8 + b) * 64 + lane] = acc[b];
        __syncthreads();
        { const int b = wid; float s = 0.f;
#pragma unroll
          for (int w = 0; w < 8; ++w) s += RED[(w * 8 + b) * 64 + lane];
          ((float*)(ws + WS_MOD))[(size_t)(l * 8 + b) * 6144 + col] = s + a.in[5][l * 6144 + col]; }
        __syncthreads();
    }
    LAS float* scr = (LAS float*)(lds + 65536 + wid * 8448);
    const int gw = blockIdx.x * 8 + wid, NGW = gridDim.x * 8;
    constexpr int I_IN = 16 * (PW_ / 32), I_OUT = 16 * 32, I_G = 16 * (FF_ / 32), I_D = (FF_ / 64) * 32, I_L = I_IN + I_OUT + 2 * I_G + I_D;
    for (int it = gw; it < 2 * I_L; it += NGW) {
        const int l = it / I_L; int r = it % I_L;
        if (r < I_IN) { transpose_item(a.in[6] + (size_t)l * D_ * PW_, D_, PW_, (bf16_t*)(ws + WS_WIN + l * SZ_WIN), 0, scr, r, lane); continue; } r -= I_IN;
        if (r < I_OUT) { transpose_item(a.in[27] + (size_t)l * D_ * D_, D_, D_, (bf16_t*)(ws + WS_WOUT + l * SZ_WOUT), 0, scr, r, lane); continue; } r -= I_OUT;
        if (r < I_G) { transpose_item(a.in[28] + (size_t)l * D_ * FF_, D_, FF_, (bf16_t*)(ws + WS_WGU + l * SZ_WGU), 1, scr, r, lane); continue; } r -= I_G;
        if (r < I_G) { transpose_item(a.in[29] + (size_t)l * D_ * FF_, D_, FF_, (bf16_t*)(ws + WS_WGU + l * SZ_WGU), 2, scr, r, lane); continue; } r -= I_G;
        transpose_item(a.in[30] + (size_t)l * FF_ * D_, FF_, D_, (bf16_t*)(ws + WS_WD + l * SZ_WD), 0, scr, r, lane);
    }
    for (int e = blockIdx.x * 512 + tid; e < 2 * 98304; e += gridDim.x * 512) { const int l = e / 98304; int r = e % 98304; float v;
        if (r < 24576) { const int cidx = r >> 6, i = r & 63; v = a.in[17][((size_t)l * 64 + i) * 384 + cidx]; }
        else if (r < 49152) { const int r2 = r - 24576, cidx = r2 >> 6, i = r2 & 63; v = a.in[19][((size_t)l * 64 + i) * 384 + cidx]; }
        else { const int r2 = r - 49152, cidx = r2 >> 7, i = r2 & 127; v = a.in[20][((size_t)l * 128 + i) * 384 + cidx]; }
        ((bf16_t*)(ws + WS_LORA))[e] = (bf16_t)f2bf(v); }
    for (int i = blockIdx.x * 512 + tid; i < 2 * 16384; i += gridDim.x * 512) { const int l = i >> 14, e = i & 16383;
        *(u32x4*)(ws + WS_WIN + l * SZ_WIN + (size_t)PW_ * D_ * 2 + (size_t)e * 16) = (u32x4){0u, 0u, 0u, 0u}; }
}
__device__ __forceinline__ void phase_norm(const float* xin, const float* gain, const float* sh, const float* sc, bf16_t* H) {
    const int tid = otid(), wid = tid >> 6, lane = tid & 63, gw = blockIdx.x * 8 + wid, NGW = gridDim.x * 8;
    for (int row = gw; row < M_; row += NGW) { const int b = row >> 11;
        const f32x4* xr = (const f32x4*)(xin + (size_t)row * D_) + lane; f32x4 v[4]; float ss = 0.f;
#pragma unroll
        for (int j = 0; j < 4; ++j) { v[j] = xr[64 * j]; ss += (v[j].x * v[j].x + v[j].y * v[j].y) + (v[j].z * v[j].z + v[j].w * v[j].w); }
        const float rs = 1.0f / sqrtf(wave_sum(ss) * (1.0f / D_) + 1e-6f);
#pragma unroll
        for (int j = 0; j < 4; ++j) { const int col = 4 * lane + 256 * j;
            const f32x4 g = *(const f32x4*)(gain + col), s1 = *(const f32x4*)(sc + (size_t)b * 6144 + col), s0 = *(const f32x4*)(sh + (size_t)b * 6144 + col);
            const f32x4 h = v[j] * rs * g * (s1 + 1.0f) + s0;
            u32x2 w; w.x = pk2(h.x, h.y); w.y = pk2(h.z, h.w); *(u32x2*)(H + (size_t)row * D_ + col) = w; }
    }
}
__device__ __forceinline__ void phase_final(float* x, const float* gain) {
    const int tid = otid(), wid = tid >> 6, lane = tid & 63, gw = blockIdx.x * 8 + wid, NGW = gridDim.x * 8;
    for (int row = gw; row < M_; row += NGW) {
        f32x4* xr = (f32x4*)(x + (size_t)row * D_) + lane; f32x4 v[4]; float ss = 0.f;
#pragma unroll
        for (int j = 0; j < 4; ++j) { v[j] = xr[64 * j]; ss += (v[j].x * v[j].x + v[j].y * v[j].y) + (v[j].z * v[j].z + v[j].w * v[j].w); }
        const float rs = 1.0f / sqrtf(wave_sum(ss) * (1.0f / D_) + 1e-6f);
#pragma unroll
        for (int j = 0; j < 4; ++j) { const f32x4 g = *(const f32x4*)(gain + 4 * lane + 256 * j); xr[64 * j] = v[j] * rs * g; }
    }
}
#define XB_TMO      128
#define XB_XCNT(j)  (256  + 64 * (j))
#define XB_XSUB(j)  (1280 + 64 * (j))
#define XB_XGEN(j)  (2304 + 64 * (j))
#define XB_TOP      3328
#define XB_TOPGEN   3392
#define XCD_BAR_WORDS 3456
#define XB_SPIN_CAP (1u << 18)

__device__ __forceinline__ unsigned xb_ld(unsigned* p)              { return __hip_atomic_load(p, __ATOMIC_RELAXED, __HIP_MEMORY_SCOPE_AGENT); }
__device__ __forceinline__ unsigned xb_add(unsigned* p, unsigned v) { return __hip_atomic_fetch_add(p, v, __ATOMIC_RELAXED, __HIP_MEMORY_SCOPE_AGENT); }
__device__ __forceinline__ unsigned xb_xcc_id() { return (unsigned)__builtin_amdgcn_s_getreg((3 << 11) | 20) & 0xFu; }
#define XB_SPIN(cond, bar) do { unsigned _sp = 0; while (cond) { __builtin_amdgcn_s_sleep(1); \
    if ((++_sp & 255u) == 0u) { if (xb_ld(&(bar)[XB_TMO])) break; if (_sp > XB_SPIN_CAP) { atomicAdd(&(bar)[XB_TMO], 1u); break; } } } } while (0)

struct XcdBarrier {
    unsigned* bar; unsigned x;
    volatile LAS unsigned* st;
};

__device__ __forceinline__ XcdBarrier xcd_barrier_post(unsigned* bar, volatile LAS unsigned* st) {
    XcdBarrier b; b.bar = bar; b.x = xb_xcc_id(); b.st = st;
    if (threadIdx.x == 0) (void)xb_add(&bar[XB_XCNT(b.x)], 1u);
    return b;
}
__device__ __forceinline__ void xcd_barrier_complete(unsigned* bar, unsigned x, unsigned& nloc, unsigned& nx) {
    const unsigned G = gridDim.x * gridDim.y * gridDim.z;
    unsigned sum, cnt, mine, sp = 0u;
    for (;;) {
        sum = 0u; cnt = 0u; mine = 0u;
#pragma unroll
        for (unsigned j = 0; j < 16; ++j) { const unsigned c = xb_ld(&bar[XB_XCNT(j)]); sum += c; cnt += (c > 0u) ? 1u : 0u; mine = (j == x) ? c : mine; }
        if (sum == G) break;
        __builtin_amdgcn_s_sleep(1);
        if ((++sp & 255u) == 0u) { if (xb_ld(&bar[XB_TMO])) break; if (sp > XB_SPIN_CAP) { atomicAdd(&bar[XB_TMO], 1u); break; } }
    }
    nloc = mine > 0u ? mine : 1u; nx = cnt > 0u ? cnt : 1u;
}

__device__ __forceinline__ void xcd_barrier(const XcdBarrier& b) {
    asm volatile("s_waitcnt vmcnt(0)" ::: "memory");
    __syncthreads();
    if (threadIdx.x == 0) {
        unsigned* bar = b.bar;
        __builtin_amdgcn_s_waitcnt(0);
        unsigned nloc = b.st[0], nx = b.st[1];
        if (nloc == 0u) { xcd_barrier_complete(bar, b.x, nloc, nx); b.st[0] = nloc; b.st[1] = nx; }
        const unsigned old = xb_add(&bar[XB_XSUB(b.x)], 1u);
        const unsigned gen = old / nloc;
        if (old + 1u == (gen + 1u) * nloc) {
            __builtin_amdgcn_fence(__ATOMIC_RELEASE, "agent");
            asm volatile("s_waitcnt vmcnt(0)" ::: "memory");
            const unsigned og = xb_add(&bar[XB_TOP], 1u);
            const unsigned tg = og / nx;
            if (og + 1u == (tg + 1u) * nx) xb_add(&bar[XB_TOPGEN], 1u);
            else XB_SPIN(xb_ld(&bar[XB_TOPGEN]) == tg, bar);
            __builtin_amdgcn_fence(__ATOMIC_ACQUIRE, "agent");
            xb_add(&bar[XB_XGEN(b.x)], 1u);
            asm volatile("s_waitcnt vmcnt(0)" ::: "memory");
        } else {
            XB_SPIN(xb_ld(&bar[XB_XGEN(b.x)]) == gen, bar);
            __builtin_amdgcn_fence(__ATOMIC_ACQUIRE, "agent");
            asm volatile("s_waitcnt vmcnt(0)" ::: "memory");
        }
    }
    __syncthreads();
}

__device__ __forceinline__ float gelu_tanh(float x) { const float u = 0.7978845608f * (x + 0.044715f * x * x * x); const float e = __expf(2.0f * u); const float th = 1.0f - 2.0f / (e + 1.0f); return 0.5f * x * (1.0f + th); }
template <int MODE>
__device__ __forceinline__ void rg_item(const Args& a, int l, int item, int lane) {
    const int g = item & 3, c = (item >> 2) & 31, b = item >> 7, ch = 64 * g + lane, row0 = b * T_ + 64 * c;
    const bf16_t* P = (const bf16_t*)(a.ws + WS_P);
    float* AGG = (float*)(a.ws + WS_RGA);
    float Wr[64], Wi[64];
#pragma unroll
    for (int i = 0; i < 64; ++i) { Wr[i] = a.in[9][((size_t)(l * 4 + g) * 64 + i) * 64 + lane]; Wi[i] = a.in[11][((size_t)(l * 4 + g) * 64 + i) * 64 + lane]; }
    const float cw0 = a.in[7][(l * 4 + 0) * 256 + ch], cw1 = a.in[7][(l * 4 + 1) * 256 + ch], cw2 = a.in[7][(l * 4 + 2) * 256 + ch], cw3 = a.in[7][(l * 4 + 3) * 256 + ch];
    const float cb = a.in[8][l * 256 + ch], rb = a.in[10][l * 256 + ch], ib = a.in[12][l * 256 + ch], lam = a.in[13][l * 256 + ch];
    const float sp = log1pf(__expf(-lam));
    float xm3 = 0.f, xm2 = 0.f, xm1 = 0.f;
    if (c > 0) { xm3 = bf2f(P[(size_t)(row0 - 3) * PS_ + PAX + ch]); xm2 = bf2f(P[(size_t)(row0 - 2) * PS_ + PAX + ch]); xm1 = bf2f(P[(size_t)(row0 - 1) * PS_ + PAX + ch]); }
    float h = 0.f, Ap = 1.f, beta = 0.f;
    if (MODE == 1) { h = AGG[2 * 65536 + (b * 32 + c) * 256 + ch]; beta = a.in[26][l * 1024 + ch]; }
    bf16_t* Y = (bf16_t*)(a.ws + WS_HY);
    for (int t = 0; t < 64; ++t) {
        const float xc = bf2f(P[(size_t)(row0 + t) * PS_ + PAX + ch]);
        const float u = cb + cw0 * xm3 + cw1 * xm2 + cw2 * xm1 + cw3 * xc;
        xm3 = xm2; xm2 = xm1; xm1 = xc;
        float rp = rb, ip = ib;
#pragma unroll
        for (int i = 0; i < 64; ++i) { const float ui = __builtin_bit_cast(float, __builtin_amdgcn_readlane(__builtin_bit_cast(int, u), i)); rp += ui * Wr[i]; ip += ui * Wi[i]; }
        const float r = sigmoidf_(rp), ig = sigmoidf_(ip);
        const float log_a = -8.0f * r * sp, av = __expf(log_a);
        float mult = sqrtf(-expm1f(2.0f * log_a)); if (c == 0 && t == 0) mult = 1.0f;
        const float bv = mult * ig * u;
        h = av * h + bv;
        if (MODE == 0) Ap *= av;
        else { const float ya = bf2f(P[(size_t)(row0 + t) * PS_ + PAY + ch]); const float y = h * gelu_tanh(ya);
            const float ss = wave_sum(y * y); const float o = y * (1.0f / sqrtf(ss * (1.0f / 64.0f) + 1e-6f)) * beta;
            Y[(size_t)(row0 + t) * D_ + ch] = (bf16_t)f2bf(o); }
    }
    if (MODE == 0) { AGG[(b * 32 + c) * 256 + ch] = Ap; AGG[65536 + (b * 32 + c) * 256 + ch] = h; }
}
__device__ __forceinline__ void rg_carry(const Args& a, int gid) {
    float* AGG = (float*)(a.ws + WS_RGA); const int b = gid >> 8, ch = gid & 255; float H = 0.f;
    for (int c = 0; c < 32; ++c) { const int i = (b * 32 + c) * 256 + ch; AGG[2 * 65536 + i] = H; H = AGG[i] * H + AGG[65536 + i]; }
}
__device__ __forceinline__ f32x4 mfma16(bf16x8 x, bf16x8 y, f32x4 c) { return __builtin_amdgcn_mfma_f32_16x16x32_bf16(x, y, c, 0, 0, 0); }
constexpr int LST = 72;
template <int MODE>
__device__ __forceinline__ void hgrn_item(const Args& a, int l, int item, LAS unsigned char* lds) {
    const int tid = otid(), wid = tid >> 6, lane = tid & 63, fr = lane & 15, fq = lane >> 4;
    const int c = item & 31, bh = item >> 5, h = bh % 6, b = bh / 6, row0 = b * T_ + 64 * c;
    const bf16_t* P = (const bf16_t*)(a.ws + WS_P);
    bf16_t* KVT = (bf16_t*)(a.ws + WS_HKV) + (size_t)item * 4096;
    LAS float* PART = (LAS float*)lds;
    LAS float* RHO = (LAS float*)(lds + 2048);
    LAS float* BC = (LAS float*)(lds + 4096);
    LAS bf16_t* L0 = (LAS bf16_t*)(lds + 20480);
    LAS bf16_t* L1 = (LAS bf16_t*)(lds + 29696);
    LAS bf16_t* L2 = (LAS bf16_t*)(lds + 38912);
    LAS bf16_t* VT = (LAS bf16_t*)(lds + 48128);
    LAS bf16_t* AM = (LAS bf16_t*)(lds + 57344);
    LAS float* SS = (LAS float*)(lds + 66560);
    const int k = lane, pt = wid;
    const float* hl = a.in[14];
    float lbv = 0.f; if (l == 1) lbv = 1.0f / (1.0f + __expf(hl[64 * h + k] - hl[384 + 64 * h + k]));
    float bc[8], kvv[8]; float s = 0.f;
#pragma unroll
    for (int i = 0; i < 8; ++i) { const float z = bf2f(P[(size_t)(row0 + 8 * pt + i) * PS_ + PBF + 64 * h + k]);
        const float sg = 1.0f / (1.0f + __expf(-z)); const float f = fmaxf(lbv + (1.0f - lbv) * sg, 1e-37f);
        s += __logf(f); bc[i] = s; kvv[i] = (1.0f - lbv) / (1.0f + __expf(z)); }
    PART[pt * 64 + k] = s;
    { unsigned short vv[8];
#pragma unroll
      for (int i = 0; i < 8; ++i) vv[i] = P[(size_t)(row0 + 8 * pt + i) * PS_ + PBV + 64 * h + k];
      u32x4 w; w.x = vv[0] | ((unsigned)vv[1] << 16); w.y = vv[2] | ((unsigned)vv[3] << 16); w.z = vv[4] | ((unsigned)vv[5] << 16); w.w = vv[6] | ((unsigned)vv[7] << 16);
      *(LAS u32x4*)(VT + k * LST + 8 * pt) = w; }
    __syncthreads();
    float off = 0.f, tot = 0.f, rho = 0.f;
#pragma unroll
    for (int p = 0; p < 8; ++p) { const float v = PART[p * 64 + k]; if (p < pt) off += v; if (p < 4) rho += v; tot += v; }
#pragma unroll
    for (int i = 0; i < 8; ++i) bc[i] += off;
    if (MODE == 0) {
        u32x4 w; float e[8];
#pragma unroll
        for (int i = 0; i < 8; ++i) e[i] = kvv[i] * __expf(tot - bc[i]);
        w.x = pk2(e[0], e[1]); w.y = pk2(e[2], e[3]); w.z = pk2(e[4], e[5]); w.w = pk2(e[6], e[7]);
        *(LAS u32x4*)(L0 + k * LST + 8 * pt) = w;
        if (pt == 0) ((float*)(a.ws + WS_HDEC))[(size_t)item * 64 + k] = __expf(tot);
        __syncthreads();
        const int kt = wid >> 1;
#pragma unroll
        for (int q = 0; q < 2; ++q) { const int vt = 2 * (wid & 1) + q; f32x4 acc = {0.f, 0.f, 0.f, 0.f};
#pragma unroll
            for (int ks = 0; ks < 2; ++ks) { const bf16x8 x = *(const LAS bf16x8*)(L0 + (16 * kt + fr) * LST + 32 * ks + 8 * fq), y = *(const LAS bf16x8*)(VT + (16 * vt + fr) * LST + 32 * ks + 8 * fq);
                acc = mfma16(x, y, acc); }
            u32x2 w2; w2.x = pk2(acc[0], acc[1]); w2.y = pk2(acc[2], acc[3]);
            *(u32x2*)(KVT + (16 * vt + fr) * 64 + 16 * kt + 4 * fq) = w2; }
        __syncthreads();
    } else {
#pragma unroll
        for (int i = 0; i < 8; ++i) BC[(8 * pt + i) * 64 + k] = bc[i];
        if (pt == 0) RHO[k] = rho;
        __syncthreads();
        { const int t2 = tid >> 3, kg = tid & 7;
          const u32x4 qw = *(const u32x4*)(P + (size_t)(row0 + t2) * PS_ + PBQ + 64 * h + 8 * kg), zw = *(const u32x4*)(P + (size_t)(row0 + t2) * PS_ + PBF + 64 * h + 8 * kg);
          float q[8], z[8], qp[8], qt[8], kt_[8];
          q[0] = bflo(qw.x); q[1] = bfhi(qw.x); q[2] = bflo(qw.y); q[3] = bfhi(qw.y); q[4] = bflo(qw.z); q[5] = bfhi(qw.z); q[6] = bflo(qw.w); q[7] = bfhi(qw.w);
          z[0] = bflo(zw.x); z[1] = bfhi(zw.x); z[2] = bflo(zw.y); z[3] = bfhi(zw.y); z[4] = bflo(zw.z); z[5] = bfhi(zw.z); z[6] = bflo(zw.w); z[7] = bfhi(zw.w);
#pragma unroll
          for (int i = 0; i < 8; ++i) { const int kk = 8 * kg + i; float lb2 = 0.f; if (l == 1) lb2 = 1.0f / (1.0f + __expf(hl[64 * h + kk] - hl[384 + 64 * h + kk]));
              const float kvl = (1.0f - lb2) / (1.0f + __expf(z[i])); const float bcv = BC[t2 * 64 + kk], rh = RHO[kk]; const float qs = q[i] * 0.125f;
              qp[i] = qs * __expf(bcv); qt[i] = qs * __expf(bcv - rh); kt_[i] = kvl * __expf(rh - bcv); }
          u32x4 w; w.x = pk2(qp[0], qp[1]); w.y = pk2(qp[2], qp[3]); w.z = pk2(qp[4], qp[5]); w.w = pk2(qp[6], qp[7]); *(LAS u32x4*)(L0 + t2 * LST + 8 * kg) = w;
          w.x = pk2(qt[0], qt[1]); w.y = pk2(qt[2], qt[3]); w.z = pk2(qt[4], qt[5]); w.w = pk2(qt[6], qt[7]); *(LAS u32x4*)(L1 + t2 * LST + 8 * kg) = w;
          w.x = pk2(kt_[0], kt_[1]); w.y = pk2(kt_[2], kt_[3]); w.z = pk2(kt_[4], kt_[5]); w.w = pk2(kt_[6], kt_[7]); *(LAS u32x4*)(L2 + t2 * LST + 8 * kg) = w; }
        __syncthreads();
        const int tt = wid >> 1;
#pragma unroll
        for (int q = 0; q < 2; ++q) { const int st = 2 * (wid & 1) + q; f32x4 acc = {0.f, 0.f, 0.f, 0.f};
            if (st <= tt) {
#pragma unroll
                for (int ks = 0; ks < 2; ++ks) { const bf16x8 x = *(const LAS bf16x8*)(L2 + (16 * st + fr) * LST + 32 * ks + 8 * fq), y = *(const LAS bf16x8*)(L1 + (16 * tt + fr) * LST + 32 * ks + 8 * fq);
                    acc = mfma16(x, y, acc); }
                const int t = 16 * tt + fr;
#pragma unroll
                for (int j = 0; j < 4; ++j) { const int sidx = 16 * st + 4 * fq + j; if (sidx > t) acc[j] = 0.f; }
            }
            u32x2 w2; w2.x = pk2(acc[0], acc[1]); w2.y = pk2(acc[2], acc[3]);
            *(LAS u32x2*)(AM + (16 * tt + fr) * LST + 16 * st + 4 * fq) = w2; }
        __syncthreads();
        f32x4 o[2]; float ss = 0.f;
#pragma unroll
        for (int q = 0; q < 2; ++q) { const int vt = 2 * (wid & 1) + q; f32x4 acc = {0.f, 0.f, 0.f, 0.f};
#pragma unroll
            for (int ks = 0; ks < 2; ++ks) { const bf16x8 x = *(const bf16x8*)(KVT + (16 * vt + fr) * 64 + 32 * ks + 8 * fq), y = *(const LAS bf16x8*)(L0 + (16 * tt + fr) * LST + 32 * ks + 8 * fq);
                acc = mfma16(x, y, acc); }
#pragma unroll
            for (int ks = 0; ks < 2; ++ks) { const bf16x8 x = *(const LAS bf16x8*)(VT + (16 * vt + fr) * LST + 32 * ks + 8 * fq), y = *(const LAS bf16x8*)(AM + (16 * tt + fr) * LST + 32 * ks + 8 * fq);
                acc = mfma16(x, y, acc); }
            o[q] = acc; ss += (acc[0] * acc[0] + acc[1] * acc[1]) + (acc[2] * acc[2] + acc[3] * acc[3]); }
        ss += __shfl_xor(ss, 16); ss += __shfl_xor(ss, 32);
        if (fq == 0) SS[wid * 16 + fr] = ss;
        __syncthreads();
        const float tot2 = SS[wid * 16 + fr] + SS[(wid ^ 1) * 16 + fr];
        const float rs = 1.0f / sqrtf(tot2 * (1.0f / 64.0f) + 1e-6f);
        bf16_t* Y = (bf16_t*)(a.ws + WS_HY);
#pragma unroll
        for (int q = 0; q < 2; ++q) { const int vt = 2 * (wid & 1) + q, t = 16 * tt + fr, cv = 64 * h + 16 * vt + 4 * fq;
            const u32x2 gw2 = *(const u32x2*)(P + (size_t)(row0 + t) * PS_ + PBG + cv);
            const f32x4 be = *(const f32x4*)(a.in[26] + l * 1024 + 256 + cv);
            float gg[4] = {bflo(gw2.x), bfhi(gw2.x), bflo(gw2.y), bfhi(gw2.y)}; float r[4];
#pragma unroll
            for (int j = 0; j < 4; ++j) r[j] = o[q][j] * rs * (gg[j] * sigmoidf_(gg[j])) * be[j];
            u32x2 w2; w2.x = pk2(r[0], r[1]); w2.y = pk2(r[2], r[3]);
            *(u32x2*)(Y + (size_t)(row0 + t) * D_ + 256 + cv) = w2; }
        __syncthreads();
    }
}
__device__ __forceinline__ void hgrn_scan(const Args& a, int e) {
    bf16_t* KVT = (bf16_t*)(a.ws + WS_HKV); const float* DEC = (const float*)(a.ws + WS_HDEC);
    const int bh = e >> 12, vk = e & 4095, k = vk & 63; float S = 0.f;
    for (int c = 0; c < 32; ++c) { const size_t idx = ((size_t)(bh * 32 + c) << 12) + vk; const float kv = bf2f(KVT[idx]); KVT[idx] = (bf16_t)f2bf(S);
        S = DEC[(bh * 32 + c) * 64 + k] * S + kv; }
}
__device__ __forceinline__ f32x4 mfma16k16(s16x4 x, s16x4 y, f32x4 c) { return __builtin_amdgcn_mfma_f32_16x16x16bf16_1k(x, y, c, 0, 0, 0); }
__device__ __forceinline__ s16x4 pack4(f32x4 v) { u32x2 w; w.x = pk2(v[0], v[1]); w.y = pk2(v[2], v[3]); return __builtin_bit_cast(s16x4, w); }
__device__ __forceinline__ void unpack8(const u32x4 w, float* o) { o[0] = bflo(w.x); o[1] = bfhi(w.x); o[2] = bflo(w.y); o[3] = bfhi(w.y); o[4] = bflo(w.z); o[5] = bfhi(w.z); o[6] = bflo(w.w); o[7] = bfhi(w.w); }
__device__ __forceinline__ u32x4 pack8(const float* e) { u32x4 w; w.x = pk2(e[0], e[1]); w.y = pk2(e[2], e[3]); w.z = pk2(e[4], e[5]); w.w = pk2(e[6], e[7]); return w; }
__device__ __forceinline__ void shift8(const bf16_t* P, size_t row, bool has_prev, int col, const float* mu, float* o) {
    const u32x4 cw = *(const u32x4*)(P + row * PS_ + PC + col); u32x4 pw = {0u, 0u, 0u, 0u}; if (has_prev) pw = *(const u32x4*)(P + (row - 1) * PS_ + PC + col);
    float c[8], p[8]; unpack8(cw, c); unpack8(pw, p); const f32x4 m0 = *(const f32x4*)(mu + col), m1 = *(const f32x4*)(mu + col + 4);
#pragma unroll
    for (int i = 0; i < 8; ++i) o[i] = c[i] + (p[i] - c[i]) * (i < 4 ? m0[i] : m1[i - 4]);
}
constexpr int RW_LIN = 0, RW_LINS = 264;
constexpr int RW_RH = 0, RW_YL = 18432, RW_YLS = 68;
constexpr int RW_CUM = 33792, RW_PART = 50176;
constexpr int RW_LO = 52224, RW_LOS = 68;
constexpr int RW_AT = 52224, RW_BD = 61440, RW_KD = 70656, RW_RT = 79872, RW_BTT = 89088, RW_KTT = 98304, RW_VT = 107520, RW_NAB = 116736, RW_AK = 125952;
constexpr int RW_ARB = RW_BTT, RW_ARK = RW_KTT;
constexpr int RW_NABF = 135168, RW_TII = 139264;
template <int MODE>
__device__ __forceinline__ void rwkv_chunk(const Args& a, int l, int item, LAS unsigned char* lds) {
    const int tid = otid(), wid = tid >> 6, lane = tid & 63, fr = lane & 15, fq = lane >> 4;
    const int c = item & 31, bh = item >> 5, h = bh % 6, b = bh / 6;
    const size_t row0 = (size_t)b * T_ + 64 * c;
    const bf16_t* P = (const bf16_t*)(a.ws + WS_P);
    const bf16_t* LW = (const bf16_t*)(a.ws + WS_LORA) + (size_t)l * 98304;
    const float* mu = a.in[15] + l * 1408;
    LAS bf16_t* LIN = (LAS bf16_t*)(lds + RW_LIN);
    LAS float* CUM = (LAS float*)(lds + RW_CUM); LAS float* PART = (LAS float*)(lds + RW_PART); LAS float* LO = (LAS float*)(lds + RW_LO);
    LAS bf16_t* AT = (LAS bf16_t*)(lds + RW_AT); LAS bf16_t* BD = (LAS bf16_t*)(lds + RW_BD); LAS bf16_t* KD = (LAS bf16_t*)(lds + RW_KD); LAS bf16_t* RT = (LAS bf16_t*)(lds + RW_RT);
    LAS bf16_t* BTT = (LAS bf16_t*)(lds + RW_BTT); LAS bf16_t* KTT = (LAS bf16_t*)(lds + RW_KTT); LAS bf16_t* VT = (LAS bf16_t*)(lds + RW_VT);
    LAS bf16_t* NAB = (LAS bf16_t*)(lds + RW_NAB); LAS bf16_t* AK = (LAS bf16_t*)(lds + RW_AK); LAS bf16_t* ARB = (LAS bf16_t*)(lds + RW_ARB); LAS bf16_t* ARK = (LAS bf16_t*)(lds + RW_ARK);
    LAS float* NABF = (LAS float*)(lds + RW_NABF); LAS bf16_t* TII = (LAS bf16_t*)(lds + RW_TII);
    const int t2 = tid >> 3, kg = tid & 7; const size_t row = row0 + t2; const bool has_prev = (c > 0) || (t2 > 0);
    {
#pragma unroll
        for (int q = 0; q < 4; ++q) { float ps[8]; const int col = 32 * kg + 8 * q; shift8(P, row, has_prev, 1152 + col, mu, ps);
#pragma unroll
            for (int i = 0; i < 8; ++i) { if (kg < 2) { const float e = __expf(2.0f * ps[i]); ps[i] = 1.0f - 2.0f / (e + 1.0f); } else if (kg >= 4) ps[i] = sigmoidf_(ps[i]); }
            *(LAS u32x4*)(LIN + t2 * RW_LINS + col) = pack8(ps); }
    }
    float rr[8], kx[8], vx[8];
    shift8(P, row, has_prev, 64 * h + 8 * kg, mu, rr); shift8(P, row, has_prev, 384 + 64 * h + 8 * kg, mu, kx); shift8(P, row, has_prev, 768 + 64 * h + 8 * kg, mu, vx);
    __syncthreads();
    { const int tt = wid >> 1;
#pragma unroll
      for (int q = 0; q < 2; ++q) { const int ct = 2 * (wid & 1) + q; const int crow = 64 * h + 16 * ct + fr;
          f32x4 aw = {0.f, 0.f, 0.f, 0.f}, aa = {0.f, 0.f, 0.f, 0.f}, ag = {0.f, 0.f, 0.f, 0.f};
#pragma unroll
          for (int ks = 0; ks < 2; ++ks) { const bf16x8 x = *(const LAS bf16x8*)(LIN + (16 * tt + fr) * RW_LINS + 32 * ks + 8 * fq), y = *(const bf16x8*)(LW + (size_t)crow * 64 + 32 * ks + 8 * fq); aw = mfma16(x, y, aw); }
#pragma unroll
          for (int ks = 0; ks < 2; ++ks) { const bf16x8 x = *(const LAS bf16x8*)(LIN + (16 * tt + fr) * RW_LINS + 64 + 32 * ks + 8 * fq), y = *(const bf16x8*)(LW + 24576 + (size_t)crow * 64 + 32 * ks + 8 * fq); aa = mfma16(x, y, aa); }
#pragma unroll
          for (int ks = 0; ks < 4; ++ks) { const bf16x8 x = *(const LAS bf16x8*)(LIN + (16 * tt + fr) * RW_LINS + 128 + 32 * ks + 8 * fq), y = *(const bf16x8*)(LW + 49152 + (size_t)crow * 128 + 32 * ks + 8 * fq); ag = mfma16(x, y, ag); }
#pragma unroll
          for (int j = 0; j < 4; ++j) { const int o = (16 * tt + 4 * fq + j) * RW_LOS + 16 * ct + fr; LO[o] = aw[j]; LO[64 * RW_LOS + o] = aa[j]; LO[2 * 64 * RW_LOS + o] = ag[j]; } }
    }
    __syncthreads();
    float gg[8], lw[8], be[8], al[8], kp[8]; float rkt = 0.f;
    { const int cb = l * 384 + 64 * h + 8 * kg; float wa[8], av[8];
      *(f32x4*)&wa[0] = *(const LAS f32x4*)(LO + t2 * RW_LOS + 8 * kg); *(f32x4*)&wa[4] = *(const LAS f32x4*)(LO + t2 * RW_LOS + 8 * kg + 4);
      *(f32x4*)&av[0] = *(const LAS f32x4*)(LO + 64 * RW_LOS + t2 * RW_LOS + 8 * kg); *(f32x4*)&av[4] = *(const LAS f32x4*)(LO + 64 * RW_LOS + t2 * RW_LOS + 8 * kg + 4);
      *(f32x4*)&gg[0] = *(const LAS f32x4*)(LO + 128 * RW_LOS + t2 * RW_LOS + 8 * kg); *(f32x4*)&gg[4] = *(const LAS f32x4*)(LO + 128 * RW_LOS + t2 * RW_LOS + 8 * kg + 4);
      float ssq = 0.f, kkr[8];
#pragma unroll
      for (int i = 0; i < 8; ++i) { const float wp = wa[i] + a.in[16][cb + i]; const float w = -log1pf(__expf(-wp)) - 0.5f; lw[i] = -__expf(w);
          const float aa = sigmoidf_(av[i] + a.in[18][cb + i]);
          kkr[i] = kx[i] * a.in[21][cb + i]; ssq += kkr[i] * kkr[i];
          kp[i] = kx[i] * (1.0f + (aa - 1.0f) * a.in[22][cb + i]); be[i] = aa;
          rkt += rr[i] * kp[i] * a.in[23][cb + i]; }
      ssq += __shfl_xor(ssq, 1); ssq += __shfl_xor(ssq, 2); ssq += __shfl_xor(ssq, 4);
      rkt += __shfl_xor(rkt, 1); rkt += __shfl_xor(rkt, 2); rkt += __shfl_xor(rkt, 4);
      const float rn = 1.0f / sqrtf(ssq + 1e-12f);
#pragma unroll
      for (int i = 0; i < 8; ++i) { const float kk = kkr[i] * rn; al[i] = -kk; be[i] = kk * be[i]; }
#pragma unroll
      for (int i = 0; i < 8; ++i) CUM[t2 * 64 + 8 * kg + i] = lw[i];
    }
    __syncthreads();
    { const int k = lane, pt = wid; float s = 0.f; float cv[8];
#pragma unroll
      for (int i = 0; i < 8; ++i) { s += CUM[(8 * pt + i) * 64 + k]; cv[i] = s; }
      PART[pt * 64 + k] = s;
      __syncthreads();
      float off = 0.f;
#pragma unroll
      for (int p = 0; p < 8; ++p) { const float v = PART[p * 64 + k]; if (p < pt) off += v; }
#pragma unroll
      for (int i = 0; i < 8; ++i) CUM[(8 * pt + i) * 64 + k] = cv[i] + off;
    }
    __syncthreads();
    { float cu[8], cl[8], e[8];
      *(f32x4*)&cu[0] = *(const LAS f32x4*)(CUM + t2 * 64 + 8 * kg); *(f32x4*)&cu[4] = *(const LAS f32x4*)(CUM + t2 * 64 + 8 * kg + 4);
      *(f32x4*)&cl[0] = *(const LAS f32x4*)(CUM + 63 * 64 + 8 * kg); *(f32x4*)&cl[4] = *(const LAS f32x4*)(CUM + 63 * 64 + 8 * kg + 4);
#pragma unroll
      for (int i = 0; i < 8; ++i) e[i] = al[i] * __expf(cu[i] - lw[i]);
      *(LAS u32x4*)(AT + t2 * LST + 8 * kg) = pack8(e);
      float en[8];
#pragma unroll
      for (int i = 0; i < 8; ++i) en[i] = __expf(-cu[i]);
#pragma unroll
      for (int i = 0; i < 8; ++i) e[i] = be[i] * en[i];
      *(LAS u32x4*)(BD + t2 * LST + 8 * kg) = pack8(e);
#pragma unroll
      for (int i = 0; i < 8; ++i) e[i] = kp[i] * en[i];
      *(LAS u32x4*)(KD + t2 * LST + 8 * kg) = pack8(e);
      if (MODE == 1) {
#pragma unroll
          for (int i = 0; i < 8; ++i) e[i] = rr[i] * __expf(cu[i]);
          *(LAS u32x4*)(RT + t2 * LST + 8 * kg) = pack8(e);
      } else {
#pragma unroll
          for (int i = 0; i < 8; ++i) { const float ed = __expf(cl[i] - cu[i]); BTT[(8 * kg + i) * LST + t2] = (bf16_t)f2bf(be[i] * ed); KTT[(8 * kg + i) * LST + t2] = (bf16_t)f2bf(kp[i] * ed); }
          if (t2 == 63) {
#pragma unroll
              for (int i = 0; i < 8; ++i) ((float*)(a.ws + WS_RGAM))[(size_t)item * 64 + 8 * kg + i] = __expf(cl[i]); }
      }
#pragma unroll
      for (int i = 0; i < 8; ++i) VT[(8 * kg + i) * LST + t2] = (bf16_t)f2bf(vx[i]);
    }
    __syncthreads();
    { const int tt = wid >> 1;
#pragma unroll
      for (int q = 0; q < 2; ++q) { const int st = 2 * (wid & 1) + q;
          f32x4 ab = {0.f, 0.f, 0.f, 0.f}, ak = {0.f, 0.f, 0.f, 0.f}, rb = {0.f, 0.f, 0.f, 0.f}, rk = {0.f, 0.f, 0.f, 0.f};
          if (st <= tt) {
#pragma unroll
              for (int ks = 0; ks < 2; ++ks) { const int ao = (16 * st + fr) * LST + 32 * ks + 8 * fq, bo = (16 * tt + fr) * LST + 32 * ks + 8 * fq;
                  const bf16x8 xb = *(const LAS bf16x8*)(BD + ao), xk = *(const LAS bf16x8*)(KD + ao), ya = *(const LAS bf16x8*)(AT + bo);
                  ab = mfma16(xb, ya, ab); ak = mfma16(xk, ya, ak);
                  if (MODE == 1) { const bf16x8 yr = *(const LAS bf16x8*)(RT + bo); rb = mfma16(xb, yr, rb); rk = mfma16(xk, yr, rk); } }
              const int t = 16 * tt + fr;
#pragma unroll
              for (int j = 0; j < 4; ++j) { const int s = 16 * st + 4 * fq + j; if (s >= t) { ab[j] = 0.f; ak[j] = 0.f; } if (s > t) { rb[j] = 0.f; rk[j] = 0.f; } }
              if (st == tt) *(LAS f32x4*)(NABF + tt * 256 + fr * 16 + 4 * fq) = ab;
          }
          const int o = (16 * tt + fr) * LST + 16 * st + 4 * fq;
          *(LAS s16x4*)(NAB + o) = pack4(ab); *(LAS s16x4*)(AK + o) = pack4(ak);
          if (MODE == 1) { *(LAS s16x4*)(ARB + o) = pack4(rb); *(LAS s16x4*)(ARK + o) = pack4(rk); } }
    }
    __syncthreads();
    f32x4 R[4];
    if (wid == 0) { const int blk = fq, j = fr; float Tc[16];
#pragma unroll
        for (int i = 0; i < 16; ++i) { float acc = (i == j) ? 1.0f : 0.0f;
#pragma unroll
            for (int m = 0; m < 16; ++m) if (m < i) acc += NABF[blk * 256 + i * 16 + m] * Tc[m];
            Tc[i] = acc; TII[blk * 256 + i * 16 + j] = (bf16_t)f2bf(acc); }
    }
    if (wid >= 4) { const int vt = wid - 4;
#pragma unroll
        for (int I = 0; I < 4; ++I) { f32x4 acc = {0.f, 0.f, 0.f, 0.f};
#pragma unroll
            for (int ks = 0; ks < 2; ++ks) { const bf16x8 x = *(const LAS bf16x8*)(AK + (16 * I + fr) * LST + 32 * ks + 8 * fq), y = *(const LAS bf16x8*)(VT + (16 * vt + fr) * LST + 32 * ks + 8 * fq); acc = mfma16(x, y, acc); }
            R[I] = acc; }
    } else {
#pragma unroll
        for (int I = 0; I < 4; ++I)
#pragma unroll
            for (int j = 0; j < 4; ++j) R[I][j] = bf2f(AT[(16 * I + 4 * fq + j) * LST + 16 * wid + fr]);
    }
    __syncthreads();
    s16x4 Xb[4];
#pragma unroll
    for (int I = 0; I < 4; ++I) { f32x4 acc = R[I];
#pragma unroll
        for (int J = 0; J < 4; ++J) if (J < I) acc = mfma16k16(*(const LAS s16x4*)(NAB + (16 * I + fr) * LST + 16 * J + 4 * fq), Xb[J], acc);
        const f32x4 z = {0.f, 0.f, 0.f, 0.f};
        const f32x4 x = mfma16k16(*(const LAS s16x4*)(TII + I * 256 + fr * 16 + 4 * fq), pack4(acc), z);
        Xb[I] = pack4(x); }
    s16x4 Vf[4];
    if (wid >= 4) {
#pragma unroll
        for (int J = 0; J < 4; ++J) Vf[J] = *(const LAS s16x4*)(VT + (16 * (wid - 4) + fr) * LST + 16 * J + 4 * fq); }
    if (MODE == 0) {
#pragma unroll
        for (int kt = 0; kt < 4; ++kt) { f32x4 acc = {0.f, 0.f, 0.f, 0.f};
#pragma unroll
            for (int J = 0; J < 4; ++J) acc = mfma16k16(*(const LAS s16x4*)(BTT + (16 * kt + fr) * LST + 16 * J + 4 * fq), Xb[J], acc);
            if (wid >= 4) {
#pragma unroll
                for (int J = 0; J < 4; ++J) acc = mfma16k16(*(const LAS s16x4*)(KTT + (16 * kt + fr) * LST + 16 * J + 4 * fq), Vf[J], acc);
                *(s16x4*)((bf16_t*)(a.ws + WS_RN) + (size_t)item * 4096 + ((kt * 4 + (wid - 4)) * 64 + lane) * 4) = pack4(acc);
            } else { bf16_t* RM = (bf16_t*)(a.ws + WS_RM) + (size_t)item * 4096;
#pragma unroll
                for (int j = 0; j < 4; ++j) RM[(16 * kt + 4 * fq + j) * 64 + 16 * wid + fr] = (bf16_t)f2bf(acc[j]); } }
        __syncthreads();
    } else {
        LAS bf16_t* RH = (LAS bf16_t*)(lds + RW_RH); LAS float* YL = (LAS float*)(lds + RW_YL);
        f32x4 yh[4];
#pragma unroll
        for (int tt = 0; tt < 4; ++tt) { f32x4 acc = {0.f, 0.f, 0.f, 0.f};
            if (wid < 4) {
#pragma unroll
                for (int j = 0; j < 4; ++j) acc[j] = bf2f(RT[(16 * tt + 4 * fq + j) * LST + 16 * wid + fr]); }
#pragma unroll
            for (int J = 0; J < 4; ++J) if (J <= tt) acc = mfma16k16(*(const LAS s16x4*)(ARB + (16 * tt + fr) * LST + 16 * J + 4 * fq), Xb[J], acc);
            if (wid >= 4) {
#pragma unroll
                for (int J = 0; J < 4; ++J) if (J <= tt) acc = mfma16k16(*(const LAS s16x4*)(ARK + (16 * tt + fr) * LST + 16 * J + 4 * fq), Vf[J], acc);
                yh[tt] = acc;
            } else {
#pragma unroll
                for (int j = 0; j < 4; ++j) RH[(16 * tt + 4 * fq + j) * LST + 16 * wid + fr] = (bf16_t)f2bf(acc[j]); } }
        __syncthreads();
        if (wid >= 4) { const int vt = wid - 4; s16x4 S0[4];
#pragma unroll
            for (int kt = 0; kt < 4; ++kt) S0[kt] = *(const s16x4*)((const bf16_t*)(a.ws + WS_RN) + (size_t)item * 4096 + ((kt * 4 + vt) * 64 + lane) * 4);
#pragma unroll
            for (int tt = 0; tt < 4; ++tt) { f32x4 acc = yh[tt];
#pragma unroll
                for (int kt = 0; kt < 4; ++kt) acc = mfma16k16(*(const LAS s16x4*)(RH + (16 * tt + fr) * LST + 16 * kt + 4 * fq), S0[kt], acc);
#pragma unroll
                for (int j = 0; j < 4; ++j) YL[(16 * tt + 4 * fq + j) * RW_YLS + 16 * vt + fr] = acc[j]; } }
        __syncthreads();
        { const int cb = l * 384 + 64 * h + 8 * kg; float y[8];
          *(f32x4*)&y[0] = *(const LAS f32x4*)(YL + t2 * RW_YLS + 8 * kg); *(f32x4*)&y[4] = *(const LAS f32x4*)(YL + t2 * RW_YLS + 8 * kg + 4);
          float sm = 0.f;
#pragma unroll
          for (int i = 0; i < 8; ++i) sm += y[i];
          sm += __shfl_xor(sm, 1); sm += __shfl_xor(sm, 2); sm += __shfl_xor(sm, 4);
          const float mean = sm * (1.0f / 64.0f); float vr = 0.f;
#pragma unroll
          for (int i = 0; i < 8; ++i) { y[i] -= mean; vr += y[i] * y[i]; }
          vr += __shfl_xor(vr, 1); vr += __shfl_xor(vr, 2); vr += __shfl_xor(vr, 4);
          const float rs = 1.0f / sqrtf(vr * (1.0f / 64.0f) + 64e-5f); float o[8];
#pragma unroll
          for (int i = 0; i < 8; ++i) o[i] = ((y[i] * rs * a.in[24][cb + i] + a.in[25][cb + i]) + rkt * vx[i]) * gg[i] * a.in[26][l * 1024 + 640 + 64 * h + 8 * kg + i];
          *(u32x4*)((bf16_t*)(a.ws + WS_HY) + row * D_ + 640 + 64 * h + 8 * kg) = pack8(o); }
        __syncthreads();
    }
}
__device__ __forceinline__ void rwkv_scan(const Args& a, int bh, int vt, int lane) {
    const int fr = lane & 15, fq = lane >> 4;
    const bf16_t* RM = (const bf16_t*)(a.ws + WS_RM); bf16_t* RN = (bf16_t*)(a.ws + WS_RN); const float* GAM = (const float*)(a.ws + WS_RGAM);
    f32x4 S[4];
#pragma unroll
    for (int k = 0; k < 4; ++k) S[k] = (f32x4){0.f, 0.f, 0.f, 0.f};
#pragma unroll 1
    for (int c = 0; c < 32; ++c) { const size_t item = (size_t)bh * 32 + c;
        s16x4 Mf[4][4]; s16x4 Nf[4]; f32x4 gam[4];
#pragma unroll
        for (int kt = 0; kt < 4; ++kt) {
#pragma unroll
            for (int k2 = 0; k2 < 4; ++k2) Mf[kt][k2] = *(const s16x4*)(RM + item * 4096 + (16 * kt + fr) * 64 + 16 * k2 + 4 * fq);
            Nf[kt] = *(const s16x4*)(RN + item * 4096 + ((kt * 4 + vt) * 64 + lane) * 4);
            gam[kt] = *(const f32x4*)(GAM + item * 64 + 16 * kt + 4 * fq); }
        s16x4 Sb[4];
#pragma unroll
        for (int k = 0; k < 4; ++k) { Sb[k] = pack4(S[k]); *(s16x4*)(RN + item * 4096 + ((k * 4 + vt) * 64 + lane) * 4) = Sb[k]; }
#pragma unroll
        for (int kt = 0; kt < 4; ++kt) { const u32x2 nw = __builtin_bit_cast(u32x2, Nf[kt]);
            f32x4 acc = gam[kt] * S[kt] + (f32x4){bflo(nw.x), bfhi(nw.x), bflo(nw.y), bfhi(nw.y)};
#pragma unroll
            for (int k2 = 0; k2 < 4; ++k2) acc = mfma16k16(Mf[kt][k2], Sb[k2], acc);
            S[kt] = acc; }
    }
}
__device__ __forceinline__ float shiftmix(const bf16_t* P, size_t row, int tglob, int col, float mu) {
    const float cur = bf2f(P[row * PS_ + PC + col]); const float prev = (tglob > 0) ? bf2f(P[(row - 1) * PS_ + PC + col]) : 0.f; return cur + (prev - cur) * mu; }
__device__ __forceinline__ void rwkv_seq(const Args& a, int l, int bh, LAS unsigned char* lds) {
    const int tid = otid(), wid = tid >> 6, lane = tid & 63, h = bh % 6, b = bh / 6;
    const bf16_t* P = (const bf16_t*)(a.ws + WS_P); bf16_t* Y = (bf16_t*)(a.ws + WS_HY);
    LAS float* LIN = (LAS float*)lds;
    LAS float* VEC = (LAS float*)(lds + 32768);
    LAS float* YL = (LAS float*)(lds + 90112);
    const float* mu = a.in[15] + l * 1408;
    float S[64];
#pragma unroll
    for (int k = 0; k < 64; ++k) S[k] = 0.f;
    const int t = tid >> 4, jg = tid & 15;
#pragma unroll 1
    for (int tb = 0; tb < T_; tb += 32) {
        const size_t row = (size_t)b * T_ + tb + t; const int tglob = tb + t;
#pragma unroll 4
        for (int i = 0; i < 16; ++i) { const int col = 16 * jg + i; const float ps = shiftmix(P, row, tglob, 1152 + col, mu[1152 + col]);
            float v; if (col < 64) { const float e = __expf(2.0f * ps); v = 1.0f - 2.0f / (e + 1.0f); } else if (col < 128) v = ps; else v = sigmoidf_(ps);
            LIN[t * 256 + col] = v; }
        __syncthreads();
        { const int cb = l * 384 + 64 * h + 4 * jg;
          f32x4 wacc = *(const f32x4*)(a.in[16] + cb), aacc = *(const f32x4*)(a.in[18] + cb), gacc = {0.f, 0.f, 0.f, 0.f};
          const float* wu = a.in[17] + (size_t)l * 64 * 384 + 64 * h + 4 * jg; const float* au = a.in[19] + (size_t)l * 64 * 384 + 64 * h + 4 * jg; const float* gu = a.in[20] + (size_t)l * 128 * 384 + 64 * h + 4 * jg;
#pragma unroll 4
          for (int i = 0; i < 64; ++i) { const float x = LIN[t * 256 + i]; wacc += x * *(const f32x4*)(wu + (size_t)i * 384); }
#pragma unroll 4
          for (int i = 0; i < 64; ++i) { const float x = LIN[t * 256 + 64 + i]; aacc += x * *(const f32x4*)(au + (size_t)i * 384); }
#pragma unroll 4
          for (int i = 0; i < 128; ++i) { const float x = LIN[t * 256 + 128 + i]; gacc += x * *(const f32x4*)(gu + (size_t)i * 384); }
          float kk[4], kp[4], aa[4], dec[4], rr[4], vv[4]; float ssq = 0.f;
#pragma unroll
          for (int j = 0; j < 4; ++j) { const int hc = 64 * h + 4 * jg + j;
              const float wp = wacc[j]; const float w = -log1pf(__expf(-wp)) - 0.5f; dec[j] = __expf(-__expf(w));
              aa[j] = sigmoidf_(aacc[j]);
              rr[j] = shiftmix(P, row, tglob, hc, mu[hc]); const float kx = shiftmix(P, row, tglob, 384 + hc, mu[384 + hc]); vv[j] = shiftmix(P, row, tglob, 768 + hc, mu[768 + hc]);
              kk[j] = kx * a.in[21][l * 384 + hc]; ssq += kk[j] * kk[j];
              kp[j] = kx * (1.0f + (aa[j] - 1.0f) * a.in[22][l * 384 + hc]); }
          ssq += __shfl_xor(ssq, 1); ssq += __shfl_xor(ssq, 2); ssq += __shfl_xor(ssq, 4); ssq += __shfl_xor(ssq, 8);
          const float rn = 1.0f / sqrtf(ssq + 1e-12f);
#pragma unroll
          for (int j = 0; j < 4; ++j) { const int jj = 4 * jg + j; const float kn = kk[j] * rn;
              VEC[(t * 7 + 0) * 64 + jj] = kn; VEC[(t * 7 + 1) * 64 + jj] = dec[j]; VEC[(t * 7 + 2) * 64 + jj] = kp[j]; VEC[(t * 7 + 3) * 64 + jj] = kn * aa[j];
              VEC[(t * 7 + 4) * 64 + jj] = rr[j]; VEC[(t * 7 + 5) * 64 + jj] = vv[j]; VEC[(t * 7 + 6) * 64 + jj] = gacc[j]; } }
        __syncthreads();
        if (wid == 0) {
#pragma unroll 1
            for (int ts = 0; ts < 32; ++ts) { const LAS f32x4* V4 = (const LAS f32x4*)(VEC + ts * 7 * 64);
                const float vv = VEC[(ts * 7 + 5) * 64 + lane]; float sa = 0.f;
#pragma unroll
                for (int k4 = 0; k4 < 16; ++k4) { const f32x4 q = V4[k4]; sa += S[4 * k4] * q.x; sa += S[4 * k4 + 1] * q.y; sa += S[4 * k4 + 2] * q.z; sa += S[4 * k4 + 3] * q.w; }
                sa = -sa; float y = 0.f;
#pragma unroll
                for (int k4 = 0; k4 < 16; ++k4) { const f32x4 w = V4[16 + k4], kp = V4[32 + k4], ka = V4[48 + k4], r = V4[64 + k4];
                    S[4 * k4] = S[4 * k4] * w.x + sa * ka.x + vv * kp.x; S[4 * k4 + 1] = S[4 * k4 + 1] * w.y + sa * ka.y + vv * kp.y;
                    S[4 * k4 + 2] = S[4 * k4 + 2] * w.z + sa * ka.z + vv * kp.z; S[4 * k4 + 3] = S[4 * k4 + 3] * w.w + sa * ka.w + vv * kp.w;
                    y += S[4 * k4] * r.x; y += S[4 * k4 + 1] * r.y; y += S[4 * k4 + 2] * r.z; y += S[4 * k4 + 3] * r.w; }
                YL[ts * 64 + lane] = y; }
        }
        __syncthreads();
        { const int cb = l * 384 + 64 * h + 4 * jg; const f32x4 y4 = *(const LAS f32x4*)(YL + t * 64 + 4 * jg);
          float sm = (y4.x + y4.y) + (y4.z + y4.w); sm += __shfl_xor(sm, 1); sm += __shfl_xor(sm, 2); sm += __shfl_xor(sm, 4); sm += __shfl_xor(sm, 8);
          const float mean = sm * (1.0f / 64.0f); const f32x4 d = y4 - mean;
          float vr = (d.x * d.x + d.y * d.y) + (d.z * d.z + d.w * d.w); vr += __shfl_xor(vr, 1); vr += __shfl_xor(vr, 2); vr += __shfl_xor(vr, 4); vr += __shfl_xor(vr, 8);
          const float rs = 1.0f / sqrtf(vr * (1.0f / 64.0f) + 64e-5f);
          const f32x4 rk = *(const f32x4*)(a.in[23] + cb), lw = *(const f32x4*)(a.in[24] + cb), lb = *(const f32x4*)(a.in[25] + cb), be = *(const f32x4*)(a.in[26] + l * 1024 + 640 + 64 * h + 4 * jg);
          float bs = 0.f; float r4[4], v4[4], g4[4];
#pragma unroll
          for (int j = 0; j < 4; ++j) { const int jj = 4 * jg + j; r4[j] = VEC[(t * 7 + 4) * 64 + jj]; v4[j] = VEC[(t * 7 + 5) * 64 + jj]; g4[j] = VEC[(t * 7 + 6) * 64 + jj]; bs += r4[j] * VEC[(t * 7 + 2) * 64 + jj] * rk[j]; }
          bs += __shfl_xor(bs, 1); bs += __shfl_xor(bs, 2); bs += __shfl_xor(bs, 4); bs += __shfl_xor(bs, 8);
          float o[4];
#pragma unroll
          for (int j = 0; j < 4; ++j) o[j] = ((d[j] * rs * lw[j] + lb[j]) + bs * v4[j]) * g4[j] * be[j];
          u32x2 w2; w2.x = pk2(o[0], o[1]); w2.y = pk2(o[2], o[3]);
          *(u32x2*)(Y + row * D_ + 640 + 64 * h + 4 * jg) = w2; }
        __syncthreads();
    }
}
__global__ void __launch_bounds__(512, 2) mk_fwd(Args a) {
    extern __shared__ __attribute__((aligned(16))) unsigned char shm[];
    LAS unsigned char* lds = (LAS unsigned char*)shm;
    cg::grid_group grid = cg::this_grid();
    if (a.ph_hi > 1000) grid.sync();
    { volatile LAS unsigned* stw = (volatile LAS unsigned*)(lds + LDS_BYTES - 16); if (threadIdx.x < 4) stw[threadIdx.x] = 0u; }
    __syncthreads();
    XcdBarrier xb = xcd_barrier_post((unsigned*)(a.ws + WS_BAR), (volatile LAS unsigned*)(lds + LDS_BYTES - 16));
    const int tid = otid(), wid = tid >> 6, lane = tid & 63, G = gridDim.x;
    unsigned char* ws = a.ws;
    bf16_t* Pb = (bf16_t*)(ws + WS_P); bf16_t* HY = (bf16_t*)(ws + WS_HY); float* MOD = (float*)(ws + WS_MOD);
#ifdef MK_PROBE
    unsigned long long t_prev = __builtin_amdgcn_s_memrealtime(), t_acc = 0;
#define PH_STAMP(n) { grid.sync(); const unsigned long long t_now = __builtin_amdgcn_s_memrealtime(); if ((MK_PROBE >> (n)) & 1) t_acc += t_now - t_prev; t_prev = t_now; }
#else
#define PH_STAMP(n)
#endif
#ifndef MK_REP
#define MK_REP 0
#endif
#define PH_BEGIN(n) if (a.ph_lo <= (n) && (n) < a.ph_hi) { const int ph_cur = (n); (void)ph_cur; if ((n) > a.ph_lo) xcd_barrier(xb); for (int rep_ = 0; rep_ < (((MK_REP >> (n)) & 1) ? 2 : 1); ++rep_) {
#define PH_END } PH_STAMP(ph_cur) }
    PH_BEGIN(0) phase_pro(a, lds); PH_END
#pragma unroll
    for (int l = 0; l < 2; ++l) {
        const int p0 = 1 + 9 * l;
        const float* xin = (l == 0) ? a.in[0] : a.out;
        const float* modl = MOD + (size_t)l * 8 * 6144;
        PH_BEGIN(p0 + 0) phase_norm(xin, a.in[2] + l * D_, modl + 0, modl + 1024, HY); PH_END
        PH_BEGIN(p0 + 1) { pg8::Gemm g{HY, (const bf16_t*)(ws + WS_WIN + l * SZ_WIN), M_, PS_, D_}; pg8::StaticOrder S; S.init(M_, PS_, G, blockIdx.x); EpiP E{Pb, PS_};
                  pg8::gemm_phase<EpiP, pg8::StaticOrder>(lds, g, S, E, nullptr); } PH_END
        PH_BEGIN(p0 + 2) { for (int it = blockIdx.x; it < 1536; it += G) hgrn_item<0>(a, l, it, lds);
                  for (int it = blockIdx.x; it < 1536; it += G) rwkv_chunk<0>(a, l, it, lds);
                  for (int it = blockIdx.x * 8 + (otid() >> 6); it < 1024; it += G * 8) rg_item<0>(a, l, it, otid() & 63); } PH_END
        PH_BEGIN(p0 + 3) { const int t3 = otid();
                  if (t3 < 64) { if ((int)blockIdx.x < 192) rwkv_scan(a, blockIdx.x >> 2, blockIdx.x & 3, t3); }
                  else { for (int e = blockIdx.x * 448 + (t3 - 64); e < 48 * 4096; e += G * 448) hgrn_scan(a, e);
                         for (int e = blockIdx.x * 448 + (t3 - 64); e < 2048; e += G * 448) rg_carry(a, e); } } PH_END
        PH_BEGIN(p0 + 4) { for (int it = blockIdx.x; it < 1536; it += G) hgrn_item<1>(a, l, it, lds);
                  for (int it = blockIdx.x; it < 1536; it += G) rwkv_chunk<1>(a, l, it, lds);
                  for (int it = blockIdx.x * 8 + (otid() >> 6); it < 1024; it += G * 8) rg_item<1>(a, l, it, otid() & 63); } PH_END
        PH_BEGIN(p0 + 5) { pg8::Gemm g{HY, (const bf16_t*)(ws + WS_WOUT + l * SZ_WOUT), M_, D_, D_}; pg8::StaticOrder S; S.init(M_, D_, G, blockIdx.x); EpiRes E{xin, a.out, modl + 2048};
                  pg8::gemm_phase<EpiRes, pg8::StaticOrder>(lds, g, S, E, nullptr); } PH_END
        PH_BEGIN(p0 + 6) phase_norm(a.out, a.in[3] + l * D_, modl + 3072, modl + 4096, HY); PH_END
        PH_BEGIN(p0 + 7) { pg8::Gemm g{HY, (const bf16_t*)(ws + WS_WGU + l * SZ_WGU), M_, NGU_, D_}; pg8::StaticOrder S; S.init(M_, NGU_, G, blockIdx.x); EpiSwi E{Pb};
                  pg8::gemm_phase<EpiSwi, pg8::StaticOrder>(lds, g, S, E, nullptr); } PH_END
        PH_BEGIN(p0 + 8) { pg8::Gemm g{Pb, (const bf16_t*)(ws + WS_WD + l * SZ_WD), M_, D_, FF_}; pg8::StaticOrder S; S.init(M_, D_, G, blockIdx.x); EpiRes E{a.out, a.out, modl + 5120};
                  pg8::gemm_phase<EpiRes, pg8::StaticOrder>(lds, g, S, E, nullptr); } PH_END
    }
    PH_BEGIN(19) phase_final(a.out, a.in[31]); PH_END
#ifdef MK_PROBE
    if (blockIdx.x == 0 && threadIdx.x == 0) a.out[0] = (float)t_acc * 0.01f;
#endif
}
#ifndef MK_MULTI
#define MK_MULTI 0
#endif
extern "C" void kernel_launch(void* const* d_in, const int* in_sizes, int n_in, void* d_out, int out_size, void* d_ws, size_t ws_size, hipStream_t stream) {
    static int grid = 0;
    if (!grid) {
        if (n_in != 32 || ws_size < WS_END) { fprintf(stderr, "kernel_launch: bad args n_in %d ws %zu need %zu\n", n_in, ws_size, (size_t)WS_END); return; }
        hipFuncSetAttribute((const void*)mk_fwd, hipFuncAttributeMaxDynamicSharedMemorySize, LDS_BYTES);
        int dev = 0, cus = 0, per_cu = 0; hipGetDevice(&dev); hipDeviceGetAttribute(&cus, hipDeviceAttributeMultiprocessorCount, dev);
        hipOccupancyMaxActiveBlocksPerMultiprocessor(&per_cu, mk_fwd, 512, LDS_BYTES);
        if (per_cu < 1) { fprintf(stderr, "kernel_launch: occupancy 0\n"); per_cu = 1; }
        grid = cus;
    }
    Args a{}; for (int i = 0; i < 32; ++i) a.in[i] = (const float*)d_in[i];
    a.out = (float*)d_out; a.ws = (unsigned char*)d_ws;
#if MK_MULTI
    for (int ph = 0; ph < 20; ++ph) { a.ph_lo = ph; a.ph_hi = ph + 1; hipLaunchKernelGGL(mk_fwd, dim3(grid), dim3(512), LDS_BYTES, stream, a); }
#else
    a.ph_lo = 0; a.ph_hi = 20; void* args[] = {&a};
    if (hipMemsetAsync((char*)d_ws + WS_BAR, 0, XCD_BAR_WORDS * 4, stream) != hipSuccess) { fprintf(stderr, "memset failed\n"); return; }
    hipError_t e = hipLaunchCooperativeKernel((const void*)mk_fwd, dim3(grid), dim3(512), args, LDS_BYTES, stream);
    if (e != hipSuccess) fprintf(stderr, "cooperative launch failed: %s (grid %d)\n", hipGetErrorString(e), grid);
#endif
}
```

```cpp
#include <hip/hip_runtime.h>
#include <hip/hip_cooperative_groups.h>
#include <cstdio>
#include <cstdint>
namespace cg = cooperative_groups;
__device__ __forceinline__ int otid() { int t = threadIdx.x; asm volatile("" : "+v"(t)); return t; }
namespace pg8 {
#define PG8_LAS __attribute__((address_space(3)))
typedef unsigned short bf16_t;
typedef short bf16x8 __attribute__((ext_vector_type(8)));
typedef float f32x4 __attribute__((ext_vector_type(4)));
typedef unsigned u32x4 __attribute__((ext_vector_type(4)));
constexpr int BM = 256, BK = 64, HALF = 128, HTB = HALF * BK * 2  , STAGE_BYTES = 8 * HTB, NXCD = 8, WGM = 8;

__host__ __device__ __forceinline__ int lds_byte(int r, int c) { const int st = (r >> 4) * 2 + (c >> 5), rr = r & 15, cc = c & 31, ob = rr * 64 + cc * 2; return st * 1024 + (ob ^ (((ob >> 9) & 1) << 5)); }
__host__ __device__ __forceinline__ void stage_rc(int b, int& R, int& C) { const int st = b / 1024, sb = b % 1024, swz = sb ^ (((sb >> 9) & 1) << 5); R = (st >> 1) * 16 + swz / 64; C = (st & 1) * 32 + (swz % 64) / 2; }
__host__ __device__ __forceinline__ int perm32(int rho) { const int n = rho >> 4, i = rho & 15; return 8 * (i >> 2) + 4 * n + (i & 3); }

struct Unit { int pm, pn; };
struct Gemm { const bf16_t* A; const bf16_t* Bt; int M, N, K; };

struct StaticOrder {
    int nM, nN, nwg, G, c;
    __host__ __device__ void init(int M, int N, int G_, int c_) { nM = M / BM; nN = N / BM; nwg = nM * nN; G = G_; c = c_; }
    __host__ __device__ bool next(int i, Unit& u) const {
        const long L = (long)i * G + c; if (L >= nwg) return false;
        int wgid = (int)L; { const int q = nwg / NXCD, r = nwg % NXCD, xcd = wgid % NXCD, off = wgid / NXCD; wgid = (xcd < r ? xcd * (q + 1) : r * (q + 1) + (xcd - r) * q) + off; }
        const int nig = WGM * nN, gid = wgid / nig, fm = gid * WGM, gsz = (nM - fm) < WGM ? (nM - fm) : WGM;
        u.pm = fm + ((wgid % nig) % gsz); u.pn = (wgid % nig) / gsz; return true;
    }
    __device__ __forceinline__ void a_ready(const Unit&) const {}
    __device__ __forceinline__ void done(const Unit&) const {}
};
__device__ __forceinline__ unsigned cvt_pk_bf16(float lo, float hi) { unsigned r; asm volatile("v_cvt_pk_bf16_f32 %0, %1, %2" : "=v"(r) : "v"(lo), "v"(hi)); return r; }
template <class Epi, class Sched, bool STAMP = false>
__device__ __forceinline__ void gemm_phase(PG8_LAS unsigned char* lds, const Gemm g, const Sched& S, const Epi& E, unsigned long long* stamps) {
    const int tid = otid(), wid = __builtin_amdgcn_readfirstlane(tid >> 6), lane = tid & 63, wr = wid >> 2, wc = wid & 3, fr = lane & 15, fq = lane >> 4;
    const int K = g.K, nt = K / BK;
    unsigned voffA[2], voffB[2];
#pragma unroll
    for (int i = 0; i < 2; ++i) { int R, C; stage_rc(tid * 16 + i * 8192, R, C); const int Rb = Epi::PERM ? ((R & ~31) + perm32(R & 31)) : R;
        voffA[i] = (unsigned)(R * K + C) * 2u; voffB[i] = (unsigned)(Rb * K + C) * 2u; }
    const size_t kstep = (size_t)(BK * 2);
    const size_t hstep = (size_t)HALF * K * 2;
    const size_t tstep = 2 * hstep;
    const unsigned ldsw = (unsigned)wid * 1024u;
    const int aoff = lds_byte(wr * 64 + fr, fq * 8), boff = lds_byte(wc * 32 + fr, fq * 8);
#define PG8_SA(b, h) (((b) * 2 + (h)) * HTB)
#define PG8_SB(b, h) ((4 + (b) * 2 + (h)) * HTB)
#define PG8_STAGE(bufoff, gbase, voff) do { _Pragma("unroll") for (int _i = 0; _i < 2; ++_i) \
        __builtin_amdgcn_global_load_lds((const unsigned*)((const char*)(gbase) + (voff)[_i]), (PG8_LAS unsigned*)(lds + (bufoff) + ldsw + _i * 8192), 16, 0, 0); } while (0)
#define PG8_LDA(dst, b, h) do { _Pragma("unroll") for (int m = 0; m < 4; ++m) _Pragma("unroll") for (int k = 0; k < 2; ++k) dst[m][k] = *(const PG8_LAS bf16x8*)(lds + PG8_SA(b, h) + aoff + m * 2048 + k * 1024); } while (0)
#define PG8_LDB(dst, b, h) do { _Pragma("unroll") for (int n = 0; n < 2; ++n) _Pragma("unroll") for (int k = 0; k < 2; ++k) dst[n][k] = *(const PG8_LAS bf16x8*)(lds + PG8_SB(b, h) + boff + n * 2048 + k * 1024); } while (0)
#define PG8_MMA(ai, bj, At, Bt) do { __builtin_amdgcn_s_setprio(1); _Pragma("unroll") for (int m = 0; m < 4; ++m) _Pragma("unroll") for (int n = 0; n < 2; ++n) _Pragma("unroll") for (int k = 0; k < 2; ++k) \
        acc[ai][bj][m][n] = __builtin_amdgcn_mfma_f32_16x16x32_bf16(Bt[n][k], At[m][k], acc[ai][bj][m][n], 0, 0, 0); __builtin_amdgcn_s_setprio(0); } while (0)
#define PG8_WAIT_V(n) asm volatile("s_waitcnt vmcnt(" #n ")" ::: "memory")
#define PG8_WAIT_L(n) asm volatile("s_waitcnt lgkmcnt(" #n ")" ::: "memory")
#define PG8_BAR __builtin_amdgcn_s_barrier()
#define PG8_SCHED __builtin_amdgcn_sched_barrier(0)
    Unit cur, nxt; int ui = 0;
    if (!S.next(0, cur)) return;
    f32x4 acc[2][2][4][2];
#pragma unroll
    for (int a = 0; a < 2; ++a)
#pragma unroll
        for (int b = 0; b < 2; ++b)
#pragma unroll
            for (int m = 0; m < 4; ++m)
#pragma unroll
                for (int n = 0; n < 2; ++n) acc[a][b][m][n] = (f32x4){0.f, 0.f, 0.f, 0.f};
    bf16x8 At[4][2], B0[2][2], B1[2][2];
    const char* cA = (const char*)g.A + (size_t)cur.pm * tstep; const char* cB = (const char*)g.Bt + (size_t)cur.pn * tstep;
    S.a_ready(cur);
    PG8_STAGE(PG8_SB(0, 0), cB, voffB); PG8_STAGE(PG8_SA(0, 0), cA, voffA); PG8_STAGE(PG8_SB(0, 1), cB + hstep, voffB); PG8_STAGE(PG8_SA(0, 1), cA + hstep, voffA);
    if (wr == 1) PG8_BAR;
    PG8_WAIT_V(4); PG8_BAR;
    PG8_STAGE(PG8_SB(1, 0), cB + kstep, voffB); PG8_STAGE(PG8_SA(1, 0), cA + kstep, voffA); PG8_STAGE(PG8_SB(1, 1), cB + hstep + kstep, voffB);
    PG8_WAIT_V(6); PG8_BAR;
    for (;;) {
        const bool has_next = S.next(ui + 1, nxt);
        const char* nA = has_next ? (const char*)g.A + (size_t)nxt.pm * tstep : cA; const char* nB = has_next ? (const char*)g.Bt + (size_t)nxt.pn * tstep : cB;
        for (int t = 0; t < nt; t += 2) {
            const bool last = (t == nt - 2);
            const char* a1 = cA + (size_t)(t + 1) * kstep;
            const char* a2 = last ? nA : cA + (size_t)(t + 2) * kstep; const char* b2 = last ? nB : cB + (size_t)(t + 2) * kstep;
            const char* a3 = a2 + kstep; const char* b3 = b2 + kstep;
            if (last && has_next) S.a_ready(nxt);
            PG8_LDB(B0, 0, 0); PG8_SCHED; PG8_LDA(At, 0, 0); PG8_STAGE(PG8_SA(1, 1), a1 + hstep, voffA);
            PG8_WAIT_L(8); PG8_BAR; PG8_WAIT_L(0); PG8_MMA(0, 0, At, B0); PG8_BAR; PG8_SCHED;
            PG8_LDB(B1, 0, 1); PG8_STAGE(PG8_SB(0, 0), b2, voffB);
            PG8_BAR; PG8_WAIT_L(0); PG8_MMA(0, 1, At, B1); PG8_BAR;
            PG8_LDA(At, 0, 1); PG8_STAGE(PG8_SA(0, 0), a2, voffA);
            PG8_BAR; PG8_WAIT_L(0); PG8_MMA(1, 0, At, B0); PG8_BAR; PG8_SCHED;
            PG8_STAGE(PG8_SB(0, 1), b2 + hstep, voffB);
            PG8_WAIT_V(6); PG8_BAR; PG8_MMA(1, 1, At, B1); PG8_BAR;
            PG8_LDB(B0, 1, 0); PG8_SCHED; PG8_LDA(At, 1, 0); PG8_STAGE(PG8_SA(0, 1), a2 + hstep, voffA);
            PG8_WAIT_L(8); PG8_BAR; PG8_WAIT_L(0); PG8_MMA(0, 0, At, B0); PG8_BAR; PG8_SCHED;
            PG8_LDB(B1, 1, 1); PG8_STAGE(PG8_SB(1, 0), b3, voffB);
            PG8_BAR; PG8_WAIT_L(0); PG8_MMA(0, 1, At, B1); PG8_BAR;
            PG8_LDA(At, 1, 1); PG8_STAGE(PG8_SA(1, 0), a3, voffA);
            PG8_BAR; PG8_WAIT_L(0); PG8_MMA(1, 0, At, B0); PG8_BAR; PG8_SCHED;
            PG8_STAGE(PG8_SB(1, 1), b3 + hstep, voffB);
            PG8_WAIT_V(6); PG8_BAR; PG8_MMA(1, 1, At, B1); PG8_BAR;
        }
        if constexpr (!Epi::AFTER_DRAIN) { E(acc, cur, wr, wc, fr, fq); S.done(cur); }
        if (!has_next) break;
#pragma unroll
        for (int a = 0; a < 2; ++a)
#pragma unroll
            for (int b = 0; b < 2; ++b)
#pragma unroll
                for (int m = 0; m < 4; ++m)
#pragma unroll
                    for (int n = 0; n < 2; ++n) acc[a][b][m][n] = (f32x4){0.f, 0.f, 0.f, 0.f};
        cur = nxt; cA = nA; cB = nB; ++ui;
    }
    PG8_WAIT_V(0);
    if (wr == 0) PG8_BAR;
    PG8_BAR;
    if constexpr (Epi::AFTER_DRAIN) { E.fused(acc, cur, wr, wc, fr, fq, lds, wid, lane); S.done(cur); }
#undef PG8_SA
#undef PG8_SB
#undef PG8_STAGE
#undef PG8_LDA
#undef PG8_LDB
#undef PG8_MMA
#undef PG8_WAIT_V
#undef PG8_WAIT_L
#undef PG8_BAR
#undef PG8_SCHED
}
}
using pg8::bf16_t; using pg8::bf16x8; using pg8::f32x4; using pg8::u32x4;
#define LAS __attribute__((address_space(3)))
typedef float f32x2 __attribute__((ext_vector_type(2)));
typedef unsigned u32x2 __attribute__((ext_vector_type(2)));
typedef short s16x4 __attribute__((ext_vector_type(4)));

constexpr int M_ = 16384, D_ = 1024, T_ = 2048, NB_ = 8, PS_ = 3584, PW_ = 3456, FF_ = 2816, NGU_ = 5632;
constexpr int PAX = 0, PAY = 256, PBQ = 512, PBF = 896, PBV = 1280, PBG = 1664, PC = 2048;
constexpr int LDS_BYTES = 144 * 1024;
constexpr size_t SZ_WIN = (size_t)PS_ * D_ * 2, SZ_WOUT = (size_t)D_ * D_ * 2, SZ_WGU = (size_t)NGU_ * D_ * 2, SZ_WD = (size_t)D_ * FF_ * 2;
constexpr size_t WS_WIN = 0, WS_WOUT = WS_WIN + 2 * SZ_WIN, WS_WGU = WS_WOUT + 2 * SZ_WOUT, WS_WD = WS_WGU + 2 * SZ_WGU;
constexpr size_t WS_MOD = WS_WD + 2 * SZ_WD;
constexpr size_t WS_P = WS_MOD + 2 * 8 * 6144 * 4;
constexpr size_t WS_HY = WS_P + (size_t)M_ * PS_ * 2;
constexpr size_t WS_RGA = WS_HY + (size_t)M_ * D_ * 2;
constexpr size_t WS_HKV = WS_RGA + 3 * 8 * 32 * 256 * 4;
constexpr size_t WS_HDEC = WS_HKV + (size_t)1536 * 4096 * 2;
constexpr size_t WS_RM = WS_HDEC + (size_t)1536 * 64 * 4;
constexpr size_t WS_RN = WS_RM + (size_t)1536 * 4096 * 2;
constexpr size_t WS_RGAM = WS_RN + (size_t)1536 * 4096 * 2;
constexpr size_t WS_LORA = WS_RGAM + (size_t)1536 * 64 * 4;
constexpr size_t WS_BAR = WS_LORA + (size_t)2 * 98304 * 2;
constexpr size_t WS_END = WS_BAR + 16384;

struct Args { const float* in[32]; float* out; unsigned char* ws; int ph_lo, ph_hi; };

__device__ __forceinline__ unsigned f2bf(float f) { unsigned u = __builtin_bit_cast(unsigned, f); return (u + 0x7fffu + ((u >> 16) & 1u)) >> 16; }
__device__ __forceinline__ unsigned pk2(float lo, float hi) { return f2bf(lo) | (f2bf(hi) << 16); }
__device__ __forceinline__ float bf2f(unsigned short b) { return __builtin_bit_cast(float, ((unsigned)b) << 16); }
__device__ __forceinline__ float bflo(unsigned w) { return __builtin_bit_cast(float, w << 16); }
__device__ __forceinline__ float bfhi(unsigned w) { return __builtin_bit_cast(float, w & 0xffff0000u); }
__device__ __forceinline__ float wave_sum(float v) {
#pragma unroll
    for (int o = 1; o < 64; o <<= 1) v += __shfl_xor(v, o);
    return v;
}
__device__ __forceinline__ float sigmoidf_(float x) { return 1.0f / (1.0f + __expf(-x)); }
#define LDS_WAIT() asm volatile("s_waitcnt lgkmcnt(0)" ::: "memory")

struct EpiP {
    static constexpr bool PERM = true, AFTER_DRAIN = false;
    bf16_t* O; int ldc;
    __device__ __forceinline__ void operator()(const f32x4 (&acc)[2][2][4][2], const pg8::Unit& u, int wr, int wc, int fr, int fq) const {
        const int row0 = u.pm * 256 + wr * 64 + fr, col0 = u.pn * 256 + wc * 32 + 8 * fq;
#pragma unroll
        for (int ai = 0; ai < 2; ++ai)
#pragma unroll
            for (int m = 0; m < 4; ++m) { bf16_t* rowp = O + (size_t)(row0 + ai * 128 + m * 16) * ldc + col0;
#pragma unroll
                for (int bj = 0; bj < 2; ++bj) { const f32x4 v0 = acc[ai][bj][m][0], v1 = acc[ai][bj][m][1]; u32x4 w;
                    w.x = pg8::cvt_pk_bf16(v0[0], v0[1]); w.y = pg8::cvt_pk_bf16(v0[2], v0[3]); w.z = pg8::cvt_pk_bf16(v1[0], v1[1]); w.w = pg8::cvt_pk_bf16(v1[2], v1[3]);
                    *(u32x4*)(rowp + bj * 128) = w; } }
    }
};
struct EpiRes {
    static constexpr bool PERM = false, AFTER_DRAIN = false;
    const float* base; float* out; const float* gate;
    __device__ __forceinline__ void operator()(const f32x4 (&acc)[2][2][4][2], const pg8::Unit& u, int wr, int wc, int fr, int fq) const {
        const int row0 = u.pm * 256 + wr * 64 + fr, col0 = u.pn * 256 + wc * 32 + 4 * fq, b = u.pm >> 3;
        f32x4 gv[2][2];
#pragma unroll
        for (int bj = 0; bj < 2; ++bj)
#pragma unroll
            for (int n = 0; n < 2; ++n) gv[bj][n] = *(const f32x4*)(gate + (size_t)b * 6144 + col0 + bj * 128 + n * 16);
#pragma unroll
        for (int ai = 0; ai < 2; ++ai)
#pragma unroll
            for (int m = 0; m < 4; ++m) { const size_t ro = (size_t)(row0 + ai * 128 + m * 16) * 1024 + col0;
#pragma unroll
                for (int bj = 0; bj < 2; ++bj)
#pragma unroll
                    for (int n = 0; n < 2; ++n) { const f32x4 bv = *(const f32x4*)(base + ro + bj * 128 + n * 16);
                        *(f32x4*)(out + ro + bj * 128 + n * 16) = bv + gv[bj][n] * acc[ai][bj][m][n]; } }
    }
};
struct EpiSwi {
    static constexpr bool PERM = true, AFTER_DRAIN = false;
    bf16_t* O;
    __device__ __forceinline__ void operator()(const f32x4 (&acc)[2][2][4][2], const pg8::Unit& u, int wr, int wc, int fr, int fq) const {
        const int row0 = u.pm * 256 + wr * 64 + fr, col0 = u.pn * 128 + wc * 32 + 8 * fq;
#pragma unroll
        for (int ai = 0; ai < 2; ++ai)
#pragma unroll
            for (int m = 0; m < 4; ++m) { bf16_t* rowp = O + (size_t)(row0 + ai * 128 + m * 16) * FF_ + col0; float o[8];
#pragma unroll
                for (int n = 0; n < 2; ++n)
#pragma unroll
                    for (int i = 0; i < 4; ++i) { const float g = acc[ai][0][m][n][i], up = acc[ai][1][m][n][i]; o[4 * n + i] = g * sigmoidf_(g) * up; }
                u32x4 w; w.x = pg8::cvt_pk_bf16(o[0], o[1]); w.y = pg8::cvt_pk_bf16(o[2], o[3]); w.z = pg8::cvt_pk_bf16(o[4], o[5]); w.w = pg8::cvt_pk_bf16(o[6], o[7]);
                *(u32x4*)rowp = w; }
    }
};

__device__ __forceinline__ void transpose_item(const float* W, int K, int N, bf16_t* WT, int mode, LAS float* scr, int item, int lane) {
    const int nblk = N / 32, kb = item / nblk, nb = item % nblk, k0 = 64 * kb, n0 = 32 * nb;
#pragma unroll 8
    for (int i = 0; i < 32; ++i) { const int kk = 2 * i + (lane >> 5); scr[kk * 33 + (lane & 31)] = W[(size_t)(k0 + kk) * N + n0 + (lane & 31)]; }
    LDS_WAIT(); asm volatile("" ::: "memory");
    const int c = lane & 7;
#pragma unroll
    for (int j = 0; j < 4; ++j) { const int nl = (lane >> 3) + 8 * j, n = n0 + nl; const LAS float* s = scr + (8 * c) * 33 + nl;
        const int row = (mode == 0) ? n : (256 * (n >> 7) + (n & 127) + (mode == 2 ? 128 : 0));
        u32x4 o; o.x = pk2(s[0 * 33], s[1 * 33]); o.y = pk2(s[2 * 33], s[3 * 33]); o.z = pk2(s[4 * 33], s[5 * 33]); o.w = pk2(s[6 * 33], s[7 * 33]);
        *(u32x4*)(WT + (size_t)row * K + k0 + 8 * c) = o; }
    LDS_WAIT(); asm volatile("" ::: "memory");
}
__device__ __forceinline__ void phase_pro(const Args& a, LAS unsigned char* lds) {
    const int tid = otid(), wid = tid >> 6, lane = tid & 63;
    unsigned char* ws = a.ws;
    LAS float* CS = (LAS float*)lds;
    LAS float* RED = (LAS float*)(lds + 32768);
    if ((int)blockIdx.x < 192) {
        for (int i = tid; i < 8192; i += 512) { const float cv = a.in[1][i]; CS[i] = cv * sigmoidf_(cv); }
        __syncthreads();
    }
    for (int item = blockIdx.x; item < 192; item += gridDim.x) {
        const int l = item / 96, cgp = item % 96, col = cgp * 64 + lane;
        const float* aw = a.in[4] + (size_t)l * 1024 * 6144;
        float acc[8];
#pragma unroll
        for (int b = 0; b < 8; ++b) acc[b] = 0.f;
        for (int k = wid * 128; k < wid * 128 + 128; ++k) { const float w = aw[(size_t)k * 6144 + col];
#pragma unroll
            for (int b = 0; b < 8; ++b) acc[b] += CS[b * 1024 + k] * w; }
#pragma unroll
        for (int b = 0; b < 8; ++b) RED[(wid * 8 + b) * 64 + lane] = acc[b];
        __syncthreads();
        { const int b = wid; float s = 0.f;
#pragma unroll
          for (int w = 0; w < 8; ++w) s += RED[(w * 8 + b) * 64 + lane];
          ((float*)(ws + WS_MOD))[(size_t)(l * 8 + b) * 6144 + col] = s + a.in[5][l * 6144 + col]; }
        __syncthreads();
    }
    LAS float* scr = (LAS float*)(lds + 65536 + wid * 8448);
    const int gw = blockIdx.x * 8 + wid, NGW = gridDim.x * 8;
    constexpr int I_IN = 16 * (PW_ / 32), I_OUT = 16 * 32, I_G = 16 * (FF_ / 32), I_D = (FF_ / 64) * 32, I_L = I_IN + I_OUT + 2 * I_G + I_D;
    for (int it = gw; it < 2 * I_L; it += NGW) {
        const int l = it / I_L; int r = it % I_L;
        if (r < I_IN) { transpose_item(a.in[6] + (size_t)l * D_ * PW_, D_, PW_, (bf16_t*)(ws + WS_WIN + l * SZ_WIN), 0, scr, r, lane); continue; } r -= I_IN;
        if (r < I_OUT) { transpose_item(a.in[27] + (size_t)l * D_ * D_, D_, D_, (bf16_t*)(ws + WS_WOUT + l * SZ_WOUT), 0, scr, r, lane); continue; } r -= I_OUT;
        if (r < I_G) { transpose_item(a.in[28] + (size_t)l * D_ * FF_, D_, FF_, (bf16_t*)(ws + WS_WGU + l * SZ_WGU), 1, scr, r, lane); continue; } r -= I_G;
        if (r < I_G) { transpose_item(a.in[29] + (size_t)l * D_ * FF_, D_, FF_, (bf16_t*)(ws + WS_WGU + l * SZ_WGU), 2, scr, r, lane); continue; } r -= I_G;
        transpose_item(a.in[30] + (size_t)l * FF_ * D_, FF_, D_, (bf16_t*)(ws + WS_WD + l * SZ_WD), 0, scr, r, lane);
    }
    for (int e = blockIdx.x * 512 + tid; e < 2 * 98304; e += gridDim.x * 512) { const int l = e / 98304; int r = e % 98304; float v;
        if (r < 24576) { const int cidx = r >> 6, i = r & 63; v = a.in[17][((size_t)l * 64 + i) * 384 + cidx]; }
        else if (r < 49152) { const int r2 = r - 24576, cidx = r2 >> 6, i = r2 & 63; v = a.in[19][((size_t)l * 64 + i) * 384 + cidx]; }
        else { const int r2 = r - 49152, cidx = r2 >> 7, i = r2 & 127; v = a.in[20][((size_t)l * 128 + i) * 384 + cidx]; }
        ((bf16_t*)(ws + WS_LORA))[e] = (bf16_t)f2bf(v); }
    for (int i = blockIdx.x * 512 + tid; i < 2 * 16384; i += gridDim.x * 512) { const int l = i >> 14, e = i & 16383;
        *(u32x4*)(ws + WS_WIN + l * SZ_WIN + (size_t)PW_ * D_ * 2 + (size_t)e * 16) = (u32x4){0u, 0u, 0u, 0u}; }
}
__device__ __forceinline__ void phase_norm(const float* xin, const float* gain, const float* sh, const float* sc, bf16_t* H) {
    const int tid = otid(), wid = tid >> 6, lane = tid & 63, gw = blockIdx.x * 8 + wid, NGW = gridDim.x * 8;
    for (int row = gw; row < M_; row += NGW) { const int b = row >> 11;
        const f32x4* xr = (const f32x4*)(xin + (size_t)row * D_) + lane; f32x4 v[4]; float ss = 0.f;
#pragma unroll
        for (int j = 0; j < 4; ++j) { v[j] = xr[64 * j]; ss += (v[j].x * v[j].x + v[j].y * v[j].y) + (v[j].z * v[j].z + v[j].w * v[j].w); }
        const float rs = 1.0f / sqrtf(wave_sum(ss) * (1.0f / D_) + 1e-6f);
#pragma unroll
        for (int j = 0; j < 4; ++j) { const int col = 4 * lane + 256 * j;
            const f32x4 g = *(const f32x4*)(gain + col), s1 = *(const f32x4*)(sc + (size_t)b * 6144 + col), s0 = *(const f32x4*)(sh + (size_t)b * 6144 + col);
            const f32x4 h = v[j] * rs * g * (s1 + 1.0f) + s0;
            u32x2 w; w.x = pk2(h.x, h.y); w.y = pk2(h.z, h.w); *(u32x2*)(H + (size_t)row * D_ + col) = w; }
    }
}
__device__ __forceinline__ void phase_final(float* x, const float* gain) {
    const int tid = otid(), wid = tid >> 6, lane = tid & 63, gw = blockIdx.x * 8 + wid, NGW = gridDim.x * 8;
    for (int row = gw; row < M_; row += NGW) {
        f32x4* xr = (f32x4*)(x + (size_t)row * D_) + lane; f32x4 v[4]; float ss = 0.f;
#pragma unroll
        for (int j = 0; j < 4; ++j) { v[j] = xr[64 * j]; ss += (v[j].x * v[j].x + v[j].y * v[j].y) + (v[j].z * v[j].z + v[j].w * v[j].w); }
        const float rs = 1.0f / sqrtf(wave_sum(ss) * (1.0f / D_) + 1e-6f);
#pragma unroll
        for (int j = 0; j < 4; ++j) { const f32x4 g = *(const f32x4*)(gain + 4 * lane + 256 * j); xr[64 * j] = v[j] * rs * g; }
    }
}
#define XB_TMO      128
#define XB_XCNT(j)  (256  + 64 * (j))
#define XB_XSUB(j)  (1280 + 64 * (j))
#define XB_XGEN(j)  (2304 + 64 * (j))
#define XB_TOP      3328
#define XB_TOPGEN   3392
#define XCD_BAR_WORDS 3456
#define XB_SPIN_CAP (1u << 18)

__device__ __forceinline__ unsigned xb_ld(unsigned* p)              { return __hip_atomic_load(p, __ATOMIC_RELAXED, __HIP_MEMORY_SCOPE_AGENT); }
__device__ __forceinline__ unsigned xb_add(unsigned* p, unsigned v) { return __hip_atomic_fetch_add(p, v, __ATOMIC_RELAXED, __HIP_MEMORY_SCOPE_AGENT); }
__device__ __forceinline__ unsigned xb_xcc_id() { return (unsigned)__builtin_amdgcn_s_getreg((3 << 11) | 20) & 0xFu; }
#define XB_SPIN(cond, bar) do { unsigned _sp = 0; while (cond) { __builtin_amdgcn_s_sleep(1); \
    if ((++_sp & 255u) == 0u) { if (xb_ld(&(bar)[XB_TMO])) break; if (_sp > XB_SPIN_CAP) { atomicAdd(&(bar)[XB_TMO], 1u); break; } } } } while (0)

struct XcdBarrier {
    unsigned* bar; unsigned x;
    volatile LAS unsigned* st;
};

__device__ __forceinline__ XcdBarrier xcd_barrier_post(unsigned* bar, volatile LAS unsigned* st) {
    XcdBarrier b; b.bar = bar; b.x = xb_xcc_id(); b.st = st;
    if (threadIdx.x == 0) (void)xb_add(&bar[XB_XCNT(b.x)], 1u);
    return b;
}
__device__ __forceinline__ void xcd_barrier_complete(unsigned* bar, unsigned x, unsigned& nloc, unsigned& nx) {
    const unsigned G = gridDim.x * gridDim.y * gridDim.z;
    unsigned sum, cnt, mine, sp = 0u;
    for (;;) {
        sum = 0u; cnt = 0u; mine = 0u;
#pragma unroll
        for (unsigned j = 0; j < 16; ++j) { const unsigned c = xb_ld(&bar[XB_XCNT(j)]); sum += c; cnt += (c > 0u) ? 1u : 0u; mine = (j == x) ? c : mine; }
        if (sum == G) break;
        __builtin_amdgcn_s_sleep(1);
        if ((++sp & 255u) == 0u) { if (xb_ld(&bar[XB_TMO])) break; if (sp > XB_SPIN_CAP) { atomicAdd(&bar[XB_TMO], 1u); break; } }
    }
    nloc = mine > 0u ? mine : 1u; nx = cnt > 0u ? cnt : 1u;
}

__device__ __forceinline__ void xcd_barrier(const XcdBarrier& b) {
    asm volatile("s_waitcnt vmcnt(0)" ::: "memory");
    __syncthreads();
    if (threadIdx.x == 0) {
        unsigned* bar = b.bar;
        __builtin_amdgcn_s_waitcnt(0);
        unsigned nloc = b.st[0], nx = b.st[1];
        if (nloc == 0u) { xcd_barrier_complete(bar, b.x, nloc, nx); b.st[0] = nloc; b.st[1] = nx; }
        const unsigned old = xb_add(&bar[XB_XSUB(b.x)], 1u);
        const unsigned gen = old / nloc;
        if (old + 1u == (gen + 1u) * nloc) {
            __builtin_amdgcn_fence(__ATOMIC_RELEASE, "agent");
            asm volatile("s_waitcnt vmcnt(0)" ::: "memory");
            const unsigned og = xb_add(&bar[XB_TOP], 1u);
            const unsigned tg = og / nx;
            if (og + 1u == (tg + 1u) * nx) xb_add(&bar[XB_TOPGEN], 1u);
            else XB_SPIN(xb_ld(&bar[XB_TOPGEN]) == tg, bar);
            __builtin_amdgcn_fence(__ATOMIC_ACQUIRE, "agent");
            xb_add(&bar[XB_XGEN(b.x)], 1u);
            asm volatile("s_waitcnt vmcnt(0)" ::: "memory");
        } else {
            XB_SPIN(xb_ld(&bar[XB_XGEN(b.x)]) == gen, bar);
            __builtin_amdgcn_fence(__ATOMIC_ACQUIRE, "agent");
            asm volatile("s_waitcnt vmcnt(0)" ::: "memory");
        }
    }
    __syncthreads();
}

__device__ __forceinline__ float gelu_tanh(float x) { const float u = 0.7978845608f * (x + 0.044715f * x * x * x); const float e = __expf(2.0f * u); const float th = 1.0f - 2.0f / (e + 1.0f); return 0.5f * x * (1.0f + th); }
template <int MODE>
__device__ __forceinline__ void rg_item(const Args& a, int l, int item, int lane) {
    const int g = item & 3, c = (item >> 2) & 31, b = item >> 7, ch = 64 * g + lane, row0 = b * T_ + 64 * c;
    const bf16_t* P = (const bf16_t*)(a.ws + WS_P);
    float* AGG = (float*)(a.ws + WS_RGA);
    float Wr[64], Wi[64];
#pragma unroll
    for (int i = 0; i < 64; ++i) { Wr[i] = a.in[9][((size_t)(l * 4 + g) * 64 + i) * 64 + lane]; Wi[i] = a.in[11][((size_t)(l * 4 + g) * 64 + i) * 64 + lane]; }
    const float cw0 = a.in[7][(l * 4 + 0) * 256 + ch], cw1 = a.in[7][(l * 4 + 1) * 256 + ch], cw2 = a.in[7][(l * 4 + 2) * 256 + ch], cw3 = a.in[7][(l * 4 + 3) * 256 + ch];
    const float cb = a.in[8][l * 256 + ch], rb = a.in[10][l * 256 + ch], ib = a.in[12][l * 256 + ch], lam = a.in[13][l * 256 + ch];
    const float sp = log1pf(__expf(-lam));
    float xm3 = 0.f, xm2 = 0.f, xm1 = 0.f;
    if (c > 0) { xm3 = bf2f(P[(size_t)(row0 - 3) * PS_ + PAX + ch]); xm2 = bf2f(P[(size_t)(row0 - 2) * PS_ + PAX + ch]); xm1 = bf2f(P[(size_t)(row0 - 1) * PS_ + PAX + ch]); }
    float h = 0.f, Ap = 1.f, beta = 0.f;
    if (MODE == 1) { h = AGG[2 * 65536 + (b * 32 + c) * 256 + ch]; beta = a.in[26][l * 1024 + ch]; }
    bf16_t* Y = (bf16_t*)(a.ws + WS_HY);
    unsigned short xn[8], yn[8];
#pragma unroll
    for (int i = 0; i < 8; ++i) { xn[i] = P[(size_t)(row0 + i) * PS_ + PAX + ch]; yn[i] = (MODE == 1) ? P[(size_t)(row0 + i) * PS_ + PAY + ch] : (unsigned short)0; }
#pragma unroll 1
    for (int tg = 0; tg < 8; ++tg) {
        unsigned short xr[8], yr[8];
#pragma unroll
        for (int i = 0; i < 8; ++i) { xr[i] = xn[i]; yr[i] = yn[i]; }
        if (tg < 7) {
#pragma unroll
            for (int i = 0; i < 8; ++i) { xn[i] = P[(size_t)(row0 + 8 * tg + 8 + i) * PS_ + PAX + ch]; if (MODE == 1) yn[i] = P[(size_t)(row0 + 8 * tg + 8 + i) * PS_ + PAY + ch]; } }
#pragma unroll
        for (int i8 = 0; i8 < 8; ++i8) { const int t = 8 * tg + i8;
        const float xc = bf2f(xr[i8]);
        const float u = cb + cw0 * xm3 + cw1 * xm2 + cw2 * xm1 + cw3 * xc;
        xm3 = xm2; xm2 = xm1; xm1 = xc;
        float rp = rb, ip = ib;
#pragma unroll
        for (int i = 0; i < 64; ++i) { const float ui = __builtin_bit_cast(float, __builtin_amdgcn_readlane(__builtin_bit_cast(int, u), i)); rp += ui * Wr[i]; ip += ui * Wi[i]; }
        const float r = sigmoidf_(rp), ig = sigmoidf_(ip);
        const float log_a = -8.0f * r * sp, av = __expf(log_a);
        float mult = sqrtf(-expm1f(2.0f * log_a)); if (c == 0 && t == 0) mult = 1.0f;
        const float bv = mult * ig * u;
        h = av * h + bv;
        if (MODE == 0) Ap *= av;
        else { const float ya = bf2f(yr[i8]); const float y = h * gelu_tanh(ya);
            const float ss = wave_sum(y * y); const float o = y * (1.0f / sqrtf(ss * (1.0f / 64.0f) + 1e-6f)) * beta;
            Y[(size_t)(row0 + t) * D_ + ch] = (bf16_t)f2bf(o); }
        }
    }
    if (MODE == 0) { AGG[(b * 32 + c) * 256 + ch] = Ap; AGG[65536 + (b * 32 + c) * 256 + ch] = h; }
}
__device__ __forceinline__ void rg_carry(const Args& a, int gid) {
    float* AGG = (float*)(a.ws + WS_RGA); const int b = gid >> 8, ch = gid & 255; float H = 0.f; float Av[32], Bv[32];
#pragma unroll
    for (int c = 0; c < 32; ++c) { const int i = (b * 32 + c) * 256 + ch; Av[c] = AGG[i]; Bv[c] = AGG[65536 + i]; }
#pragma unroll
    for (int c = 0; c < 32; ++c) { const int i = (b * 32 + c) * 256 + ch; AGG[2 * 65536 + i] = H; H = Av[c] * H + Bv[c]; }
}
__device__ __forceinline__ f32x4 mfma16(bf16x8 x, bf16x8 y, f32x4 c) { return __builtin_amdgcn_mfma_f32_16x16x32_bf16(x, y, c, 0, 0, 0); }
constexpr int LST = 72;
template <int MODE>
__device__ __forceinline__ void hgrn_item(const Args& a, int l, int item, LAS unsigned char* lds) {
    const int tid = otid(), wid = tid >> 6, lane = tid & 63, fr = lane & 15, fq = lane >> 4;
    const int c = item & 31, bh = item >> 5, h = bh % 6, b = bh / 6, row0 = b * T_ + 64 * c;
    const bf16_t* P = (const bf16_t*)(a.ws + WS_P);
    bf16_t* KVT = (bf16_t*)(a.ws + WS_HKV) + (size_t)item * 4096;
    LAS float* PART = (LAS float*)lds;
    LAS float* RHO = (LAS float*)(lds + 2048);
    LAS float* BC = (LAS float*)(lds + 4096);
    LAS bf16_t* L0 = (LAS bf16_t*)(lds + 20480);
    LAS bf16_t* L1 = (LAS bf16_t*)(lds + 29696);
    LAS bf16_t* L2 = (LAS bf16_t*)(lds + 38912);
    LAS bf16_t* VT = (LAS bf16_t*)(lds + 48128);
    LAS bf16_t* AM = (LAS bf16_t*)(lds + 57344);
    LAS float* SS = (LAS float*)(lds + 66560);
    const int k = lane, pt = wid;
    const float* hl = a.in[14];
    float lbv = 0.f; if (l == 1) lbv = 1.0f / (1.0f + __expf(hl[64 * h + k] - hl[384 + 64 * h + k]));
    float bc[8], kvv[8]; float s = 0.f;
#pragma unroll
    for (int i = 0; i < 8; ++i) { const float z = bf2f(P[(size_t)(row0 + 8 * pt + i) * PS_ + PBF + 64 * h + k]);
        const float sg = 1.0f / (1.0f + __expf(-z)); const float f = fmaxf(lbv + (1.0f - lbv) * sg, 1e-37f);
        s += __logf(f); bc[i] = s; kvv[i] = (1.0f - lbv) / (1.0f + __expf(z)); }
    PART[pt * 64 + k] = s;
    { unsigned short vv[8];
#pragma unroll
      for (int i = 0; i < 8; ++i) vv[i] = P[(size_t)(row0 + 8 * pt + i) * PS_ + PBV + 64 * h + k];
      u32x4 w; w.x = vv[0] | ((unsigned)vv[1] << 16); w.y = vv[2] | ((unsigned)vv[3] << 16); w.z = vv[4] | ((unsigned)vv[5] << 16); w.w = vv[6] | ((unsigned)vv[7] << 16);
      *(LAS u32x4*)(VT + k * LST + 8 * pt) = w; }
    __syncthreads();
    float off = 0.f, tot = 0.f, rho = 0.f;
#pragma unroll
    for (int p = 0; p < 8; ++p) { const float v = PART[p * 64 + k]; if (p < pt) off += v; if (p < 4) rho += v; tot += v; }
#pragma unroll
    for (int i = 0; i < 8; ++i) bc[i] += off;
    if (MODE == 0) {
        u32x4 w; float e[8];
#pragma unroll
        for (int i = 0; i < 8; ++i) e[i] = kvv[i] * __expf(tot - bc[i]);
        w.x = pk2(e[0], e[1]); w.y = pk2(e[2], e[3]); w.z = pk2(e[4], e[5]); w.w = pk2(e[6], e[7]);
        *(LAS u32x4*)(L0 + k * LST + 8 * pt) = w;
        if (pt == 0) ((float*)(a.ws + WS_HDEC))[(size_t)item * 64 + k] = __expf(tot);
        __syncthreads();
        const int kt = wid >> 1;
#pragma unroll
        for (int q = 0; q < 2; ++q) { const int vt = 2 * (wid & 1) + q; f32x4 acc = {0.f, 0.f, 0.f, 0.f};
#pragma unroll
            for (int ks = 0; ks < 2; ++ks) { const bf16x8 x = *(const LAS bf16x8*)(L0 + (16 * kt + fr) * LST + 32 * ks + 8 * fq), y = *(const LAS bf16x8*)(VT + (16 * vt + fr) * LST + 32 * ks + 8 * fq);
                acc = mfma16(x, y, acc); }
            u32x2 w2; w2.x = pk2(acc[0], acc[1]); w2.y = pk2(acc[2], acc[3]);
            *(u32x2*)(KVT + (16 * vt + fr) * 64 + 16 * kt + 4 * fq) = w2; }
        __syncthreads();
    } else {
#pragma unroll
        for (int i = 0; i < 8; ++i) BC[(8 * pt + i) * 64 + k] = bc[i];
        if (pt == 0) RHO[k] = rho;
        __syncthreads();
        { const int t2 = tid >> 3, kg = tid & 7;
          const u32x4 qw = *(const u32x4*)(P + (size_t)(row0 + t2) * PS_ + PBQ + 64 * h + 8 * kg), zw = *(const u32x4*)(P + (size_t)(row0 + t2) * PS_ + PBF + 64 * h + 8 * kg);
          float q[8], z[8], qp[8], qt[8], kt_[8];
          q[0] = bflo(qw.x); q[1] = bfhi(qw.x); q[2] = bflo(qw.y); q[3] = bfhi(qw.y); q[4] = bflo(qw.z); q[5] = bfhi(qw.z); q[6] = bflo(qw.w); q[7] = bfhi(qw.w);
          z[0] = bflo(zw.x); z[1] = bfhi(zw.x); z[2] = bflo(zw.y); z[3] = bfhi(zw.y); z[4] = bflo(zw.z); z[5] = bfhi(zw.z); z[6] = bflo(zw.w); z[7] = bfhi(zw.w);
#pragma unroll
          for (int i = 0; i < 8; ++i) { const int kk = 8 * kg + i; float lb2 = 0.f; if (l == 1) lb2 = 1.0f / (1.0f + __expf(hl[64 * h + kk] - hl[384 + 64 * h + kk]));
              const float kvl = (1.0f - lb2) / (1.0f + __expf(z[i])); const float bcv = BC[t2 * 64 + kk], rh = RHO[kk]; const float qs = q[i] * 0.125f;
              qp[i] = qs * __expf(bcv); qt[i] = qs * __expf(bcv - rh); kt_[i] = kvl * __expf(rh - bcv); }
          u32x4 w; w.x = pk2(qp[0], qp[1]); w.y = pk2(qp[2], qp[3]); w.z = pk2(qp[4], qp[5]); w.w = pk2(qp[6], qp[7]); *(LAS u32x4*)(L0 + t2 * LST + 8 * kg) = w;
          w.x = pk2(qt[0], qt[1]); w.y = pk2(qt[2], qt[3]); w.z = pk2(qt[4], qt[5]); w.w = pk2(qt[6], qt[7]); *(LAS u32x4*)(L1 + t2 * LST + 8 * kg) = w;
          w.x = pk2(kt_[0], kt_[1]); w.y = pk2(kt_[2], kt_[3]); w.z = pk2(kt_[4], kt_[5]); w.w = pk2(kt_[6], kt_[7]); *(LAS u32x4*)(L2 + t2 * LST + 8 * kg) = w; }
        __syncthreads();
        const int tt = wid >> 1;
#pragma unroll
        for (int q = 0; q < 2; ++q) { const int st = 2 * (wid & 1) + q; f32x4 acc = {0.f, 0.f, 0.f, 0.f};
            if (st <= tt) {
#pragma unroll
                for (int ks = 0; ks < 2; ++ks) { const bf16x8 x = *(const LAS bf16x8*)(L2 + (16 * st + fr) * LST + 32 * ks + 8 * fq), y = *(const LAS bf16x8*)(L1 + (16 * tt + fr) * LST + 32 * ks + 8 * fq);
                    acc = mfma16(x, y, acc); }
                const int t = 16 * tt + fr;
#pragma unroll
                for (int j = 0; j < 4; ++j) { const int sidx = 16 * st + 4 * fq + j; if (sidx > t) acc[j] = 0.f; }
            }
            u32x2 w2; w2.x = pk2(acc[0], acc[1]); w2.y = pk2(acc[2], acc[3]);
            *(LAS u32x2*)(AM + (16 * tt + fr) * LST + 16 * st + 4 * fq) = w2; }
        __syncthreads();
        f32x4 o[2]; float ss = 0.f;
#pragma unroll
        for (int q = 0; q < 2; ++q) { const int vt = 2 * (wid & 1) + q; f32x4 acc = {0.f, 0.f, 0.f, 0.f};
#pragma unroll
            for (int ks = 0; ks < 2; ++ks) { const bf16x8 x = *(const bf16x8*)(KVT + (16 * vt + fr) * 64 + 32 * ks + 8 * fq), y = *(const LAS bf16x8*)(L0 + (16 * tt + fr) * LST + 32 * ks + 8 * fq);
                acc = mfma16(x, y, acc); }
#pragma unroll
            for (int ks = 0; ks < 2; ++ks) { const bf16x8 x = *(const LAS bf16x8*)(VT + (16 * vt + fr) * LST + 32 * ks + 8 * fq), y = *(const LAS bf16x8*)(AM + (16 * tt + fr) * LST + 32 * ks + 8 * fq);
                acc = mfma16(x, y, acc); }
            o[q] = acc; ss += (acc[0] * acc[0] + acc[1] * acc[1]) + (acc[2] * acc[2] + acc[3] * acc[3]); }
        ss += __shfl_xor(ss, 16); ss += __shfl_xor(ss, 32);
        if (fq == 0) SS[wid * 16 + fr] = ss;
        __syncthreads();
        const float tot2 = SS[wid * 16 + fr] + SS[(wid ^ 1) * 16 + fr];
        const float rs = 1.0f / sqrtf(tot2 * (1.0f / 64.0f) + 1e-6f);
        bf16_t* Y = (bf16_t*)(a.ws + WS_HY);
#pragma unroll
        for (int q = 0; q < 2; ++q) { const int vt = 2 * (wid & 1) + q, t = 16 * tt + fr, cv = 64 * h + 16 * vt + 4 * fq;
            const u32x2 gw2 = *(const u32x2*)(P + (size_t)(row0 + t) * PS_ + PBG + cv);
            const f32x4 be = *(const f32x4*)(a.in[26] + l * 1024 + 256 + cv);
            float gg[4] = {bflo(gw2.x), bfhi(gw2.x), bflo(gw2.y), bfhi(gw2.y)}; float r[4];
#pragma unroll
            for (int j = 0; j < 4; ++j) r[j] = o[q][j] * rs * (gg[j] * sigmoidf_(gg[j])) * be[j];
            u32x2 w2; w2.x = pk2(r[0], r[1]); w2.y = pk2(r[2], r[3]);
            *(u32x2*)(Y + (size_t)(row0 + t) * D_ + 256 + cv) = w2; }
        __syncthreads();
    }
}
__device__ __forceinline__ void hgrn_scan(const Args& a, int e) {
    bf16_t* KVT = (bf16_t*)(a.ws + WS_HKV); const float* DEC = (const float*)(a.ws + WS_HDEC);
    const int bh = e >> 12, vk = e & 4095, k = vk & 63; float S = 0.f; unsigned short kv[32]; float dc[32];
#pragma unroll
    for (int c = 0; c < 32; ++c) { kv[c] = KVT[((size_t)(bh * 32 + c) << 12) + vk]; dc[c] = DEC[(bh * 32 + c) * 64 + k]; }
#pragma unroll
    for (int c = 0; c < 32; ++c) { KVT[((size_t)(bh * 32 + c) << 12) + vk] = (bf16_t)f2bf(S); S = dc[c] * S + bf2f(kv[c]); }
}
__device__ __forceinline__ f32x4 mfma16k16(s16x4 x, s16x4 y, f32x4 c) { return __builtin_amdgcn_mfma_f32_16x16x16bf16_1k(x, y, c, 0, 0, 0); }
__device__ __forceinline__ s16x4 pack4(f32x4 v) { u32x2 w; w.x = pk2(v[0], v[1]); w.y = pk2(v[2], v[3]); return __builtin_bit_cast(s16x4, w); }
__device__ __forceinline__ void unpack8(const u32x4 w, float* o) { o[0] = bflo(w.x); o[1] = bfhi(w.x); o[2] = bflo(w.y); o[3] = bfhi(w.y); o[4] = bflo(w.z); o[5] = bfhi(w.z); o[6] = bflo(w.w); o[7] = bfhi(w.w); }
__device__ __forceinline__ u32x4 pack8(const float* e) { u32x4 w; w.x = pk2(e[0], e[1]); w.y = pk2(e[2], e[3]); w.z = pk2(e[4], e[5]); w.w = pk2(e[6], e[7]); return w; }
__device__ __forceinline__ void shift8(const bf16_t* P, size_t row, bool has_prev, int col, const float* mu, float* o) {
    const u32x4 cw = *(const u32x4*)(P + row * PS_ + PC + col); u32x4 pw = {0u, 0u, 0u, 0u}; if (has_prev) pw = *(const u32x4*)(P + (row - 1) * PS_ + PC + col);
    float c[8], p[8]; unpack8(cw, c); unpack8(pw, p); const f32x4 m0 = *(const f32x4*)(mu + col), m1 = *(const f32x4*)(mu + col + 4);
#pragma unroll
    for (int i = 0; i < 8; ++i) o[i] = c[i] + (p[i] - c[i]) * (i < 4 ? m0[i] : m1[i - 4]);
}
constexpr int RW_LIN = 0, RW_LINS = 264;
constexpr int RW_RH = 0, RW_YL = 18432, RW_YLS = 68;
constexpr int RW_CUM = 33792, RW_PART = 50176;
constexpr int RW_LO = 52224, RW_LOS = 68;
constexpr int RW_AT = 52224, RW_BD = 61440, RW_KD = 70656, RW_RT = 79872, RW_BTT = 89088, RW_KTT = 98304, RW_VT = 107520, RW_NAB = 116736, RW_AK = 125952;
constexpr int RW_ARB = RW_BTT, RW_ARK = RW_KTT;
constexpr int RW_NABF = 135168, RW_TII = 139264;
template <int MODE>
__device__ __forceinline__ void rwkv_chunk(const Args& a, int l, int item, LAS unsigned char* lds) {
    const int tid = otid(), wid = tid >> 6, lane = tid & 63, fr = lane & 15, fq = lane >> 4;
    const int c = item & 31, bh = item >> 5, h = bh % 6, b = bh / 6;
    const size_t row0 = (size_t)b * T_ + 64 * c;
    const bf16_t* P = (const bf16_t*)(a.ws + WS_P);
    const bf16_t* LW = (const bf16_t*)(a.ws + WS_LORA) + (size_t)l * 98304;
    const float* mu = a.in[15] + l * 1408;
    LAS bf16_t* LIN = (LAS bf16_t*)(lds + RW_LIN);
    LAS float* CUM = (LAS float*)(lds + RW_CUM); LAS float* PART = (LAS float*)(lds + RW_PART); LAS float* LO = (LAS float*)(lds + RW_LO);
    LAS bf16_t* AT = (LAS bf16_t*)(lds + RW_AT); LAS bf16_t* BD = (LAS bf16_t*)(lds + RW_BD); LAS bf16_t* KD = (LAS bf16_t*)(lds + RW_KD); LAS bf16_t* RT = (LAS bf16_t*)(lds + RW_RT);
    LAS bf16_t* BTT = (LAS bf16_t*)(lds + RW_BTT); LAS bf16_t* KTT = (LAS bf16_t*)(lds + RW_KTT); LAS bf16_t* VT = (LAS bf16_t*)(lds + RW_VT);
    LAS bf16_t* NAB = (LAS bf16_t*)(lds + RW_NAB); LAS bf16_t* AK = (LAS bf16_t*)(lds + RW_AK); LAS bf16_t* ARB = (LAS bf16_t*)(lds + RW_ARB); LAS bf16_t* ARK = (LAS bf16_t*)(lds + RW_ARK);
    LAS float* NABF = (LAS float*)(lds + RW_NABF); LAS bf16_t* TII = (LAS bf16_t*)(lds + RW_TII);
    const int t2 = tid >> 3, kg = tid & 7; const size_t row = row0 + t2; const bool has_prev = (c > 0) || (t2 > 0);
    {
#pragma unroll
        for (int q = 0; q < 4; ++q) { float ps[8]; const int col = 32 * kg + 8 * q; shift8(P, row, has_prev, 1152 + col, mu, ps);
#pragma unroll
            for (int i = 0; i < 8; ++i) { if (kg < 2) { const float e = __expf(2.0f * ps[i]); ps[i] = 1.0f - 2.0f / (e + 1.0f); } else if (kg >= 4) ps[i] = sigmoidf_(ps[i]); }
            *(LAS u32x4*)(LIN + t2 * RW_LINS + col) = pack8(ps); }
    }
    float rr[8], kx[8], vx[8];
    shift8(P, row, has_prev, 64 * h + 8 * kg, mu, rr); shift8(P, row, has_prev, 384 + 64 * h + 8 * kg, mu, kx); shift8(P, row, has_prev, 768 + 64 * h + 8 * kg, mu, vx);
    __syncthreads();
    { const int tt = wid >> 1;
#pragma unroll
      for (int q = 0; q < 2; ++q) { const int ct = 2 * (wid & 1) + q; const int crow = 64 * h + 16 * ct + fr;
          f32x4 aw = {0.f, 0.f, 0.f, 0.f}, aa = {0.f, 0.f, 0.f, 0.f}, ag = {0.f, 0.f, 0.f, 0.f};
#pragma unroll
          for (int ks = 0; ks < 2; ++ks) { const bf16x8 x = *(const LAS bf16x8*)(LIN + (16 * tt + fr) * RW_LINS + 32 * ks + 8 * fq), y = *(const bf16x8*)(LW + (size_t)crow * 64 + 32 * ks + 8 * fq); aw = mfma16(x, y, aw); }
#pragma unroll
          for (int ks = 0; ks < 2; ++ks) { const bf16x8 x = *(const LAS bf16x8*)(LIN + (16 * tt + fr) * RW_LINS + 64 + 32 * ks + 8 * fq), y = *(const bf16x8*)(LW + 24576 + (size_t)crow * 64 + 32 * ks + 8 * fq); aa = mfma16(x, y, aa); }
#pragma unroll
          for (int ks = 0; ks < 4; ++ks) { const bf16x8 x = *(const LAS bf16x8*)(LIN + (16 * tt + fr) * RW_LINS + 128 + 32 * ks + 8 * fq), y = *(const bf16x8*)(LW + 49152 + (size_t)crow * 128 + 32 * ks + 8 * fq); ag = mfma16(x, y, ag); }
#pragma unroll
          for (int j = 0; j < 4; ++j) { const int o = (16 * tt + 4 * fq + j) * RW_LOS + 16 * ct + fr; LO[o] = aw[j]; LO[64 * RW_LOS + o] = aa[j]; LO[2 * 64 * RW_LOS + o] = ag[j]; } }
    }
    __syncthreads();
    float gg[8], lw[8], be[8], al[8], kp[8]; float rkt = 0.f;
    { const int cb = l * 384 + 64 * h + 8 * kg; float wa[8], av[8];
      *(f32x4*)&wa[0] = *(const LAS f32x4*)(LO + t2 * RW_LOS + 8 * kg); *(f32x4*)&wa[4] = *(const LAS f32x4*)(LO + t2 * RW_LOS + 8 * kg + 4);
      *(f32x4*)&av[0] = *(const LAS f32x4*)(LO + 64 * RW_LOS + t2 * RW_LOS + 8 * kg); *(f32x4*)&av[4] = *(const LAS f32x4*)(LO + 64 * RW_LOS + t2 * RW_LOS + 8 * kg + 4);
      *(f32x4*)&gg[0] = *(const LAS f32x4*)(LO + 128 * RW_LOS + t2 * RW_LOS + 8 * kg); *(f32x4*)&gg[4] = *(const LAS f32x4*)(LO + 128 * RW_LOS + t2 * RW_LOS + 8 * kg + 4);
      float ssq = 0.f, kkr[8];
#pragma unroll
      for (int i = 0; i < 8; ++i) { const float wp = wa[i] + a.in[16][cb + i]; const float w = -log1pf(__expf(-wp)) - 0.5f; lw[i] = -__expf(w);
          const float aa = sigmoidf_(av[i] + a.in[18][cb + i]);
          kkr[i] = kx[i] * a.in[21][cb + i]; ssq += kkr[i] * kkr[i];
          kp[i] = kx[i] * (1.0f + (aa - 1.0f) * a.in[22][cb + i]); be[i] = aa;
          rkt += rr[i] * kp[i] * a.in[23][cb + i]; }
      ssq += __shfl_xor(ssq, 1); ssq += __shfl_xor(ssq, 2); ssq += __shfl_xor(ssq, 4);
      rkt += __shfl_xor(rkt, 1); rkt += __shfl_xor(rkt, 2); rkt += __shfl_xor(rkt, 4);
      const float rn = 1.0f / sqrtf(ssq + 1e-12f);
#pragma unroll
      for (int i = 0; i < 8; ++i) { const float kk = kkr[i] * rn; al[i] = -kk; be[i] = kk * be[i]; }
#pragma unroll
      for (int i = 0; i < 8; ++i) CUM[t2 * 64 + 8 * kg + i] = lw[i];
    }
    __syncthreads();
    { const int k = lane, pt = wid; float s = 0.f; float cv[8];
#pragma unroll
      for (int i = 0; i < 8; ++i) { s += CUM[(8 * pt + i) * 64 + k]; cv[i] = s; }
      PART[pt * 64 + k] = s;
      __syncthreads();
      float off = 0.f;
#pragma unroll
      for (int p = 0; p < 8; ++p) { const float v = PART[p * 64 + k]; if (p < pt) off += v; }
#pragma unroll
      for (int i = 0; i < 8; ++i) CUM[(8 * pt + i) * 64 + k] = cv[i] + off;
    }
    __syncthreads();
    { float cu[8], cl[8], e[8];
      *(f32x4*)&cu[0] = *(const LAS f32x4*)(CUM + t2 * 64 + 8 * kg); *(f32x4*)&cu[4] = *(const LAS f32x4*)(CUM + t2 * 64 + 8 * kg + 4);
      *(f32x4*)&cl[0] = *(const LAS f32x4*)(CUM + 63 * 64 + 8 * kg); *(f32x4*)&cl[4] = *(const LAS f32x4*)(CUM + 63 * 64 + 8 * kg + 4);
#pragma unroll
      for (int i = 0; i < 8; ++i) e[i] = al[i] * __expf(cu[i] - lw[i]);
      *(LAS u32x4*)(AT + t2 * LST + 8 * kg) = pack8(e);
      float en[8];
#pragma unroll
      for (int i = 0; i < 8; ++i) en[i] = __expf(-cu[i]);
#pragma unroll
      for (int i = 0; i < 8; ++i) e[i] = be[i] * en[i];
      *(LAS u32x4*)(BD + t2 * LST + 8 * kg) = pack8(e);
#pragma unroll
      for (int i = 0; i < 8; ++i) e[i] = kp[i] * en[i];
      *(LAS u32x4*)(KD + t2 * LST + 8 * kg) = pack8(e);
      if (MODE == 1) {
#pragma unroll
          for (int i = 0; i < 8; ++i) e[i] = rr[i] * __expf(cu[i]);
          *(LAS u32x4*)(RT + t2 * LST + 8 * kg) = pack8(e);
      } else {
#pragma unroll
          for (int i = 0; i < 8; ++i) { const float ed = __expf(cl[i] - cu[i]); BTT[(8 * kg + i) * LST + t2] = (bf16_t)f2bf(be[i] * ed); KTT[(8 * kg + i) * LST + t2] = (bf16_t)f2bf(kp[i] * ed); }
          if (t2 == 63) {
#pragma unroll
              for (int i = 0; i < 8; ++i) ((float*)(a.ws + WS_RGAM))[(size_t)item * 64 + 8 * kg + i] = __expf(cl[i]); }
      }
#pragma unroll
      for (int i = 0; i < 8; ++i) VT[(8 * kg + i) * LST + t2] = (bf16_t)f2bf(vx[i]);
    }
    __syncthreads();
    { const int tt = wid >> 1;
#pragma unroll
      for (int q = 0; q < 2; ++q) { const int st = 2 * (wid & 1) + q;
          f32x4 ab = {0.f, 0.f, 0.f, 0.f}, ak = {0.f, 0.f, 0.f, 0.f}, rb = {0.f, 0.f, 0.f, 0.f}, rk = {0.f, 0.f, 0.f, 0.f};
          if (st <= tt) {
#pragma unroll
              for (int ks = 0; ks < 2; ++ks) { const int ao = (16 * st + fr) * LST + 32 * ks + 8 * fq, bo = (16 * tt + fr) * LST + 32 * ks + 8 * fq;
                  const bf16x8 xb = *(const LAS bf16x8*)(BD + ao), xk = *(const LAS bf16x8*)(KD + ao), ya = *(const LAS bf16x8*)(AT + bo);
                  ab = mfma16(xb, ya, ab); ak = mfma16(xk, ya, ak);
                  if (MODE == 1) { const bf16x8 yr = *(const LAS bf16x8*)(RT + bo); rb = mfma16(xb, yr, rb); rk = mfma16(xk, yr, rk); } }
              const int t = 16 * tt + fr;
#pragma unroll
              for (int j = 0; j < 4; ++j) { const int s = 16 * st + 4 * fq + j; if (s >= t) { ab[j] = 0.f; ak[j] = 0.f; } if (s > t) { rb[j] = 0.f; rk[j] = 0.f; } }
              if (st == tt) *(LAS f32x4*)(NABF + tt * 256 + fr * 16 + 4 * fq) = ab;
          }
          const int o = (16 * tt + fr) * LST + 16 * st + 4 * fq;
          *(LAS s16x4*)(NAB + o) = pack4(ab); *(LAS s16x4*)(AK + o) = pack4(ak);
          if (MODE == 1) { *(LAS s16x4*)(ARB + o) = pack4(rb); *(LAS s16x4*)(ARK + o) = pack4(rk); } }
    }
    __syncthreads();
    f32x4 R[4];
    if (wid == 0) { const int blk = fq, j = fr; float Tc[16];
#pragma unroll
        for (int i = 0; i < 16; ++i) { float acc = (i == j) ? 1.0f : 0.0f;
#pragma unroll
            for (int m = 0; m < 16; ++m) if (m < i) acc += NABF[blk * 256 + i * 16 + m] * Tc[m];
            Tc[i] = acc; TII[blk * 256 + i * 16 + j] = (bf16_t)f2bf(acc); }
    }
    if (wid >= 4) { const int vt = wid - 4;
#pragma unroll
        for (int I = 0; I < 4; ++I) { f32x4 acc = {0.f, 0.f, 0.f, 0.f};
#pragma unroll
            for (int ks = 0; ks < 2; ++ks) { const bf16x8 x = *(const LAS bf16x8*)(AK + (16 * I + fr) * LST + 32 * ks + 8 * fq), y = *(const LAS bf16x8*)(VT + (16 * vt + fr) * LST + 32 * ks + 8 * fq); acc = mfma16(x, y, acc); }
            R[I] = acc; }
    } else {
#pragma unroll
        for (int I = 0; I < 4; ++I)
#pragma unroll
            for (int j = 0; j < 4; ++j) R[I][j] = bf2f(AT[(16 * I + 4 * fq + j) * LST + 16 * wid + fr]);
    }
    __syncthreads();
    s16x4 Xb[4];
#pragma unroll
    for (int I = 0; I < 4; ++I) { f32x4 acc = R[I];
#pragma unroll
        for (int J = 0; J < 4; ++J) if (J < I) acc = mfma16k16(*(const LAS s16x4*)(NAB + (16 * I + fr) * LST + 16 * J + 4 * fq), Xb[J], acc);
        const f32x4 z = {0.f, 0.f, 0.f, 0.f};
        const f32x4 x = mfma16k16(*(const LAS s16x4*)(TII + I * 256 + fr * 16 + 4 * fq), pack4(acc), z);
        Xb[I] = pack4(x); }
    s16x4 Vf[4];
    if (wid >= 4) {
#pragma unroll
        for (int J = 0; J < 4; ++J) Vf[J] = *(const LAS s16x4*)(VT + (16 * (wid - 4) + fr) * LST + 16 * J + 4 * fq); }
    if (MODE == 0) {
#pragma unroll
        for (int kt = 0; kt < 4; ++kt) { f32x4 acc = {0.f, 0.f, 0.f, 0.f};
#pragma unroll
            for (int J = 0; J < 4; ++J) acc = mfma16k16(*(const LAS s16x4*)(BTT + (16 * kt + fr) * LST + 16 * J + 4 * fq), Xb[J], acc);
            if (wid >= 4) {
#pragma unroll
                for (int J = 0; J < 4; ++J) acc = mfma16k16(*(const LAS s16x4*)(KTT + (16 * kt + fr) * LST + 16 * J + 4 * fq), Vf[J], acc);
                *(s16x4*)((bf16_t*)(a.ws + WS_RN) + (size_t)item * 4096 + ((kt * 4 + (wid - 4)) * 64 + lane) * 4) = pack4(acc);
            } else { bf16_t* RM = (bf16_t*)(a.ws + WS_RM) + (size_t)item * 4096;
#pragma unroll
                for (int j = 0; j < 4; ++j) RM[(16 * kt + 4 * fq + j) * 64 + 16 * wid + fr] = (bf16_t)f2bf(acc[j]); } }
        __syncthreads();
    } else {
        LAS bf16_t* RH = (LAS bf16_t*)(lds + RW_RH); LAS float* YL = (LAS float*)(lds + RW_YL);
        f32x4 yh[4];
#pragma unroll
        for (int tt = 0; tt < 4; ++tt) { f32x4 acc = {0.f, 0.f, 0.f, 0.f};
            if (wid < 4) {
#pragma unroll
                for (int j = 0; j < 4; ++j) acc[j] = bf2f(RT[(16 * tt + 4 * fq + j) * LST + 16 * wid + fr]); }
#pragma unroll
            for (int J = 0; J < 4; ++J) if (J <= tt) acc = mfma16k16(*(const LAS s16x4*)(ARB + (16 * tt + fr) * LST + 16 * J + 4 * fq), Xb[J], acc);
            if (wid >= 4) {
#pragma unroll
                for (int J = 0; J < 4; ++J) if (J <= tt) acc = mfma16k16(*(const LAS s16x4*)(ARK + (16 * tt + fr) * LST + 16 * J + 4 * fq), Vf[J], acc);
                yh[tt] = acc;
            } else {
#pragma unroll
                for (int j = 0; j < 4; ++j) RH[(16 * tt + 4 * fq + j) * LST + 16 * wid + fr] = (bf16_t)f2bf(acc[j]); } }
        __syncthreads();
        if (wid >= 4) { const int vt = wid - 4; s16x4 S0[4];
#pragma unroll
            for (int kt = 0; kt < 4; ++kt) S0[kt] = *(const s16x4*)((const bf16_t*)(a.ws + WS_RN) + (size_t)item * 4096 + ((kt * 4 + vt) * 64 + lane) * 4);
#pragma unroll
            for (int tt = 0; tt < 4; ++tt) { f32x4 acc = yh[tt];
#pragma unroll
                for (int kt = 0; kt < 4; ++kt) acc = mfma16k16(*(const LAS s16x4*)(RH + (16 * tt + fr) * LST + 16 * kt + 4 * fq), S0[kt], acc);
#pragma unroll
                for (int j = 0; j < 4; ++j) YL[(16 * tt + 4 * fq + j) * RW_YLS + 16 * vt + fr] = acc[j]; } }
        __syncthreads();
        { const int cb = l * 384 + 64 * h + 8 * kg; float y[8];
          *(f32x4*)&y[0] = *(const LAS f32x4*)(YL + t2 * RW_YLS + 8 * kg); *(f32x4*)&y[4] = *(const LAS f32x4*)(YL + t2 * RW_YLS + 8 * kg + 4);
          float sm = 0.f;
#pragma unroll
          for (int i = 0; i < 8; ++i) sm += y[i];
          sm += __shfl_xor(sm, 1); sm += __shfl_xor(sm, 2); sm += __shfl_xor(sm, 4);
          const float mean = sm * (1.0f / 64.0f); float vr = 0.f;
#pragma unroll
          for (int i = 0; i < 8; ++i) { y[i] -= mean; vr += y[i] * y[i]; }
          vr += __shfl_xor(vr, 1); vr += __shfl_xor(vr, 2); vr += __shfl_xor(vr, 4);
          const float rs = 1.0f / sqrtf(vr * (1.0f / 64.0f) + 64e-5f); float o[8];
#pragma unroll
          for (int i = 0; i < 8; ++i) o[i] = ((y[i] * rs * a.in[24][cb + i] + a.in[25][cb + i]) + rkt * vx[i]) * gg[i] * a.in[26][l * 1024 + 640 + 64 * h + 8 * kg + i];
          *(u32x4*)((bf16_t*)(a.ws + WS_HY) + row * D_ + 640 + 64 * h + 8 * kg) = pack8(o); }
        __syncthreads();
    }
}
__device__ __forceinline__ void rwkv_scan(const Args& a, int bh, int vt, int lane) {
    const int fr = lane & 15, fq = lane >> 4;
    const bf16_t* RM = (const bf16_t*)(a.ws + WS_RM); bf16_t* RN = (bf16_t*)(a.ws + WS_RN); const float* GAM = (const float*)(a.ws + WS_RGAM);
    f32x4 S[4];
#pragma unroll
    for (int k = 0; k < 4; ++k) S[k] = (f32x4){0.f, 0.f, 0.f, 0.f};
    s16x4 Mn[4][4]; s16x4 Nn[4]; f32x4 gn[4];
#define RWS_LOAD(cc) { const size_t it_ = (size_t)bh * 32 + (cc); _Pragma("unroll") for (int kt = 0; kt < 4; ++kt) { _Pragma("unroll") for (int k2 = 0; k2 < 4; ++k2) Mn[kt][k2] = *(const s16x4*)(RM + it_ * 4096 + (16 * kt + fr) * 64 + 16 * k2 + 4 * fq); \
            Nn[kt] = *(const s16x4*)(RN + it_ * 4096 + ((kt * 4 + vt) * 64 + lane) * 4); gn[kt] = *(const f32x4*)(GAM + it_ * 64 + 16 * kt + 4 * fq); } }
    RWS_LOAD(0)
#pragma unroll 1
    for (int c = 0; c < 32; ++c) { const size_t item = (size_t)bh * 32 + c;
        s16x4 Mf[4][4]; s16x4 Nf[4]; f32x4 gam[4];
#pragma unroll
        for (int kt = 0; kt < 4; ++kt) { Nf[kt] = Nn[kt]; gam[kt] = gn[kt];
#pragma unroll
            for (int k2 = 0; k2 < 4; ++k2) Mf[kt][k2] = Mn[kt][k2]; }
        if (c < 31) RWS_LOAD(c + 1)
        s16x4 Sb[4];
#pragma unroll
        for (int k = 0; k < 4; ++k) { Sb[k] = pack4(S[k]); *(s16x4*)(RN + item * 4096 + ((k * 4 + vt) * 64 + lane) * 4) = Sb[k]; }
#pragma unroll
        for (int kt = 0; kt < 4; ++kt) { const u32x2 nw = __builtin_bit_cast(u32x2, Nf[kt]);
            f32x4 acc = gam[kt] * S[kt] + (f32x4){bflo(nw.x), bfhi(nw.x), bflo(nw.y), bfhi(nw.y)};
#pragma unroll
            for (int k2 = 0; k2 < 4; ++k2) acc = mfma16k16(Mf[kt][k2], Sb[k2], acc);
            S[kt] = acc; }
    }
#undef RWS_LOAD
}
__device__ __forceinline__ float shiftmix(const bf16_t* P, size_t row, int tglob, int col, float mu) {
    const float cur = bf2f(P[row * PS_ + PC + col]); const float prev = (tglob > 0) ? bf2f(P[(row - 1) * PS_ + PC + col]) : 0.f; return cur + (prev - cur) * mu; }
__device__ __forceinline__ void rwkv_seq(const Args& a, int l, int bh, LAS unsigned char* lds) {
    const int tid = otid(), wid = tid >> 6, lane = tid & 63, h = bh % 6, b = bh / 6;
    const bf16_t* P = (const bf16_t*)(a.ws + WS_P); bf16_t* Y = (bf16_t*)(a.ws + WS_HY);
    LAS float* LIN = (LAS float*)lds;
    LAS float* VEC = (LAS float*)(lds + 32768);
    LAS float* YL = (LAS float*)(lds + 90112);
    const float* mu = a.in[15] + l * 1408;
    float S[64];
#pragma unroll
    for (int k = 0; k < 64; ++k) S[k] = 0.f;
    const int t = tid >> 4, jg = tid & 15;
#pragma unroll 1
    for (int tb = 0; tb < T_; tb += 32) {
        const size_t row = (size_t)b * T_ + tb + t; const int tglob = tb + t;
#pragma unroll 4
        for (int i = 0; i < 16; ++i) { const int col = 16 * jg + i; const float ps = shiftmix(P, row, tglob, 1152 + col, mu[1152 + col]);
            float v; if (col < 64) { const float e = __expf(2.0f * ps); v = 1.0f - 2.0f / (e + 1.0f); } else if (col < 128) v = ps; else v = sigmoidf_(ps);
            LIN[t * 256 + col] = v; }
        __syncthreads();
        { const int cb = l * 384 + 64 * h + 4 * jg;
          f32x4 wacc = *(const f32x4*)(a.in[16] + cb), aacc = *(const f32x4*)(a.in[18] + cb), gacc = {0.f, 0.f, 0.f, 0.f};
          const float* wu = a.in[17] + (size_t)l * 64 * 384 + 64 * h + 4 * jg; const float* au = a.in[19] + (size_t)l * 64 * 384 + 64 * h + 4 * jg; const float* gu = a.in[20] + (size_t)l * 128 * 384 + 64 * h + 4 * jg;
#pragma unroll 4
          for (int i = 0; i < 64; ++i) { const float x = LIN[t * 256 + i]; wacc += x * *(const f32x4*)(wu + (size_t)i * 384); }
#pragma unroll 4
          for (int i = 0; i < 64; ++i) { const float x = LIN[t * 256 + 64 + i]; aacc += x * *(const f32x4*)(au + (size_t)i * 384); }
#pragma unroll 4
          for (int i = 0; i < 128; ++i) { const float x = LIN[t * 256 + 128 + i]; gacc += x * *(const f32x4*)(gu + (size_t)i * 384); }
          float kk[4], kp[4], aa[4], dec[4], rr[4], vv[4]; float ssq = 0.f;
#pragma unroll
          for (int j = 0; j < 4; ++j) { const int hc = 64 * h + 4 * jg + j;
              const float wp = wacc[j]; const float w = -log1pf(__expf(-wp)) - 0.5f; dec[j] = __expf(-__expf(w));
              aa[j] = sigmoidf_(aacc[j]);
              rr[j] = shiftmix(P, row, tglob, hc, mu[hc]); const float kx = shiftmix(P, row, tglob, 384 + hc, mu[384 + hc]); vv[j] = shiftmix(P, row, tglob, 768 + hc, mu[768 + hc]);
              kk[j] = kx * a.in[21][l * 384 + hc]; ssq += kk[j] * kk[j];
              kp[j] = kx * (1.0f + (aa[j] - 1.0f) * a.in[22][l * 384 + hc]); }
          ssq += __shfl_xor(ssq, 1); ssq += __shfl_xor(ssq, 2); ssq += __shfl_xor(ssq, 4); ssq += __shfl_xor(ssq, 8);
          const float rn = 1.0f / sqrtf(ssq + 1e-12f);
#pragma unroll
          for (int j = 0; j < 4; ++j) { const int jj = 4 * jg + j; const float kn = kk[j] * rn;
              VEC[(t * 7 + 0) * 64 + jj] = kn; VEC[(t * 7 + 1) * 64 + jj] = dec[j]; VEC[(t * 7 + 2) * 64 + jj] = kp[j]; VEC[(t * 7 + 3) * 64 + jj] = kn * aa[j];
              VEC[(t * 7 + 4) * 64 + jj] = rr[j]; VEC[(t * 7 + 5) * 64 + jj] = vv[j]; VEC[(t * 7 + 6) * 64 + jj] = gacc[j]; } }
        __syncthreads();
        if (wid == 0) {
#pragma unroll 1
            for (int ts = 0; ts < 32; ++ts) { const LAS f32x4* V4 = (const LAS f32x4*)(VEC + ts * 7 * 64);
                const float vv = VEC[(ts * 7 + 5) * 64 + lane]; float sa = 0.f;
#pragma unroll
                for (int k4 = 0; k4 < 16; ++k4) { const f32x4 q = V4[k4]; sa += S[4 * k4] * q.x; sa += S[4 * k4 + 1] * q.y; sa += S[4 * k4 + 2] * q.z; sa += S[4 * k4 + 3] * q.w; }
                sa = -sa; float y = 0.f;
#pragma unroll
                for (int k4 = 0; k4 < 16; ++k4) { const f32x4 w = V4[16 + k4], kp = V4[32 + k4], ka = V4[48 + k4], r = V4[64 + k4];
                    S[4 * k4] = S[4 * k4] * w.x + sa * ka.x + vv * kp.x; S[4 * k4 + 1] = S[4 * k4 + 1] * w.y + sa * ka.y + vv * kp.y;
                    S[4 * k4 + 2] = S[4 * k4 + 2] * w.z + sa * ka.z + vv * kp.z; S[4 * k4 + 3] = S[4 * k4 + 3] * w.w + sa * ka.w + vv * kp.w;
                    y += S[4 * k4] * r.x; y += S[4 * k4 + 1] * r.y; y += S[4 * k4 + 2] * r.z; y += S[4 * k4 + 3] * r.w; }
                YL[ts * 64 + lane] = y; }
        }
        __syncthreads();
        { const int cb = l * 384 + 64 * h + 4 * jg; const f32x4 y4 = *(const LAS f32x4*)(YL + t * 64 + 4 * jg);
          float sm = (y4.x + y4.y) + (y4.z + y4.w); sm += __shfl_xor(sm, 1); sm += __shfl_xor(sm, 2); sm += __shfl_xor(sm, 4); sm += __shfl_xor(sm, 8);
          const float mean = sm * (1.0f / 64.0f); const f32x4 d = y4 - mean;
          float vr = (d.x * d.x + d.y * d.y) + (d.z * d.z + d.w * d.w); vr += __shfl_xor(vr, 1); vr += __shfl_xor(vr, 2); vr += __shfl_xor(vr, 4); vr += __shfl_xor(vr, 8);
          const float rs = 1.0f / sqrtf(vr * (1.0f / 64.0f) + 64e-5f);
          const f32x4 rk = *(const f32x4*)(a.in[23] + cb), lw = *(const f32x4*)(a.in[24] + cb), lb = *(const f32x4*)(a.in[25] + cb), be = *(const f32x4*)(a.in[26] + l * 1024 + 640 + 64 * h + 4 * jg);
          float bs = 0.f; float r4[4], v4[4], g4[4];
#pragma unroll
          for (int j = 0; j < 4; ++j) { const int jj = 4 * jg + j; r4[j] = VEC[(t * 7 + 4) * 64 + jj]; v4[j] = VEC[(t * 7 + 5) * 64 + jj]; g4[j] = VEC[(t * 7 + 6) * 64 + jj]; bs += r4[j] * VEC[(t * 7 + 2) * 64 + jj] * rk[j]; }
          bs += __shfl_xor(bs, 1); bs += __shfl_xor(bs, 2); bs += __shfl_xor(bs, 4); bs += __shfl_xor(bs, 8);
          float o[4];
#pragma unroll
          for (int j = 0; j < 4; ++j) o[j] = ((d[j] * rs * lw[j] + lb[j]) + bs * v4[j]) * g4[j] * be[j];
          u32x2 w2; w2.x = pk2(o[0], o[1]); w2.y = pk2(o[2], o[3]);
          *(u32x2*)(Y + row * D_ + 640 + 64 * h + 4 * jg) = w2; }
        __syncthreads();
    }
}
__global__ void __launch_bounds__(512, 2) mk_fwd(Args a) {
    extern __shared__ __attribute__((aligned(16))) unsigned char shm[];
    LAS unsigned char* lds = (LAS unsigned char*)shm;
    cg::grid_group grid = cg::this_grid();
    if (a.ph_hi > 1000) grid.sync();
    { volatile LAS unsigned* stw = (volatile LAS unsigned*)(lds + LDS_BYTES - 16); if (threadIdx.x < 4) stw[threadIdx.x] = 0u; }
    __syncthreads();
    XcdBarrier xb = xcd_barrier_post((unsigned*)(a.ws + WS_BAR), (volatile LAS unsigned*)(lds + LDS_BYTES - 16));
    const int tid = otid(), wid = tid >> 6, lane = tid & 63, G = gridDim.x;
    unsigned char* ws = a.ws;
    bf16_t* Pb = (bf16_t*)(ws + WS_P); bf16_t* HY = (bf16_t*)(ws + WS_HY); float* MOD = (float*)(ws + WS_MOD);
#ifdef MK_PROBE
    unsigned long long t_prev = __builtin_amdgcn_s_memrealtime(), t_acc = 0;
#define PH_STAMP(n) { grid.sync(); const unsigned long long t_now = __builtin_amdgcn_s_memrealtime(); if ((MK_PROBE >> (n)) & 1) t_acc += t_now - t_prev; t_prev = t_now; }
#else
#define PH_STAMP(n)
#endif
#ifndef MK_SUB
#define MK_SUB 0
#endif
#ifndef MK_REP
#define MK_REP 0
#endif
#define PH_BEGIN(n) if (a.ph_lo <= (n) && (n) < a.ph_hi) { const int ph_cur = (n); (void)ph_cur; if ((n) > a.ph_lo) xcd_barrier(xb); for (int rep_ = 0; rep_ < (((MK_REP >> (n)) & 1) ? 2 : 1); ++rep_) {
#define PH_END } PH_STAMP(ph_cur) }
    PH_BEGIN(0) phase_pro(a, lds); PH_END
#pragma unroll
    for (int l = 0; l < 2; ++l) {
        const int p0 = 1 + 9 * l;
        const float* xin = (l == 0) ? a.in[0] : a.out;
        const float* modl = MOD + (size_t)l * 8 * 6144;
        PH_BEGIN(p0 + 0) phase_norm(xin, a.in[2] + l * D_, modl + 0, modl + 1024, HY); PH_END
        PH_BEGIN(p0 + 1) { pg8::Gemm g{HY, (const bf16_t*)(ws + WS_WIN + l * SZ_WIN), M_, PS_, D_}; pg8::StaticOrder S; S.init(M_, PS_, G, blockIdx.x); EpiP E{Pb, PS_};
                  pg8::gemm_phase<EpiP, pg8::StaticOrder>(lds, g, S, E, nullptr); } PH_END
        PH_BEGIN(p0 + 2) { for (int r_ = 0; r_ < ((MK_SUB & 1) ? 2 : 1); ++r_) for (int it = blockIdx.x; it < 1536; it += G) hgrn_item<0>(a, l, it, lds);
                  for (int r_ = 0; r_ < ((MK_SUB & 2) ? 2 : 1); ++r_) for (int it = blockIdx.x; it < 1536; it += G) rwkv_chunk<0>(a, l, it, lds);
                  for (int r_ = 0; r_ < ((MK_SUB & 4) ? 2 : 1); ++r_) for (int it = (otid() >> 6) * G + blockIdx.x; it < 1024; it += G * 8) rg_item<0>(a, l, it, otid() & 63); } PH_END
        PH_BEGIN(p0 + 3) { const int t3 = otid();
                  if (t3 < 64) { if ((int)blockIdx.x < 192) rwkv_scan(a, blockIdx.x >> 2, blockIdx.x & 3, t3); }
                  else { for (int e = blockIdx.x * 448 + (t3 - 64); e < 48 * 4096; e += G * 448) hgrn_scan(a, e);
                         for (int e = blockIdx.x * 448 + (t3 - 64); e < 2048; e += G * 448) rg_carry(a, e); } } PH_END
        PH_BEGIN(p0 + 4) { for (int r_ = 0; r_ < ((MK_SUB & 1) ? 2 : 1); ++r_) for (int it = blockIdx.x; it < 1536; it += G) hgrn_item<1>(a, l, it, lds);
                  for (int r_ = 0; r_ < ((MK_SUB & 2) ? 2 : 1); ++r_) for (int it = blockIdx.x; it < 1536; it += G) rwkv_chunk<1>(a, l, it, lds);
                  for (int r_ = 0; r_ < ((MK_SUB & 4) ? 2 : 1); ++r_) for (int it = (otid() >> 6) * G + blockIdx.x; it < 1024; it += G * 8) rg_item<1>(a, l, it, otid() & 63); } PH_END
        PH_BEGIN(p0 + 5) { pg8::Gemm g{HY, (const bf16_t*)(ws + WS_WOUT + l * SZ_WOUT), M_, D_, D_}; pg8::StaticOrder S; S.init(M_, D_, G, blockIdx.x); EpiRes E{xin, a.out, modl + 2048};
                  pg8::gemm_phase<EpiRes, pg8::StaticOrder>(lds, g, S, E, nullptr); } PH_END
        PH_BEGIN(p0 + 6) phase_norm(a.out, a.in[3] + l * D_, modl + 3072, modl + 4096, HY); PH_END
        PH_BEGIN(p0 + 7) { pg8::Gemm g{HY, (const bf16_t*)(ws + WS_WGU + l * SZ_WGU), M_, NGU_, D_}; pg8::StaticOrder S; S.init(M_, NGU_, G, blockIdx.x); EpiSwi E{Pb};
                  pg8::gemm_phase<EpiSwi, pg8::StaticOrder>(lds, g, S, E, nullptr); } PH_END
        PH_BEGIN(p0 + 8) { pg8::Gemm g{Pb, (const bf16_t*)(ws + WS_WD + l * SZ_WD), M_, D_, FF_}; pg8::StaticOrder S; S.init(M_, D_, G, blockIdx.x); EpiRes E{a.out, a.out, modl + 5120};
                  pg8::gemm_phase<EpiRes, pg8::StaticOrder>(lds, g, S, E, nullptr); } PH_END
    }
    PH_BEGIN(19) phase_final(a.out, a.in[31]); PH_END
#ifdef MK_PROBE
    if (blockIdx.x == 0 && threadIdx.x == 0) a.out[0] = (float)t_acc * 0.01f;
#endif
}
#ifndef MK_MULTI
#define MK_MULTI 0
#endif
extern "C" void kernel_launch(void* const* d_in, const int* in_sizes, int n_in, void* d_out, int out_size, void* d_ws, size_t ws_size, hipStream_t stream) {
    static int grid = 0;
    if (!grid) {
        if (n_in != 32 || ws_size < WS_END) { fprintf(stderr, "kernel_launch: bad args n_in %d ws %zu need %zu\n", n_in, ws_size, (size_t)WS_END); return; }
        hipFuncSetAttribute((const void*)mk_fwd, hipFuncAttributeMaxDynamicSharedMemorySize, LDS_BYTES);
        int dev = 0, cus = 0, per_cu = 0; hipGetDevice(&dev); hipDeviceGetAttribute(&cus, hipDeviceAttributeMultiprocessorCount, dev);
        hipOccupancyMaxActiveBlocksPerMultiprocessor(&per_cu, mk_fwd, 512, LDS_BYTES);
        if (per_cu < 1) { fprintf(stderr, "kernel_launch: occupancy 0\n"); per_cu = 1; }
        grid = cus;
    }
    Args a{}; for (int i = 0; i < 32; ++i) a.in[i] = (const float*)d_in[i];
    a.out = (float*)d_out; a.ws = (unsigned char*)d_ws;
#if MK_MULTI
    for (int ph = 0; ph < 20; ++ph) { a.ph_lo = ph; a.ph_hi = ph + 1; hipLaunchKernelGGL(mk_fwd, dim3(grid), dim3(512), LDS_BYTES, stream, a); }
#else
    a.ph_lo = 0; a.ph_hi = 20; void* args[] = {&a};
    if (hipMemsetAsync((char*)d_ws + WS_BAR, 0, XCD_BAR_WORDS * 4, stream) != hipSuccess) { fprintf(stderr, "memset failed\n"); return; }
    hipError_t e = hipLaunchCooperativeKernel((const void*)mk_fwd, dim3(grid), dim3(512), args, LDS_BYTES, stream);
    if (e != hipSuccess) fprintf(stderr, "cooperative launch failed: %s (grid %d)\n", hipGetErrorString(e), grid);
#endif
}
```

```cpp
#include <hip/hip_runtime.h>
#include <hip/hip_cooperative_groups.h>
#include <cstdio>
#include <cstdint>
namespace cg = cooperative_groups;
__device__ __forceinline__ int otid() { int t = threadIdx.x; asm volatile("" : "+v"(t)); return t; }
namespace pg8 {
#define PG8_LAS __attribute__((address_space(3)))
typedef unsigned short bf16_t;
typedef short bf16x8 __attribute__((ext_vector_type(8)));
typedef float f32x4 __attribute__((ext_vector_type(4)));
typedef unsigned u32x4 __attribute__((ext_vector_type(4)));
constexpr int BM = 256, BK = 64, HALF = 128, HTB = HALF * BK * 2  , STAGE_BYTES = 8 * HTB, NXCD = 8, WGM = 8;

__host__ __device__ __forceinline__ int lds_byte(int r, int c) { const int st = (r >> 4) * 2 + (c >> 5), rr = r & 15, cc = c & 31, ob = rr * 64 + cc * 2; return st * 1024 + (ob ^ (((ob >> 9) & 1) << 5)); }
__host__ __device__ __forceinline__ void stage_rc(int b, int& R, int& C) { const int st = b / 1024, sb = b % 1024, swz = sb ^ (((sb >> 9) & 1) << 5); R = (st >> 1) * 16 + swz / 64; C = (st & 1) * 32 + (swz % 64) / 2; }
__host__ __device__ __forceinline__ int perm32(int rho) { const int n = rho >> 4, i = rho & 15; return 8 * (i >> 2) + 4 * n + (i & 3); }

struct Unit { int pm, pn; };
struct Gemm { const bf16_t* A; const bf16_t* Bt; int M, N, K; };

struct StaticOrder {
    int nM, nN, nwg, G, c;
    __host__ __device__ void init(int M, int N, int G_, int c_) { nM = M / BM; nN = N / BM; nwg = nM * nN; G = G_; c = c_; }
    __host__ __device__ bool next(int i, Unit& u) const {
        const long L = (long)i * G + c; if (L >= nwg) return false;
        int wgid = (int)L; { const int q = nwg / NXCD, r = nwg % NXCD, xcd = wgid % NXCD, off = wgid / NXCD; wgid = (xcd < r ? xcd * (q + 1) : r * (q + 1) + (xcd - r) * q) + off; }
        const int nig = WGM * nN, gid = wgid / nig, fm = gid * WGM, gsz = (nM - fm) < WGM ? (nM - fm) : WGM;
        u.pm = fm + ((wgid % nig) % gsz); u.pn = (wgid % nig) / gsz; return true;
    }
    __device__ __forceinline__ void a_ready(const Unit&) const {}
    __device__ __forceinline__ void done(const Unit&) const {}
};
__device__ __forceinline__ unsigned cvt_pk_bf16(float lo, float hi) { unsigned r; asm volatile("v_cvt_pk_bf16_f32 %0, %1, %2" : "=v"(r) : "v"(lo), "v"(hi)); return r; }
template <class Epi, class Sched, bool STAMP = false>
__device__ __forceinline__ void gemm_phase(PG8_LAS unsigned char* lds, const Gemm g, const Sched& S, const Epi& E, unsigned long long* stamps) {
    const int tid = otid(), wid = __builtin_amdgcn_readfirstlane(tid >> 6), lane = tid & 63, wr = wid >> 2, wc = wid & 3, fr = lane & 15, fq = lane >> 4;
    const int K = g.K, nt = K / BK;
    unsigned voffA[2], voffB[2];
#pragma unroll
    for (int i = 0; i < 2; ++i) { int R, C; stage_rc(tid * 16 + i * 8192, R, C); const int Rb = Epi::PERM ? ((R & ~31) + perm32(R & 31)) : R;
        voffA[i] = (unsigned)(R * K + C) * 2u; voffB[i] = (unsigned)(Rb * K + C) * 2u; }
    const size_t kstep = (size_t)(BK * 2);
    const size_t hstep = (size_t)HALF * K * 2;
    const size_t tstep = 2 * hstep;
    const unsigned ldsw = (unsigned)wid * 1024u;
    const int aoff = lds_byte(wr * 64 + fr, fq * 8), boff = lds_byte(wc * 32 + fr, fq * 8);
#define PG8_SA(b, h) (((b) * 2 + (h)) * HTB)
#define PG8_SB(b, h) ((4 + (b) * 2 + (h)) * HTB)
#define PG8_STAGE(bufoff, gbase, voff) do { _Pragma("unroll") for (int _i = 0; _i < 2; ++_i) \
        __builtin_amdgcn_global_load_lds((const unsigned*)((const char*)(gbase) + (voff)[_i]), (PG8_LAS unsigned*)(lds + (bufoff) + ldsw + _i * 8192), 16, 0, 0); } while (0)
#define PG8_LDA(dst, b, h) do { _Pragma("unroll") for (int m = 0; m < 4; ++m) _Pragma("unroll") for (int k = 0; k < 2; ++k) dst[m][k] = *(const PG8_LAS bf16x8*)(lds + PG8_SA(b, h) + aoff + m * 2048 + k * 1024); } while (0)
#define PG8_LDB(dst, b, h) do { _Pragma("unroll") for (int n = 0; n < 2; ++n) _Pragma("unroll") for (int k = 0; k < 2; ++k) dst[n][k] = *(const PG8_LAS bf16x8*)(lds + PG8_SB(b, h) + boff + n * 2048 + k * 1024); } while (0)
#define PG8_MMA(ai, bj, At, Bt) do { __builtin_amdgcn_s_setprio(1); _Pragma("unroll") for (int m = 0; m < 4; ++m) _Pragma("unroll") for (int n = 0; n < 2; ++n) _Pragma("unroll") for (int k = 0; k < 2; ++k) \
        acc[ai][bj][m][n] = __builtin_amdgcn_mfma_f32_16x16x32_bf16(Bt[n][k], At[m][k], acc[ai][bj][m][n], 0, 0, 0); __builtin_amdgcn_s_setprio(0); } while (0)
#define PG8_WAIT_V(n) asm volatile("s_waitcnt vmcnt(" #n ")" ::: "memory")
#define PG8_WAIT_L(n) asm volatile("s_waitcnt lgkmcnt(" #n ")" ::: "memory")
#define PG8_BAR __builtin_amdgcn_s_barrier()
#define PG8_SCHED __builtin_amdgcn_sched_barrier(0)
    Unit cur, nxt; int ui = 0;
    if (!S.next(0, cur)) return;
    f32x4 acc[2][2][4][2];
#pragma unroll
    for (int a = 0; a < 2; ++a)
#pragma unroll
        for (int b = 0; b < 2; ++b)
#pragma unroll
            for (int m = 0; m < 4; ++m)
#pragma unroll
                for (int n = 0; n < 2; ++n) acc[a][b][m][n] = (f32x4){0.f, 0.f, 0.f, 0.f};
    bf16x8 At[4][2], B0[2][2], B1[2][2];
    const char* cA = (const char*)g.A + (size_t)cur.pm * tstep; const char* cB = (const char*)g.Bt + (size_t)cur.pn * tstep;
    S.a_ready(cur);
    PG8_STAGE(PG8_SB(0, 0), cB, voffB); PG8_STAGE(PG8_SA(0, 0), cA, voffA); PG8_STAGE(PG8_SB(0, 1), cB + hstep, voffB); PG8_STAGE(PG8_SA(0, 1), cA + hstep, voffA);
    if (wr == 1) PG8_BAR;
    PG8_WAIT_V(4); PG8_BAR;
    PG8_STAGE(PG8_SB(1, 0), cB + kstep, voffB); PG8_STAGE(PG8_SA(1, 0), cA + kstep, voffA); PG8_STAGE(PG8_SB(1, 1), cB + hstep + kstep, voffB);
    PG8_WAIT_V(6); PG8_BAR;
    for (;;) {
        const bool has_next = S.next(ui + 1, nxt);
        const char* nA = has_next ? (const char*)g.A + (size_t)nxt.pm * tstep : cA; const char* nB = has_next ? (const char*)g.Bt + (size_t)nxt.pn * tstep : cB;
        for (int t = 0; t < nt; t += 2) {
            const bool last = (t == nt - 2);
            const char* a1 = cA + (size_t)(t + 1) * kstep;
            const char* a2 = last ? nA : cA + (size_t)(t + 2) * kstep; const char* b2 = last ? nB : cB + (size_t)(t + 2) * kstep;
            const char* a3 = a2 + kstep; const char* b3 = b2 + kstep;
            if (last && has_next) S.a_ready(nxt);
            PG8_LDB(B0, 0, 0); PG8_SCHED; PG8_LDA(At, 0, 0); PG8_STAGE(PG8_SA(1, 1), a1 + hstep, voffA);
            PG8_WAIT_L(8); PG8_BAR; PG8_WAIT_L(0); PG8_MMA(0, 0, At, B0); PG8_BAR; PG8_SCHED;
            PG8_LDB(B1, 0, 1); PG8_STAGE(PG8_SB(0, 0), b2, voffB);
            PG8_BAR; PG8_WAIT_L(0); PG8_MMA(0, 1, At, B1); PG8_BAR;
            PG8_LDA(At, 0, 1); PG8_STAGE(PG8_SA(0, 0), a2, voffA);
            PG8_BAR; PG8_WAIT_L(0); PG8_MMA(1, 0, At, B0); PG8_BAR; PG8_SCHED;
            PG8_STAGE(PG8_SB(0, 1), b2 + hstep, voffB);
            PG8_WAIT_V(6); PG8_BAR; PG8_MMA(1, 1, At, B1); PG8_BAR;
            PG8_LDB(B0, 1, 0); PG8_SCHED; PG8_LDA(At, 1, 0); PG8_STAGE(PG8_SA(0, 1), a2 + hstep, voffA);
            PG8_WAIT_L(8); PG8_BAR; PG8_WAIT_L(0); PG8_MMA(0, 0, At, B0); PG8_BAR; PG8_SCHED;
            PG8_LDB(B1, 1, 1); PG8_STAGE(PG8_SB(1, 0), b3, voffB);
            PG8_BAR; PG8_WAIT_L(0); PG8_MMA(0, 1, At, B1); PG8_BAR;
            PG8_LDA(At, 1, 1); PG8_STAGE(PG8_SA(1, 0), a3, voffA);
            PG8_BAR; PG8_WAIT_L(0); PG8_MMA(1, 0, At, B0); PG8_BAR; PG8_SCHED;
            PG8_STAGE(PG8_SB(1, 1), b3 + hstep, voffB);
            PG8_WAIT_V(6); PG8_BAR; PG8_MMA(1, 1, At, B1); PG8_BAR;
        }
        if constexpr (!Epi::AFTER_DRAIN) { E(acc, cur, wr, wc, fr, fq); S.done(cur); }
        if (!has_next) break;
#pragma unroll
        for (int a = 0; a < 2; ++a)
#pragma unroll
            for (int b = 0; b < 2; ++b)
#pragma unroll
                for (int m = 0; m < 4; ++m)
#pragma unroll
                    for (int n = 0; n < 2; ++n) acc[a][b][m][n] = (f32x4){0.f, 0.f, 0.f, 0.f};
        cur = nxt; cA = nA; cB = nB; ++ui;
    }
    PG8_WAIT_V(0);
    if (wr == 0) PG8_BAR;
    PG8_BAR;
    if constexpr (Epi::AFTER_DRAIN) { E.fused(acc, cur, wr, wc, fr, fq, lds, wid, lane); S.done(cur); }
#undef PG8_SA
#undef PG8_SB
#undef PG8_STAGE
#undef PG8_LDA
#undef PG8_LDB
#undef PG8_MMA
#undef PG8_WAIT_V
#undef PG8_WAIT_L
#undef PG8_BAR
#undef PG8_SCHED
}
}
using pg8::bf16_t; using pg8::bf16x8; using pg8::f32x4; using pg8::u32x4;
#define LAS __attribute__((address_space(3)))
typedef float f32x2 __attribute__((ext_vector_type(2)));
typedef unsigned u32x2 __attribute__((ext_vector_type(2)));
typedef short s16x4 __attribute__((ext_vector_type(4)));

constexpr int M_ = 16384, D_ = 1024, T_ = 2048, NB_ = 8, PS_ = 3584, PW_ = 3456, FF_ = 2816, NGU_ = 5632;
constexpr int PAX = 0, PAY = 256, PBQ = 512, PBF = 896, PBV = 1280, PBG = 1664, PC = 2048;
constexpr int LDS_BYTES = 144 * 1024;
constexpr size_t SZ_WIN = (size_t)PS_ * D_ * 2, SZ_WOUT = (size_t)D_ * D_ * 2, SZ_WGU = (size_t)NGU_ * D_ * 2, SZ_WD = (size_t)D_ * FF_ * 2;
constexpr size_t WS_WIN = 0, WS_WOUT = WS_WIN + 2 * SZ_WIN, WS_WGU = WS_WOUT + 2 * SZ_WOUT, WS_WD = WS_WGU + 2 * SZ_WGU;
constexpr size_t WS_MOD = WS_WD + 2 * SZ_WD;
constexpr size_t WS_P = WS_MOD + 2 * 8 * 6144 * 4;
constexpr size_t WS_HY = WS_P + (size_t)M_ * PS_ * 2;
constexpr size_t WS_RGA = WS_HY + (size_t)M_ * D_ * 2;
constexpr size_t WS_HKV = WS_RGA + 3 * 8 * 32 * 256 * 4;
constexpr size_t WS_HDEC = WS_HKV + (size_t)1536 * 4096 * 2;
constexpr size_t WS_RM = WS_HDEC + (size_t)1536 * 64 * 4;
constexpr size_t WS_RN = WS_RM + (size_t)1536 * 4096 * 2;
constexpr size_t WS_RGAM = WS_RN + (size_t)1536 * 4096 * 2;
constexpr size_t WS_LORA = WS_RGAM + (size_t)1536 * 64 * 4;
constexpr size_t WS_BAR = WS_LORA + (size_t)2 * 98304 * 2;
constexpr size_t WS_END = WS_BAR + 16384;

struct Args { const float* in[32]; float* out; unsigned char* ws; int ph_lo, ph_hi; };

typedef __bf16 bf16n2 __attribute__((ext_vector_type(2)));
__device__ __forceinline__ unsigned pk2(float lo, float hi) { bf16n2 v; v.x = (__bf16)lo; v.y = (__bf16)hi; return __builtin_bit_cast(unsigned, v); }
__device__ __forceinline__ unsigned f2bf(float f) { return pk2(f, f) & 0xffffu; }
__device__ __forceinline__ float bf2f(unsigned short b) { return __builtin_bit_cast(float, ((unsigned)b) << 16); }
__device__ __forceinline__ float bflo(unsigned w) { return __builtin_bit_cast(float, w << 16); }
__device__ __forceinline__ float bfhi(unsigned w) { return __builtin_bit_cast(float, w & 0xffff0000u); }
__device__ __forceinline__ float wave_sum(float v) {
#pragma unroll
    for (int o = 1; o < 64; o <<= 1) v += __shfl_xor(v, o);
    return v;
}
__device__ __forceinline__ float rcp_(float x) { return __builtin_amdgcn_rcpf(x); }
__device__ __forceinline__ float rsq_(float x) { return __builtin_amdgcn_rsqf(x); }
__device__ __forceinline__ float sigmoidf_(float x) { return rcp_(1.0f + __expf(-x)); }
#define LDS_WAIT() asm volatile("s_waitcnt lgkmcnt(0)" ::: "memory")

struct EpiP {
    static constexpr bool PERM = true, AFTER_DRAIN = false;
    bf16_t* O; int ldc;
    __device__ __forceinline__ void operator()(const f32x4 (&acc)[2][2][4][2], const pg8::Unit& u, int wr, int wc, int fr, int fq) const {
        const int row0 = u.pm * 256 + wr * 64 + fr, col0 = u.pn * 256 + wc * 32 + 8 * fq;
#pragma unroll
        for (int ai = 0; ai < 2; ++ai)
#pragma unroll
            for (int m = 0; m < 4; ++m) { bf16_t* rowp = O + (size_t)(row0 + ai * 128 + m * 16) * ldc + col0;
#pragma unroll
                for (int bj = 0; bj < 2; ++bj) { const f32x4 v0 = acc[ai][bj][m][0], v1 = acc[ai][bj][m][1]; u32x4 w;
                    w.x = pg8::cvt_pk_bf16(v0[0], v0[1]); w.y = pg8::cvt_pk_bf16(v0[2], v0[3]); w.z = pg8::cvt_pk_bf16(v1[0], v1[1]); w.w = pg8::cvt_pk_bf16(v1[2], v1[3]);
                    *(u32x4*)(rowp + bj * 128) = w; } }
    }
};
struct EpiRes {
    static constexpr bool PERM = false, AFTER_DRAIN = false;
    const float* base; float* out; const float* gate;
    __device__ __forceinline__ void operator()(const f32x4 (&acc)[2][2][4][2], const pg8::Unit& u, int wr, int wc, int fr, int fq) const {
        const int row0 = u.pm * 256 + wr * 64 + fr, col0 = u.pn * 256 + wc * 32 + 4 * fq, b = u.pm >> 3;
        f32x4 gv[2][2];
#pragma unroll
        for (int bj = 0; bj < 2; ++bj)
#pragma unroll
            for (int n = 0; n < 2; ++n) gv[bj][n] = *(const f32x4*)(gate + (size_t)b * 6144 + col0 + bj * 128 + n * 16);
#pragma unroll
        for (int ai = 0; ai < 2; ++ai)
#pragma unroll
            for (int m = 0; m < 4; ++m) { const size_t ro = (size_t)(row0 + ai * 128 + m * 16) * 1024 + col0;
#pragma unroll
                for (int bj = 0; bj < 2; ++bj)
#pragma unroll
                    for (int n = 0; n < 2; ++n) { const f32x4 bv = *(const f32x4*)(base + ro + bj * 128 + n * 16);
                        *(f32x4*)(out + ro + bj * 128 + n * 16) = bv + gv[bj][n] * acc[ai][bj][m][n]; } }
    }
};
struct EpiSwi {
    static constexpr bool PERM = true, AFTER_DRAIN = false;
    bf16_t* O;
    __device__ __forceinline__ void operator()(const f32x4 (&acc)[2][2][4][2], const pg8::Unit& u, int wr, int wc, int fr, int fq) const {
        const int row0 = u.pm * 256 + wr * 64 + fr, col0 = u.pn * 128 + wc * 32 + 8 * fq;
#pragma unroll
        for (int ai = 0; ai < 2; ++ai)
#pragma unroll
            for (int m = 0; m < 4; ++m) { bf16_t* rowp = O + (size_t)(row0 + ai * 128 + m * 16) * FF_ + col0; float o[8];
#pragma unroll
                for (int n = 0; n < 2; ++n)
#pragma unroll
                    for (int i = 0; i < 4; ++i) { const float g = acc[ai][0][m][n][i], up = acc[ai][1][m][n][i]; o[4 * n + i] = g * sigmoidf_(g) * up; }
                u32x4 w; w.x = pg8::cvt_pk_bf16(o[0], o[1]); w.y = pg8::cvt_pk_bf16(o[2], o[3]); w.z = pg8::cvt_pk_bf16(o[4], o[5]); w.w = pg8::cvt_pk_bf16(o[6], o[7]);
                *(u32x4*)rowp = w; }
    }
};

__device__ __forceinline__ void transpose_item(const float* W, int K, int N, bf16_t* WT, int mode, LAS float* scr, int item, int lane) {
    const int nblk = N / 32, kb = item / nblk, nb = item % nblk, k0 = 64 * kb, n0 = 32 * nb;
#pragma unroll 8
    for (int i = 0; i < 32; ++i) { const int kk = 2 * i + (lane >> 5); scr[kk * 33 + (lane & 31)] = W[(size_t)(k0 + kk) * N + n0 + (lane & 31)]; }
    LDS_WAIT(); asm volatile("" ::: "memory");
    const int c = lane & 7;
#pragma unroll
    for (int j = 0; j < 4; ++j) { const int nl = (lane >> 3) + 8 * j, n = n0 + nl; const LAS float* s = scr + (8 * c) * 33 + nl;
        const int row = (mode == 0) ? n : (256 * (n >> 7) + (n & 127) + (mode == 2 ? 128 : 0));
        u32x4 o; o.x = pk2(s[0 * 33], s[1 * 33]); o.y = pk2(s[2 * 33], s[3 * 33]); o.z = pk2(s[4 * 33], s[5 * 33]); o.w = pk2(s[6 * 33], s[7 * 33]);
        *(u32x4*)(WT + (size_t)row * K + k0 + 8 * c) = o; }
    LDS_WAIT(); asm volatile("" ::: "memory");
}
__device__ __forceinline__ void phase_pro(const Args& a, LAS unsigned char* lds) {
    const int tid = otid(), wid = tid >> 6, lane = tid & 63;
    unsigned char* ws = a.ws;
    LAS float* CS = (LAS float*)lds;
    LAS float* RED = (LAS float*)(lds + 32768);
    if ((int)blockIdx.x < 192) {
        for (int i = tid; i < 8192; i += 512) { const float cv = a.in[1][i]; CS[i] = cv * sigmoidf_(cv); }
        __syncthreads();
    }
    for (int item = blockIdx.x; item < 192; item += gridDim.x) {
        const int l = item / 96, cgp = item % 96, col = cgp * 64 + lane;
        const float* aw = a.in[4] + (size_t)l * 1024 * 6144;
        float acc[8];
#pragma unroll
        for (int b = 0; b < 8; ++b) acc[b] = 0.f;
        for (int k = wid * 128; k < wid * 128 + 128; ++k) { const float w = aw[(size_t)k * 6144 + col];
#pragma unroll
            for (int b = 0; b < 8; ++b) acc[b] += CS[b * 1024 + k] * w; }
#pragma unroll
        for (int b = 0; b < 8; ++b) RED[(wid * 8 + b) * 64 + lane] = acc[b];
        __syncthreads();
        { const int b = wid; float s = 0.f;
#pragma unroll
          for (int w = 0; w < 8; ++w) s += RED[(w * 8 + b) * 64 + lane];
          ((float*)(ws + WS_MOD))[(size_t)(l * 8 + b) * 6144 + col] = s + a.in[5][l * 6144 + col]; }
        __syncthreads();
    }
    LAS float* scr = (LAS float*)(lds + 65536 + wid * 8448);
    const int gw = blockIdx.x * 8 + wid, NGW = gridDim.x * 8;
    constexpr int I_IN = 16 * (PW_ / 32), I_OUT = 16 * 32, I_G = 16 * (FF_ / 32), I_D = (FF_ / 64) * 32, I_L = I_IN + I_OUT + 2 * I_G + I_D;
    for (int it = gw; it < 2 * I_L; it += NGW) {
        const int l = it / I_L; int r = it % I_L;
        if (r < I_IN) { transpose_item(a.in[6] + (size_t)l * D_ * PW_, D_, PW_, (bf16_t*)(ws + WS_WIN + l * SZ_WIN), 0, scr, r, lane); continue; } r -= I_IN;
        if (r < I_OUT) { transpose_item(a.in[27] + (size_t)l * D_ * D_, D_, D_, (bf16_t*)(ws + WS_WOUT + l * SZ_WOUT), 0, scr, r, lane); continue; } r -= I_OUT;
        if (r < I_G) { transpose_item(a.in[28] + (size_t)l * D_ * FF_, D_, FF_, (bf16_t*)(ws + WS_WGU + l * SZ_WGU), 1, scr, r, lane); continue; } r -= I_G;
        if (r < I_G) { transpose_item(a.in[29] + (size_t)l * D_ * FF_, D_, FF_, (bf16_t*)(ws + WS_WGU + l * SZ_WGU), 2, scr, r, lane); continue; } r -= I_G;
        transpose_item(a.in[30] + (size_t)l * FF_ * D_, FF_, D_, (bf16_t*)(ws + WS_WD + l * SZ_WD), 0, scr, r, lane);
    }
    for (int e = blockIdx.x * 512 + tid; e < 2 * 98304; e += gridDim.x * 512) { const int l = e / 98304; int r = e % 98304; float v;
        if (r < 24576) { const int cidx = r >> 6, i = r & 63; v = a.in[17][((size_t)l * 64 + i) * 384 + cidx]; }
        else if (r < 49152) { const int r2 = r - 24576, cidx = r2 >> 6, i = r2 & 63; v = a.in[19][((size_t)l * 64 + i) * 384 + cidx]; }
        else { const int r2 = r - 49152, cidx = r2 >> 7, i = r2 & 127; v = a.in[20][((size_t)l * 128 + i) * 384 + cidx]; }
        ((bf16_t*)(ws + WS_LORA))[e] = (bf16_t)f2bf(v); }
    for (int i = blockIdx.x * 512 + tid; i < 2 * 16384; i += gridDim.x * 512) { const int l = i >> 14, e = i & 16383;
        *(u32x4*)(ws + WS_WIN + l * SZ_WIN + (size_t)PW_ * D_ * 2 + (size_t)e * 16) = (u32x4){0u, 0u, 0u, 0u}; }
}
__device__ __forceinline__ void phase_norm(const float* xin, const float* gain, const float* sh, const float* sc, bf16_t* H) {
    const int tid = otid(), wid = tid >> 6, lane = tid & 63, gw = blockIdx.x * 8 + wid, NGW = gridDim.x * 8;
    for (int row = gw; row < M_; row += NGW) { const int b = row >> 11;
        const f32x4* xr = (const f32x4*)(xin + (size_t)row * D_) + lane; f32x4 v[4]; float ss = 0.f;
#pragma unroll
        for (int j = 0; j < 4; ++j) { v[j] = xr[64 * j]; ss += (v[j].x * v[j].x + v[j].y * v[j].y) + (v[j].z * v[j].z + v[j].w * v[j].w); }
        const float rs = rsq_(wave_sum(ss) * (1.0f / D_) + 1e-6f);
#pragma unroll
        for (int j = 0; j < 4; ++j) { const int col = 4 * lane + 256 * j;
            const f32x4 g = *(const f32x4*)(gain + col), s1 = *(const f32x4*)(sc + (size_t)b * 6144 + col), s0 = *(const f32x4*)(sh + (size_t)b * 6144 + col);
            const f32x4 h = v[j] * rs * g * (s1 + 1.0f) + s0;
            u32x2 w; w.x = pk2(h.x, h.y); w.y = pk2(h.z, h.w); *(u32x2*)(H + (size_t)row * D_ + col) = w; }
    }
}
__device__ __forceinline__ void phase_final(float* x, const float* gain) {
    const int tid = otid(), wid = tid >> 6, lane = tid & 63, gw = blockIdx.x * 8 + wid, NGW = gridDim.x * 8;
    for (int row = gw; row < M_; row += NGW) {
        f32x4* xr = (f32x4*)(x + (size_t)row * D_) + lane; f32x4 v[4]; float ss = 0.f;
#pragma unroll
        for (int j = 0; j < 4; ++j) { v[j] = xr[64 * j]; ss += (v[j].x * v[j].x + v[j].y * v[j].y) + (v[j].z * v[j].z + v[j].w * v[j].w); }
        const float rs = rsq_(wave_sum(ss) * (1.0f / D_) + 1e-6f);
#pragma unroll
        for (int j = 0; j < 4; ++j) { const f32x4 g = *(const f32x4*)(gain + 4 * lane + 256 * j); xr[64 * j] = v[j] * rs * g; }
    }
}
#define XB_TMO      128
#define XB_XCNT(j)  (256  + 64 * (j))
#define XB_XSUB(j)  (1280 + 64 * (j))
#define XB_XGEN(j)  (2304 + 64 * (j))
#define XB_TOP      3328
#define XB_TOPGEN   3392
#define XCD_BAR_WORDS 3456
#define XB_SPIN_CAP (1u << 18)

__device__ __forceinline__ unsigned xb_ld(unsigned* p)              { return __hip_atomic_load(p, __ATOMIC_RELAXED, __HIP_MEMORY_SCOPE_AGENT); }
__device__ __forceinline__ unsigned xb_add(unsigned* p, unsigned v) { return __hip_atomic_fetch_add(p, v, __ATOMIC_RELAXED, __HIP_MEMORY_SCOPE_AGENT); }
__device__ __forceinline__ unsigned xb_xcc_id() { return (unsigned)__builtin_amdgcn_s_getreg((3 << 11) | 20) & 0xFu; }
#define XB_SPIN(cond, bar) do { unsigned _sp = 0; while (cond) { __builtin_amdgcn_s_sleep(1); \
    if ((++_sp & 255u) == 0u) { if (xb_ld(&(bar)[XB_TMO])) break; if (_sp > XB_SPIN_CAP) { atomicAdd(&(bar)[XB_TMO], 1u); break; } } } } while (0)

struct XcdBarrier {
    unsigned* bar; unsigned x;
    volatile LAS unsigned* st;
};

__device__ __forceinline__ XcdBarrier xcd_barrier_post(unsigned* bar, volatile LAS unsigned* st) {
    XcdBarrier b; b.bar = bar; b.x = xb_xcc_id(); b.st = st;
    if (threadIdx.x == 0) (void)xb_add(&bar[XB_XCNT(b.x)], 1u);
    return b;
}
__device__ __forceinline__ void xcd_barrier_complete(unsigned* bar, unsigned x, unsigned& nloc, unsigned& nx) {
    const unsigned G = gridDim.x * gridDim.y * gridDim.z;
    unsigned sum, cnt, mine, sp = 0u;
    for (;;) {
        sum = 0u; cnt = 0u; mine = 0u;
#pragma unroll
        for (unsigned j = 0; j < 16; ++j) { const unsigned c = xb_ld(&bar[XB_XCNT(j)]); sum += c; cnt += (c > 0u) ? 1u : 0u; mine = (j == x) ? c : mine; }
        if (sum == G) break;
        __builtin_amdgcn_s_sleep(1);
        if ((++sp & 255u) == 0u) { if (xb_ld(&bar[XB_TMO])) break; if (sp > XB_SPIN_CAP) { atomicAdd(&bar[XB_TMO], 1u); break; } }
    }
    nloc = mine > 0u ? mine : 1u; nx = cnt > 0u ? cnt : 1u;
}

__device__ __forceinline__ void xcd_barrier(const XcdBarrier& b) {
    asm volatile("s_waitcnt vmcnt(0)" ::: "memory");
    __syncthreads();
    if (threadIdx.x == 0) {
        unsigned* bar = b.bar;
        __builtin_amdgcn_s_waitcnt(0);
        unsigned nloc = b.st[0], nx = b.st[1];
        if (nloc == 0u) { xcd_barrier_complete(bar, b.x, nloc, nx); b.st[0] = nloc; b.st[1] = nx; }
        const unsigned old = xb_add(&bar[XB_XSUB(b.x)], 1u);
        const unsigned gen = old / nloc;
        if (old + 1u == (gen + 1u) * nloc) {
            __builtin_amdgcn_fence(__ATOMIC_RELEASE, "agent");
            asm volatile("s_waitcnt vmcnt(0)" ::: "memory");
            const unsigned og = xb_add(&bar[XB_TOP], 1u);
            const unsigned tg = og / nx;
            if (og + 1u == (tg + 1u) * nx) xb_add(&bar[XB_TOPGEN], 1u);
            else XB_SPIN(xb_ld(&bar[XB_TOPGEN]) == tg, bar);
            __builtin_amdgcn_fence(__ATOMIC_ACQUIRE, "agent");
            xb_add(&bar[XB_XGEN(b.x)], 1u);
            asm volatile("s_waitcnt vmcnt(0)" ::: "memory");
        } else {
            XB_SPIN(xb_ld(&bar[XB_XGEN(b.x)]) == gen, bar);
            __builtin_amdgcn_fence(__ATOMIC_ACQUIRE, "agent");
            asm volatile("s_waitcnt vmcnt(0)" ::: "memory");
        }
    }
    __syncthreads();
}

__device__ __forceinline__ float gelu_tanh(float x) { const float u = 0.7978845608f * (x + 0.044715f * x * x * x); const float e = __expf(2.0f * u); const float th = 1.0f - 2.0f * rcp_(e + 1.0f); return 0.5f * x * (1.0f + th); }
template <int MODE>
__device__ __forceinline__ void rg_item(const Args& a, int l, int item, int lane) {
    const int g = item & 3, c = (item >> 2) & 31, b = item >> 7, ch = 64 * g + lane, row0 = b * T_ + 64 * c;
    const bf16_t* P = (const bf16_t*)(a.ws + WS_P);
    float* AGG = (float*)(a.ws + WS_RGA);
    float Wr[64], Wi[64];
#pragma unroll
    for (int i = 0; i < 64; ++i) { Wr[i] = a.in[9][((size_t)(l * 4 + g) * 64 + i) * 64 + lane]; Wi[i] = a.in[11][((size_t)(l * 4 + g) * 64 + i) * 64 + lane]; }
    const float cw0 = a.in[7][(l * 4 + 0) * 256 + ch], cw1 = a.in[7][(l * 4 + 1) * 256 + ch], cw2 = a.in[7][(l * 4 + 2) * 256 + ch], cw3 = a.in[7][(l * 4 + 3) * 256 + ch];
    const float cb = a.in[8][l * 256 + ch], rb = a.in[10][l * 256 + ch], ib = a.in[12][l * 256 + ch], lam = a.in[13][l * 256 + ch];
    const float sp = log1pf(__expf(-lam));
    float xm3 = 0.f, xm2 = 0.f, xm1 = 0.f;
    if (c > 0) { xm3 = bf2f(P[(size_t)(row0 - 3) * PS_ + PAX + ch]); xm2 = bf2f(P[(size_t)(row0 - 2) * PS_ + PAX + ch]); xm1 = bf2f(P[(size_t)(row0 - 1) * PS_ + PAX + ch]); }
    float h = 0.f, Ap = 1.f, beta = 0.f;
    if (MODE == 1) { h = AGG[2 * 65536 + (b * 32 + c) * 256 + ch]; beta = a.in[26][l * 1024 + ch]; }
    bf16_t* Y = (bf16_t*)(a.ws + WS_HY);
    unsigned short xn[8], yn[8];
#pragma unroll
    for (int i = 0; i < 8; ++i) { xn[i] = P[(size_t)(row0 + i) * PS_ + PAX + ch]; yn[i] = (MODE == 1) ? P[(size_t)(row0 + i) * PS_ + PAY + ch] : (unsigned short)0; }
#pragma unroll 1
    for (int tg = 0; tg < 8; ++tg) {
        unsigned short xr[8], yr[8];
#pragma unroll
        for (int i = 0; i < 8; ++i) { xr[i] = xn[i]; yr[i] = yn[i]; }
        if (tg < 7) {
#pragma unroll
            for (int i = 0; i < 8; ++i) { xn[i] = P[(size_t)(row0 + 8 * tg + 8 + i) * PS_ + PAX + ch]; if (MODE == 1) yn[i] = P[(size_t)(row0 + 8 * tg + 8 + i) * PS_ + PAY + ch]; } }
#pragma unroll
        for (int i8 = 0; i8 < 8; ++i8) { const int t = 8 * tg + i8;
        const float xc = bf2f(xr[i8]);
        const float u = cb + cw0 * xm3 + cw1 * xm2 + cw2 * xm1 + cw3 * xc;
        xm3 = xm2; xm2 = xm1; xm1 = xc;
        float rp = rb, ip = ib;
#pragma unroll
        for (int i = 0; i < 64; ++i) { const float ui = __builtin_bit_cast(float, __builtin_amdgcn_readlane(__builtin_bit_cast(int, u), i)); rp += ui * Wr[i]; ip += ui * Wi[i]; }
        const float r = sigmoidf_(rp), ig = sigmoidf_(ip);
        const float log_a = -8.0f * r * sp, av = __expf(log_a);
        const float x2 = 2.0f * log_a; const float em = (x2 > -0.25f) ? -x2 * (1.0f + 0.5f * x2 * (1.0f + (1.0f / 3.0f) * x2 * (1.0f + 0.25f * x2 * (1.0f + 0.2f * x2)))) : 1.0f - __expf(x2);
        float mult = __builtin_amdgcn_sqrtf(em); if (c == 0 && t == 0) mult = 1.0f;
        const float bv = mult * ig * u;
        h = av * h + bv;
        if (MODE == 0) Ap *= av;
        else { const float ya = bf2f(yr[i8]); const float y = h * gelu_tanh(ya);
            const float ss = wave_sum(y * y); const float o = y * rsq_(ss * (1.0f / 64.0f) + 1e-6f) * beta;
            Y[(size_t)(row0 + t) * D_ + ch] = (bf16_t)f2bf(o); }
        }
    }
    if (MODE == 0) { AGG[(b * 32 + c) * 256 + ch] = Ap; AGG[65536 + (b * 32 + c) * 256 + ch] = h; }
}
__device__ __forceinline__ void rg_carry(const Args& a, int gid) {
    float* AGG = (float*)(a.ws + WS_RGA); const int b = gid >> 8, ch = gid & 255; float H = 0.f; float Av[32], Bv[32];
#pragma unroll
    for (int c = 0; c < 32; ++c) { const int i = (b * 32 + c) * 256 + ch; Av[c] = AGG[i]; Bv[c] = AGG[65536 + i]; }
#pragma unroll
    for (int c = 0; c < 32; ++c) { const int i = (b * 32 + c) * 256 + ch; AGG[2 * 65536 + i] = H; H = Av[c] * H + Bv[c]; }
}
__device__ __forceinline__ f32x4 mfma16(bf16x8 x, bf16x8 y, f32x4 c) { return __builtin_amdgcn_mfma_f32_16x16x32_bf16(x, y, c, 0, 0, 0); }
constexpr int LST = 72;
template <int MODE>
__device__ __forceinline__ void hgrn_item(const Args& a, int l, int item, LAS unsigned char* lds) {
    const int tid = otid(), wid = tid >> 6, lane = tid & 63, fr = lane & 15, fq = lane >> 4;
    const int c = item & 31, bh = item >> 5, h = bh % 6, b = bh / 6, row0 = b * T_ + 64 * c;
    const bf16_t* P = (const bf16_t*)(a.ws + WS_P);
    bf16_t* KVT = (bf16_t*)(a.ws + WS_HKV) + (size_t)item * 4096;
    LAS float* PART = (LAS float*)lds;
    LAS float* RHO = (LAS float*)(lds + 2048);
    LAS float* BC = (LAS float*)(lds + 4096);
    LAS bf16_t* L0 = (LAS bf16_t*)(lds + 20480);
    LAS bf16_t* L1 = (LAS bf16_t*)(lds + 29696);
    LAS bf16_t* L2 = (LAS bf16_t*)(lds + 38912);
    LAS bf16_t* VT = (LAS bf16_t*)(lds + 48128);
    LAS bf16_t* AM = (LAS bf16_t*)(lds + 57344);
    LAS float* SS = (LAS float*)(lds + 66560);
    const int k = lane, pt = wid;
    const float* hl = a.in[14];
    float lbv = 0.f; if (l == 1) lbv = rcp_(1.0f + __expf(hl[64 * h + k] - hl[384 + 64 * h + k]));
    float bc[8], kvv[8]; float s = 0.f;
#pragma unroll
    for (int i = 0; i < 8; ++i) { const float z = bf2f(P[(size_t)(row0 + 8 * pt + i) * PS_ + PBF + 64 * h + k]);
        const float sg = rcp_(1.0f + __expf(-z)); const float f = fmaxf(lbv + (1.0f - lbv) * sg, 1e-37f);
        s += __logf(f); bc[i] = s; kvv[i] = (1.0f - lbv) * rcp_(1.0f + __expf(z)); }
    PART[pt * 64 + k] = s;
    { unsigned short vv[8];
#pragma unroll
      for (int i = 0; i < 8; ++i) vv[i] = P[(size_t)(row0 + 8 * pt + i) * PS_ + PBV + 64 * h + k];
      u32x4 w; w.x = vv[0] | ((unsigned)vv[1] << 16); w.y = vv[2] | ((unsigned)vv[3] << 16); w.z = vv[4] | ((unsigned)vv[5] << 16); w.w = vv[6] | ((unsigned)vv[7] << 16);
      *(LAS u32x4*)(VT + k * LST + 8 * pt) = w; }
    __syncthreads();
    float off = 0.f, tot = 0.f, rho = 0.f;
#pragma unroll
    for (int p = 0; p < 8; ++p) { const float v = PART[p * 64 + k]; if (p < pt) off += v; if (p < 4) rho += v; tot += v; }
#pragma unroll
    for (int i = 0; i < 8; ++i) bc[i] += off;
    if (MODE == 0) {
        u32x4 w; float e[8];
#pragma unroll
        for (int i = 0; i < 8; ++i) e[i] = kvv[i] * __expf(tot - bc[i]);
        w.x = pk2(e[0], e[1]); w.y = pk2(e[2], e[3]); w.z = pk2(e[4], e[5]); w.w = pk2(e[6], e[7]);
        *(LAS u32x4*)(L0 + k * LST + 8 * pt) = w;
        if (pt == 0) ((float*)(a.ws + WS_HDEC))[(size_t)item * 64 + k] = __expf(tot);
        __syncthreads();
        const int kt = wid >> 1;
#pragma unroll
        for (int q = 0; q < 2; ++q) { const int vt = 2 * (wid & 1) + q; f32x4 acc = {0.f, 0.f, 0.f, 0.f};
#pragma unroll
            for (int ks = 0; ks < 2; ++ks) { const bf16x8 x = *(const LAS bf16x8*)(L0 + (16 * kt + fr) * LST + 32 * ks + 8 * fq), y = *(const LAS bf16x8*)(VT + (16 * vt + fr) * LST + 32 * ks + 8 * fq);
                acc = mfma16(x, y, acc); }
            u32x2 w2; w2.x = pk2(acc[0], acc[1]); w2.y = pk2(acc[2], acc[3]);
            *(u32x2*)(KVT + (16 * vt + fr) * 64 + 16 * kt + 4 * fq) = w2; }
        __syncthreads();
    } else {
#pragma unroll
        for (int i = 0; i < 8; ++i) BC[(8 * pt + i) * 64 + k] = bc[i];
        if (pt == 0) RHO[k] = rho;
        __syncthreads();
        { const int t2 = tid >> 3, kg = tid & 7;
          const u32x4 qw = *(const u32x4*)(P + (size_t)(row0 + t2) * PS_ + PBQ + 64 * h + 8 * kg), zw = *(const u32x4*)(P + (size_t)(row0 + t2) * PS_ + PBF + 64 * h + 8 * kg);
          float q[8], z[8], qp[8], qt[8], kt_[8];
          q[0] = bflo(qw.x); q[1] = bfhi(qw.x); q[2] = bflo(qw.y); q[3] = bfhi(qw.y); q[4] = bflo(qw.z); q[5] = bfhi(qw.z); q[6] = bflo(qw.w); q[7] = bfhi(qw.w);
          z[0] = bflo(zw.x); z[1] = bfhi(zw.x); z[2] = bflo(zw.y); z[3] = bfhi(zw.y); z[4] = bflo(zw.z); z[5] = bfhi(zw.z); z[6] = bflo(zw.w); z[7] = bfhi(zw.w);
#pragma unroll
          for (int i = 0; i < 8; ++i) { const int kk = 8 * kg + i; float lb2 = 0.f; if (l == 1) lb2 = rcp_(1.0f + __expf(hl[64 * h + kk] - hl[384 + 64 * h + kk]));
              const float kvl = (1.0f - lb2) * rcp_(1.0f + __expf(z[i])); const float bcv = BC[t2 * 64 + kk], rh = RHO[kk]; const float qs = q[i] * 0.125f;
              qp[i] = qs * __expf(bcv); qt[i] = qs * __expf(bcv - rh); kt_[i] = kvl * __expf(rh - bcv); }
          u32x4 w; w.x = pk2(qp[0], qp[1]); w.y = pk2(qp[2], qp[3]); w.z = pk2(qp[4], qp[5]); w.w = pk2(qp[6], qp[7]); *(LAS u32x4*)(L0 + t2 * LST + 8 * kg) = w;
          w.x = pk2(qt[0], qt[1]); w.y = pk2(qt[2], qt[3]); w.z = pk2(qt[4], qt[5]); w.w = pk2(qt[6], qt[7]); *(LAS u32x4*)(L1 + t2 * LST + 8 * kg) = w;
          w.x = pk2(kt_[0], kt_[1]); w.y = pk2(kt_[2], kt_[3]); w.z = pk2(kt_[4], kt_[5]); w.w = pk2(kt_[6], kt_[7]); *(LAS u32x4*)(L2 + t2 * LST + 8 * kg) = w; }
        __syncthreads();
        const int tt = wid >> 1;
#pragma unroll
        for (int q = 0; q < 2; ++q) { const int st = 2 * (wid & 1) + q; f32x4 acc = {0.f, 0.f, 0.f, 0.f};
            if (st <= tt) {
#pragma unroll
                for (int ks = 0; ks < 2; ++ks) { const bf16x8 x = *(const LAS bf16x8*)(L2 + (16 * st + fr) * LST + 32 * ks + 8 * fq), y = *(const LAS bf16x8*)(L1 + (16 * tt + fr) * LST + 32 * ks + 8 * fq);
                    acc = mfma16(x, y, acc); }
                const int t = 16 * tt + fr;
#pragma unroll
                for (int j = 0; j < 4; ++j) { const int sidx = 16 * st + 4 * fq + j; if (sidx > t) acc[j] = 0.f; }
            }
            u32x2 w2; w2.x = pk2(acc[0], acc[1]); w2.y = pk2(acc[2], acc[3]);
            *(LAS u32x2*)(AM + (16 * tt + fr) * LST + 16 * st + 4 * fq) = w2; }
        __syncthreads();
        f32x4 o[2]; float ss = 0.f;
#pragma unroll
        for (int q = 0; q < 2; ++q) { const int vt = 2 * (wid & 1) + q; f32x4 acc = {0.f, 0.f, 0.f, 0.f};
#pragma unroll
            for (int ks = 0; ks < 2; ++ks) { const bf16x8 x = *(const bf16x8*)(KVT + (16 * vt + fr) * 64 + 32 * ks + 8 * fq), y = *(const LAS bf16x8*)(L0 + (16 * tt + fr) * LST + 32 * ks + 8 * fq);
                acc = mfma16(x, y, acc); }
#pragma unroll
            for (int ks = 0; ks < 2; ++ks) { const bf16x8 x = *(const LAS bf16x8*)(VT + (16 * vt + fr) * LST + 32 * ks + 8 * fq), y = *(const LAS bf16x8*)(AM + (16 * tt + fr) * LST + 32 * ks + 8 * fq);
                acc = mfma16(x, y, acc); }
            o[q] = acc; ss += (acc[0] * acc[0] + acc[1] * acc[1]) + (acc[2] * acc[2] + acc[3] * acc[3]); }
        ss += __shfl_xor(ss, 16); ss += __shfl_xor(ss, 32);
        if (fq == 0) SS[wid * 16 + fr] = ss;
        __syncthreads();
        const float tot2 = SS[wid * 16 + fr] + SS[(wid ^ 1) * 16 + fr];
        const float rs = rsq_(tot2 * (1.0f / 64.0f) + 1e-6f);
        bf16_t* Y = (bf16_t*)(a.ws + WS_HY);
#pragma unroll
        for (int q = 0; q < 2; ++q) { const int vt = 2 * (wid & 1) + q, t = 16 * tt + fr, cv = 64 * h + 16 * vt + 4 * fq;
            const u32x2 gw2 = *(const u32x2*)(P + (size_t)(row0 + t) * PS_ + PBG + cv);
            const f32x4 be = *(const f32x4*)(a.in[26] + l * 1024 + 256 + cv);
            float gg[4] = {bflo(gw2.x), bfhi(gw2.x), bflo(gw2.y), bfhi(gw2.y)}; float r[4];
#pragma unroll
            for (int j = 0; j < 4; ++j) r[j] = o[q][j] * rs * (gg[j] * sigmoidf_(gg[j])) * be[j];
            u32x2 w2; w2.x = pk2(r[0], r[1]); w2.y = pk2(r[2], r[3]);
            *(u32x2*)(Y + (size_t)(row0 + t) * D_ + 256 + cv) = w2; }
        __syncthreads();
    }
}
__device__ __forceinline__ void hgrn_scan(const Args& a, int e) {
    bf16_t* KVT = (bf16_t*)(a.ws + WS_HKV); const float* DEC = (const float*)(a.ws + WS_HDEC);
    const int bh = e >> 12, vk = e & 4095, k = vk & 63; float S = 0.f; unsigned short kv[32]; float dc[32];
#pragma unroll
    for (int c = 0; c < 32; ++c) { kv[c] = KVT[((size_t)(bh * 32 + c) << 12) + vk]; dc[c] = DEC[(bh * 32 + c) * 64 + k]; }
#pragma unroll
    for (int c = 0; c < 32; ++c) { KVT[((size_t)(bh * 32 + c) << 12) + vk] = (bf16_t)f2bf(S); S = dc[c] * S + bf2f(kv[c]); }
}
__device__ __forceinline__ f32x4 mfma16k16(s16x4 x, s16x4 y, f32x4 c) { return __builtin_amdgcn_mfma_f32_16x16x16bf16_1k(x, y, c, 0, 0, 0); }
__device__ __forceinline__ s16x4 pack4(f32x4 v) { u32x2 w; w.x = pk2(v[0], v[1]); w.y = pk2(v[2], v[3]); return __builtin_bit_cast(s16x4, w); }
__device__ __forceinline__ void unpack8(const u32x4 w, float* o) { o[0] = bflo(w.x); o[1] = bfhi(w.x); o[2] = bflo(w.y); o[3] = bfhi(w.y); o[4] = bflo(w.z); o[5] = bfhi(w.z); o[6] = bflo(w.w); o[7] = bfhi(w.w); }
__device__ __forceinline__ u32x4 pack8(const float* e) { u32x4 w; w.x = pk2(e[0], e[1]); w.y = pk2(e[2], e[3]); w.z = pk2(e[4], e[5]); w.w = pk2(e[6], e[7]); return w; }
__device__ __forceinline__ void shift8(const bf16_t* P, size_t row, bool has_prev, int col, const float* mu, float* o) {
    const u32x4 cw = *(const u32x4*)(P + row * PS_ + PC + col); u32x4 pw = {0u, 0u, 0u, 0u}; if (has_prev) pw = *(const u32x4*)(P + (row - 1) * PS_ + PC + col);
    float c[8], p[8]; unpack8(cw, c); unpack8(pw, p); const f32x4 m0 = *(const f32x4*)(mu + col), m1 = *(const f32x4*)(mu + col + 4);
#pragma unroll
    for (int i = 0; i < 8; ++i) o[i] = c[i] + (p[i] - c[i]) * (i < 4 ? m0[i] : m1[i - 4]);
}
constexpr int RW_LIN = 0, RW_LINS = 264;
constexpr int RW_RH = 0, RW_YL = 18432, RW_YLS = 68;
constexpr int RW_CUM = 33792, RW_PART = 50176;
constexpr int RW_LO = 52224, RW_LOS = 68;
constexpr int RW_AT = 52224, RW_BD = 61440, RW_KD = 70656, RW_RT = 79872, RW_BTT = 89088, RW_KTT = 98304, RW_VT = 107520, RW_NAB = 116736, RW_AK = 125952;
constexpr int RW_ARB = RW_BTT, RW_ARK = RW_KTT;
constexpr int RW_NABF = 135168, RW_TII = 139264;
template <int MODE>
__device__ __forceinline__ void rwkv_chunk(const Args& a, int l, int item, LAS unsigned char* lds) {
    const int tid = otid(), wid = tid >> 6, lane = tid & 63, fr = lane & 15, fq = lane >> 4;
    const int c = item & 31, bh = item >> 5, h = bh % 6, b = bh / 6;
    const size_t row0 = (size_t)b * T_ + 64 * c;
    const bf16_t* P = (const bf16_t*)(a.ws + WS_P);
    const bf16_t* LW = (const bf16_t*)(a.ws + WS_LORA) + (size_t)l * 98304;
    const float* mu = a.in[15] + l * 1408;
    LAS bf16_t* LIN = (LAS bf16_t*)(lds + RW_LIN);
    LAS float* CUM = (LAS float*)(lds + RW_CUM); LAS float* PART = (LAS float*)(lds + RW_PART); LAS float* LO = (LAS float*)(lds + RW_LO);
    LAS bf16_t* AT = (LAS bf16_t*)(lds + RW_AT); LAS bf16_t* BD = (LAS bf16_t*)(lds + RW_BD); LAS bf16_t* KD = (LAS bf16_t*)(lds + RW_KD); LAS bf16_t* RT = (LAS bf16_t*)(lds + RW_RT);
    LAS bf16_t* BTT = (LAS bf16_t*)(lds + RW_BTT); LAS bf16_t* KTT = (LAS bf16_t*)(lds + RW_KTT); LAS bf16_t* VT = (LAS bf16_t*)(lds + RW_VT);
    LAS bf16_t* NAB = (LAS bf16_t*)(lds + RW_NAB); LAS bf16_t* AK = (LAS bf16_t*)(lds + RW_AK); LAS bf16_t* ARB = (LAS bf16_t*)(lds + RW_ARB); LAS bf16_t* ARK = (LAS bf16_t*)(lds + RW_ARK);
    LAS float* NABF = (LAS float*)(lds + RW_NABF); LAS bf16_t* TII = (LAS bf16_t*)(lds + RW_TII);
    const int t2 = tid >> 3, kg = tid & 7; const size_t row = row0 + t2; const bool has_prev = (c > 0) || (t2 > 0);
    {
#pragma unroll
        for (int q = 0; q < 4; ++q) { float ps[8]; const int col = 32 * kg + 8 * q; shift8(P, row, has_prev, 1152 + col, mu, ps);
#pragma unroll
            for (int i = 0; i < 8; ++i) { if (kg < 2) { const float e = __expf(2.0f * ps[i]); ps[i] = 1.0f - 2.0f * rcp_(e + 1.0f); } else if (kg >= 4) ps[i] = sigmoidf_(ps[i]); }
            *(LAS u32x4*)(LIN + t2 * RW_LINS + col) = pack8(ps); }
    }
    float rr[8], kx[8], vx[8];
    shift8(P, row, has_prev, 64 * h + 8 * kg, mu, rr); shift8(P, row, has_prev, 384 + 64 * h + 8 * kg, mu, kx); shift8(P, row, has_prev, 768 + 64 * h + 8 * kg, mu, vx);
    __syncthreads();
    { const int tt = wid >> 1;
#pragma unroll
      for (int q = 0; q < 2; ++q) { const int ct = 2 * (wid & 1) + q; const int crow = 64 * h + 16 * ct + fr;
          f32x4 aw = {0.f, 0.f, 0.f, 0.f}, aa = {0.f, 0.f, 0.f, 0.f}, ag = {0.f, 0.f, 0.f, 0.f};
#pragma unroll
          for (int ks = 0; ks < 2; ++ks) { const bf16x8 x = *(const LAS bf16x8*)(LIN + (16 * tt + fr) * RW_LINS + 32 * ks + 8 * fq), y = *(const bf16x8*)(LW + (size_t)crow * 64 + 32 * ks + 8 * fq); aw = mfma16(x, y, aw); }
#pragma unroll
          for (int ks = 0; ks < 2; ++ks) { const bf16x8 x = *(const LAS bf16x8*)(LIN + (16 * tt + fr) * RW_LINS + 64 + 32 * ks + 8 * fq), y = *(const bf16x8*)(LW + 24576 + (size_t)crow * 64 + 32 * ks + 8 * fq); aa = mfma16(x, y, aa); }
#pragma unroll
          for (int ks = 0; ks < 4; ++ks) { const bf16x8 x = *(const LAS bf16x8*)(LIN + (16 * tt + fr) * RW_LINS + 128 + 32 * ks + 8 * fq), y = *(const bf16x8*)(LW + 49152 + (size_t)crow * 128 + 32 * ks + 8 * fq); ag = mfma16(x, y, ag); }
#pragma unroll
          for (int j = 0; j < 4; ++j) { const int o = (16 * tt + 4 * fq + j) * RW_LOS + 16 * ct + fr; LO[o] = aw[j]; LO[64 * RW_LOS + o] = aa[j]; LO[2 * 64 * RW_LOS + o] = ag[j]; } }
    }
    __syncthreads();
    float gg[8], lw[8], be[8], al[8], kp[8]; float rkt = 0.f;
    { const int cb = l * 384 + 64 * h + 8 * kg; float wa[8], av[8];
      *(f32x4*)&wa[0] = *(const LAS f32x4*)(LO + t2 * RW_LOS + 8 * kg); *(f32x4*)&wa[4] = *(const LAS f32x4*)(LO + t2 * RW_LOS + 8 * kg + 4);
      *(f32x4*)&av[0] = *(const LAS f32x4*)(LO + 64 * RW_LOS + t2 * RW_LOS + 8 * kg); *(f32x4*)&av[4] = *(const LAS f32x4*)(LO + 64 * RW_LOS + t2 * RW_LOS + 8 * kg + 4);
      *(f32x4*)&gg[0] = *(const LAS f32x4*)(LO + 128 * RW_LOS + t2 * RW_LOS + 8 * kg); *(f32x4*)&gg[4] = *(const LAS f32x4*)(LO + 128 * RW_LOS + t2 * RW_LOS + 8 * kg + 4);
      float ssq = 0.f, kkr[8]; float p_w0[8], p_a0[8], p_kk[8], p_ka[8], p_rk[8];
      *(f32x4*)&p_w0[0] = *(const f32x4*)(a.in[16] + cb); *(f32x4*)&p_w0[4] = *(const f32x4*)(a.in[16] + cb + 4);
      *(f32x4*)&p_a0[0] = *(const f32x4*)(a.in[18] + cb); *(f32x4*)&p_a0[4] = *(const f32x4*)(a.in[18] + cb + 4);
      *(f32x4*)&p_kk[0] = *(const f32x4*)(a.in[21] + cb); *(f32x4*)&p_kk[4] = *(const f32x4*)(a.in[21] + cb + 4);
      *(f32x4*)&p_ka[0] = *(const f32x4*)(a.in[22] + cb); *(f32x4*)&p_ka[4] = *(const f32x4*)(a.in[22] + cb + 4);
      *(f32x4*)&p_rk[0] = *(const f32x4*)(a.in[23] + cb); *(f32x4*)&p_rk[4] = *(const f32x4*)(a.in[23] + cb + 4);
#pragma unroll
      for (int i = 0; i < 8; ++i) { const float wp = wa[i] + p_w0[i]; const float w = -__logf(1.0f + __expf(-wp)) - 0.5f; lw[i] = -__expf(w);
          const float aa = sigmoidf_(av[i] + p_a0[i]);
          kkr[i] = kx[i] * p_kk[i]; ssq += kkr[i] * kkr[i];
          kp[i] = kx[i] * (1.0f + (aa - 1.0f) * p_ka[i]); be[i] = aa;
          rkt += rr[i] * kp[i] * p_rk[i]; }
      ssq += __shfl_xor(ssq, 1); ssq += __shfl_xor(ssq, 2); ssq += __shfl_xor(ssq, 4);
      rkt += __shfl_xor(rkt, 1); rkt += __shfl_xor(rkt, 2); rkt += __shfl_xor(rkt, 4);
      const float rn = rsq_(ssq + 1e-12f);
#pragma unroll
      for (int i = 0; i < 8; ++i) { const float kk = kkr[i] * rn; al[i] = -kk; be[i] = kk * be[i]; }
#pragma unroll
      for (int i = 0; i < 8; ++i) CUM[t2 * 64 + 8 * kg + i] = lw[i];
    }
    __syncthreads();
    { const int k = lane, pt = wid; float s = 0.f; float cv[8];
#pragma unroll
      for (int i = 0; i < 8; ++i) { s += CUM[(8 * pt + i) * 64 + k]; cv[i] = s; }
      PART[pt * 64 + k] = s;
      __syncthreads();
      float off = 0.f;
#pragma unroll
      for (int p = 0; p < 8; ++p) { const float v = PART[p * 64 + k]; if (p < pt) off += v; }
#pragma unroll
      for (int i = 0; i < 8; ++i) CUM[(8 * pt + i) * 64 + k] = cv[i] + off;
    }
    __syncthreads();
    { float cu[8], cl[8], e[8];
      *(f32x4*)&cu[0] = *(const LAS f32x4*)(CUM + t2 * 64 + 8 * kg); *(f32x4*)&cu[4] = *(const LAS f32x4*)(CUM + t2 * 64 + 8 * kg + 4);
      *(f32x4*)&cl[0] = *(const LAS f32x4*)(CUM + 63 * 64 + 8 * kg); *(f32x4*)&cl[4] = *(const LAS f32x4*)(CUM + 63 * 64 + 8 * kg + 4);
#pragma unroll
      for (int i = 0; i < 8; ++i) e[i] = al[i] * __expf(cu[i] - lw[i]);
      *(LAS u32x4*)(AT + t2 * LST + 8 * kg) = pack8(e);
      float en[8];
#pragma unroll
      for (int i = 0; i < 8; ++i) en[i] = __expf(-cu[i]);
#pragma unroll
      for (int i = 0; i < 8; ++i) e[i] = be[i] * en[i];
      *(LAS u32x4*)(BD + t2 * LST + 8 * kg) = pack8(e);
#pragma unroll
      for (int i = 0; i < 8; ++i) e[i] = kp[i] * en[i];
      *(LAS u32x4*)(KD + t2 * LST + 8 * kg) = pack8(e);
      if (MODE == 1) {
#pragma unroll
          for (int i = 0; i < 8; ++i) e[i] = rr[i] * __expf(cu[i]);
          *(LAS u32x4*)(RT + t2 * LST + 8 * kg) = pack8(e);
      } else {
#pragma unroll
          for (int i = 0; i < 8; ++i) { const float ed = __expf(cl[i] - cu[i]); BTT[(8 * kg + i) * LST + t2] = (bf16_t)f2bf(be[i] * ed); KTT[(8 * kg + i) * LST + t2] = (bf16_t)f2bf(kp[i] * ed); }
          if (t2 == 63) {
#pragma unroll
              for (int i = 0; i < 8; ++i) ((float*)(a.ws + WS_RGAM))[(size_t)item * 64 + 8 * kg + i] = __expf(cl[i]); }
      }
#pragma unroll
      for (int i = 0; i < 8; ++i) VT[(8 * kg + i) * LST + t2] = (bf16_t)f2bf(vx[i]);
    }
    __syncthreads();
    { const int tt = wid >> 1;
#pragma unroll
      for (int q = 0; q < 2; ++q) { const int st = 2 * (wid & 1) + q;
          f32x4 ab = {0.f, 0.f, 0.f, 0.f}, ak = {0.f, 0.f, 0.f, 0.f}, rb = {0.f, 0.f, 0.f, 0.f}, rk = {0.f, 0.f, 0.f, 0.f};
          if (st <= tt) {
#pragma unroll
              for (int ks = 0; ks < 2; ++ks) { const int ao = (16 * st + fr) * LST + 32 * ks + 8 * fq, bo = (16 * tt + fr) * LST + 32 * ks + 8 * fq;
                  const bf16x8 xb = *(const LAS bf16x8*)(BD + ao), xk = *(const LAS bf16x8*)(KD + ao), ya = *(const LAS bf16x8*)(AT + bo);
                  ab = mfma16(xb, ya, ab); ak = mfma16(xk, ya, ak);
                  if (MODE == 1) { const bf16x8 yr = *(const LAS bf16x8*)(RT + bo); rb = mfma16(xb, yr, rb); rk = mfma16(xk, yr, rk); } }
              const int t = 16 * tt + fr;
#pragma unroll
              for (int j = 0; j < 4; ++j) { const int s = 16 * st + 4 * fq + j; if (s >= t) { ab[j] = 0.f; ak[j] = 0.f; } if (s > t) { rb[j] = 0.f; rk[j] = 0.f; } }
              if (st == tt) *(LAS f32x4*)(NABF + tt * 256 + fr * 16 + 4 * fq) = ab;
          }
          const int o = (16 * tt + fr) * LST + 16 * st + 4 * fq;
          *(LAS s16x4*)(NAB + o) = pack4(ab); *(LAS s16x4*)(AK + o) = pack4(ak);
          if (MODE == 1) { *(LAS s16x4*)(ARB + o) = pack4(rb); *(LAS s16x4*)(ARK + o) = pack4(rk); } }
    }
    __syncthreads();
    f32x4 R[4];
    if (wid == 0) { const int blk = fq, j = fr; float Tc[16];
#pragma unroll
        for (int i = 0; i < 16; ++i) { float acc = (i == j) ? 1.0f : 0.0f;
#pragma unroll
            for (int m = 0; m < 16; ++m) if (m < i) acc += NABF[blk * 256 + i * 16 + m] * Tc[m];
            Tc[i] = acc; TII[blk * 256 + i * 16 + j] = (bf16_t)f2bf(acc); }
    }
    if (wid >= 4) { const int vt = wid - 4;
#pragma unroll
        for (int I = 0; I < 4; ++I) { f32x4 acc = {0.f, 0.f, 0.f, 0.f};
#pragma unroll
            for (int ks = 0; ks < 2; ++ks) { const bf16x8 x = *(const LAS bf16x8*)(AK + (16 * I + fr) * LST + 32 * ks + 8 * fq), y = *(const LAS bf16x8*)(VT + (16 * vt + fr) * LST + 32 * ks + 8 * fq); acc = mfma16(x, y, acc); }
            R[I] = acc; }
    } else {
#pragma unroll
        for (int I = 0; I < 4; ++I)
#pragma unroll
            for (int j = 0; j < 4; ++j) R[I][j] = bf2f(AT[(16 * I + 4 * fq + j) * LST + 16 * wid + fr]);
    }
    __syncthreads();
    s16x4 Xb[4];
#pragma unroll
    for (int I = 0; I < 4; ++I) { f32x4 acc = R[I];
#pragma unroll
        for (int J = 0; J < 4; ++J) if (J < I) acc = mfma16k16(*(const LAS s16x4*)(NAB + (16 * I + fr) * LST + 16 * J + 4 * fq), Xb[J], acc);
        const f32x4 z = {0.f, 0.f, 0.f, 0.f};
        const f32x4 x = mfma16k16(*(const LAS s16x4*)(TII + I * 256 + fr * 16 + 4 * fq), pack4(acc), z);
        Xb[I] = pack4(x); }
    s16x4 Vf[4];
    if (wid >= 4) {
#pragma unroll
        for (int J = 0; J < 4; ++J) Vf[J] = *(const LAS s16x4*)(VT + (16 * (wid - 4) + fr) * LST + 16 * J + 4 * fq); }
    if (MODE == 0) {
#pragma unroll
        for (int kt = 0; kt < 4; ++kt) { f32x4 acc = {0.f, 0.f, 0.f, 0.f};
#pragma unroll
            for (int J = 0; J < 4; ++J) acc = mfma16k16(*(const LAS s16x4*)(BTT + (16 * kt + fr) * LST + 16 * J + 4 * fq), Xb[J], acc);
            if (wid >= 4) {
#pragma unroll
                for (int J = 0; J < 4; ++J) acc = mfma16k16(*(const LAS s16x4*)(KTT + (16 * kt + fr) * LST + 16 * J + 4 * fq), Vf[J], acc);
                *(s16x4*)((bf16_t*)(a.ws + WS_RN) + (size_t)item * 4096 + ((kt * 4 + (wid - 4)) * 64 + lane) * 4) = pack4(acc);
            } else { bf16_t* RM = (bf16_t*)(a.ws + WS_RM) + (size_t)item * 4096;
#pragma unroll
                for (int j = 0; j < 4; ++j) RM[(16 * kt + 4 * fq + j) * 64 + 16 * wid + fr] = (bf16_t)f2bf(acc[j]); } }
        __syncthreads();
    } else {
        LAS bf16_t* RH = (LAS bf16_t*)(lds + RW_RH); LAS float* YL = (LAS float*)(lds + RW_YL);
        f32x4 yh[4];
#pragma unroll
        for (int tt = 0; tt < 4; ++tt) { f32x4 acc = {0.f, 0.f, 0.f, 0.f};
            if (wid < 4) {
#pragma unroll
                for (int j = 0; j < 4; ++j) acc[j] = bf2f(RT[(16 * tt + 4 * fq + j) * LST + 16 * wid + fr]); }
#pragma unroll
            for (int J = 0; J < 4; ++J) if (J <= tt) acc = mfma16k16(*(const LAS s16x4*)(ARB + (16 * tt + fr) * LST + 16 * J + 4 * fq), Xb[J], acc);
            if (wid >= 4) {
#pragma unroll
                for (int J = 0; J < 4; ++J) if (J <= tt) acc = mfma16k16(*(const LAS s16x4*)(ARK + (16 * tt + fr) * LST + 16 * J + 4 * fq), Vf[J], acc);
                yh[tt] = acc;
            } else {
#pragma unroll
                for (int j = 0; j < 4; ++j) RH[(16 * tt + 4 * fq + j) * LST + 16 * wid + fr] = (bf16_t)f2bf(acc[j]); } }
        __syncthreads();
        if (wid >= 4) { const int vt = wid - 4; s16x4 S0[4];
#pragma unroll
            for (int kt = 0; kt < 4; ++kt) S0[kt] = *(const s16x4*)((const bf16_t*)(a.ws + WS_RN) + (size_t)item * 4096 + ((kt * 4 + vt) * 64 + lane) * 4);
#pragma unroll
            for (int tt = 0; tt < 4; ++tt) { f32x4 acc = yh[tt];
#pragma unroll
                for (int kt = 0; kt < 4; ++kt) acc = mfma16k16(*(const LAS s16x4*)(RH + (16 * tt + fr) * LST + 16 * kt + 4 * fq), S0[kt], acc);
#pragma unroll
                for (int j = 0; j < 4; ++j) YL[(16 * tt + 4 * fq + j) * RW_YLS + 16 * vt + fr] = acc[j]; } }
        __syncthreads();
        { const int cb = l * 384 + 64 * h + 8 * kg; float y[8];
          *(f32x4*)&y[0] = *(const LAS f32x4*)(YL + t2 * RW_YLS + 8 * kg); *(f32x4*)&y[4] = *(const LAS f32x4*)(YL + t2 * RW_YLS + 8 * kg + 4);
          float sm = 0.f;
#pragma unroll
          for (int i = 0; i < 8; ++i) sm += y[i];
          sm += __shfl_xor(sm, 1); sm += __shfl_xor(sm, 2); sm += __shfl_xor(sm, 4);
          const float mean = sm * (1.0f / 64.0f); float vr = 0.f;
#pragma unroll
          for (int i = 0; i < 8; ++i) { y[i] -= mean; vr += y[i] * y[i]; }
          vr += __shfl_xor(vr, 1); vr += __shfl_xor(vr, 2); vr += __shfl_xor(vr, 4);
          const float rs = rsq_(vr * (1.0f / 64.0f) + 64e-5f); float o[8]; float p_lw[8], p_lb[8], p_be[8];
          *(f32x4*)&p_lw[0] = *(const f32x4*)(a.in[24] + cb); *(f32x4*)&p_lw[4] = *(const f32x4*)(a.in[24] + cb + 4);
          *(f32x4*)&p_lb[0] = *(const f32x4*)(a.in[25] + cb); *(f32x4*)&p_lb[4] = *(const f32x4*)(a.in[25] + cb + 4);
          *(f32x4*)&p_be[0] = *(const f32x4*)(a.in[26] + l * 1024 + 640 + 64 * h + 8 * kg); *(f32x4*)&p_be[4] = *(const f32x4*)(a.in[26] + l * 1024 + 640 + 64 * h + 8 * kg + 4);
#pragma unroll
          for (int i = 0; i < 8; ++i) o[i] = ((y[i] * rs * p_lw[i] + p_lb[i]) + rkt * vx[i]) * gg[i] * p_be[i];
          *(u32x4*)((bf16_t*)(a.ws + WS_HY) + row * D_ + 640 + 64 * h + 8 * kg) = pack8(o); }
        __syncthreads();
    }
}
__device__ __forceinline__ void rwkv_scan(const Args& a, int bh, int vt, int lane) {
    const int fr = lane & 15, fq = lane >> 4;
    const bf16_t* RM = (const bf16_t*)(a.ws + WS_RM); bf16_t* RN = (bf16_t*)(a.ws + WS_RN); const float* GAM = (const float*)(a.ws + WS_RGAM);
    f32x4 S[4];
#pragma unroll
    for (int k = 0; k < 4; ++k) S[k] = (f32x4){0.f, 0.f, 0.f, 0.f};
    s16x4 Mn[4][4]; s16x4 Nn[4]; f32x4 gn[4];
#define RWS_LOAD(cc) { const size_t it_ = (size_t)bh * 32 + (cc); _Pragma("unroll") for (int kt = 0; kt < 4; ++kt) { _Pragma("unroll") for (int k2 = 0; k2 < 4; ++k2) Mn[kt][k2] = *(const s16x4*)(RM + it_ * 4096 + (16 * kt + fr) * 64 + 16 * k2 + 4 * fq); \
            Nn[kt] = *(const s16x4*)(RN + it_ * 4096 + ((kt * 4 + vt) * 64 + lane) * 4); gn[kt] = *(const f32x4*)(GAM + it_ * 64 + 16 * kt + 4 * fq); } }
    RWS_LOAD(0)
#pragma unroll 1
    for (int c = 0; c < 32; ++c) { const size_t item = (size_t)bh * 32 + c;
        s16x4 Mf[4][4]; s16x4 Nf[4]; f32x4 gam[4];
#pragma unroll
        for (int kt = 0; kt < 4; ++kt) { Nf[kt] = Nn[kt]; gam[kt] = gn[kt];
#pragma unroll
            for (int k2 = 0; k2 < 4; ++k2) Mf[kt][k2] = Mn[kt][k2]; }
        if (c < 31) RWS_LOAD(c + 1)
        s16x4 Sb[4];
#pragma unroll
        for (int k = 0; k < 4; ++k) { Sb[k] = pack4(S[k]); *(s16x4*)(RN + item * 4096 + ((k * 4 + vt) * 64 + lane) * 4) = Sb[k]; }
#pragma unroll
        for (int kt = 0; kt < 4; ++kt) { const u32x2 nw = __builtin_bit_cast(u32x2, Nf[kt]);
            f32x4 acc = gam[kt] * S[kt] + (f32x4){bflo(nw.x), bfhi(nw.x), bflo(nw.y), bfhi(nw.y)};
#pragma unroll
            for (int k2 = 0; k2 < 4; ++k2) acc = mfma16k16(Mf[kt][k2], Sb[k2], acc);
            S[kt] = acc; }
    }
#undef RWS_LOAD
}
__device__ __forceinline__ float shiftmix(const bf16_t* P, size_t row, int tglob, int col, float mu) {
    const float cur = bf2f(P[row * PS_ + PC + col]); const float prev = (tglob > 0) ? bf2f(P[(row - 1) * PS_ + PC + col]) : 0.f; return cur + (prev - cur) * mu; }
__device__ __forceinline__ void rwkv_seq(const Args& a, int l, int bh, LAS unsigned char* lds) {
    const int tid = otid(), wid = tid >> 6, lane = tid & 63, h = bh % 6, b = bh / 6;
    const bf16_t* P = (const bf16_t*)(a.ws + WS_P); bf16_t* Y = (bf16_t*)(a.ws + WS_HY);
    LAS float* LIN = (LAS float*)lds;
    LAS float* VEC = (LAS float*)(lds + 32768);
    LAS float* YL = (LAS float*)(lds + 90112);
    const float* mu = a.in[15] + l * 1408;
    float S[64];
#pragma unroll
    for (int k = 0; k < 64; ++k) S[k] = 0.f;
    const int t = tid >> 4, jg = tid & 15;
#pragma unroll 1
    for (int tb = 0; tb < T_; tb += 32) {
        const size_t row = (size_t)b * T_ + tb + t; const int tglob = tb + t;
#pragma unroll 4
        for (int i = 0; i < 16; ++i) { const int col = 16 * jg + i; const float ps = shiftmix(P, row, tglob, 1152 + col, mu[1152 + col]);
            float v; if (col < 64) { const float e = __expf(2.0f * ps); v = 1.0f - 2.0f / (e + 1.0f); } else if (col < 128) v = ps; else v = sigmoidf_(ps);
            LIN[t * 256 + col] = v; }
        __syncthreads();
        { const int cb = l * 384 + 64 * h + 4 * jg;
          f32x4 wacc = *(const f32x4*)(a.in[16] + cb), aacc = *(const f32x4*)(a.in[18] + cb), gacc = {0.f, 0.f, 0.f, 0.f};
          const float* wu = a.in[17] + (size_t)l * 64 * 384 + 64 * h + 4 * jg; const float* au = a.in[19] + (size_t)l * 64 * 384 + 64 * h + 4 * jg; const float* gu = a.in[20] + (size_t)l * 128 * 384 + 64 * h + 4 * jg;
#pragma unroll 4
          for (int i = 0; i < 64; ++i) { const float x = LIN[t * 256 + i]; wacc += x * *(const f32x4*)(wu + (size_t)i * 384); }
#pragma unroll 4
          for (int i = 0; i < 64; ++i) { const float x = LIN[t * 256 + 64 + i]; aacc += x * *(const f32x4*)(au + (size_t)i * 384); }
#pragma unroll 4
          for (int i = 0; i < 128; ++i) { const float x = LIN[t * 256 + 128 + i]; gacc += x * *(const f32x4*)(gu + (size_t)i * 384); }
          float kk[4], kp[4], aa[4], dec[4], rr[4], vv[4]; float ssq = 0.f;
#pragma unroll
          for (int j = 0; j < 4; ++j) { const int hc = 64 * h + 4 * jg + j;
              const float wp = wacc[j]; const float w = -log1pf(__expf(-wp)) - 0.5f; dec[j] = __expf(-__expf(w));
              aa[j] = sigmoidf_(aacc[j]);
              rr[j] = shiftmix(P, row, tglob, hc, mu[hc]); const float kx = shiftmix(P, row, tglob, 384 + hc, mu[384 + hc]); vv[j] = shiftmix(P, row, tglob, 768 + hc, mu[768 + hc]);
              kk[j] = kx * a.in[21][l * 384 + hc]; ssq += kk[j] * kk[j];
              kp[j] = kx * (1.0f + (aa[j] - 1.0f) * a.in[22][l * 384 + hc]); }
          ssq += __shfl_xor(ssq, 1); ssq += __shfl_xor(ssq, 2); ssq += __shfl_xor(ssq, 4); ssq += __shfl_xor(ssq, 8);
          const float rn = 1.0f / sqrtf(ssq + 1e-12f);
#pragma unroll
          for (int j = 0; j < 4; ++j) { const int jj = 4 * jg + j; const float kn = kk[j] * rn;
              VEC[(t * 7 + 0) * 64 + jj] = kn; VEC[(t * 7 + 1) * 64 + jj] = dec[j]; VEC[(t * 7 + 2) * 64 + jj] = kp[j]; VEC[(t * 7 + 3) * 64 + jj] = kn * aa[j];
              VEC[(t * 7 + 4) * 64 + jj] = rr[j]; VEC[(t * 7 + 5) * 64 + jj] = vv[j]; VEC[(t * 7 + 6) * 64 + jj] = gacc[j]; } }
        __syncthreads();
        if (wid == 0) {
#pragma unroll 1
            for (int ts = 0; ts < 32; ++ts) { const LAS f32x4* V4 = (const LAS f32x4*)(VEC + ts * 7 * 64);
                const float vv = VEC[(ts * 7 + 5) * 64 + lane]; float sa = 0.f;
#pragma unroll
                for (int k4 = 0; k4 < 16; ++k4) { const f32x4 q = V4[k4]; sa += S[4 * k4] * q.x; sa += S[4 * k4 + 1] * q.y; sa += S[4 * k4 + 2] * q.z; sa += S[4 * k4 + 3] * q.w; }
                sa = -sa; float y = 0.f;
#pragma unroll
                for (int k4 = 0; k4 < 16; ++k4) { const f32x4 w = V4[16 + k4], kp = V4[32 + k4], ka = V4[48 + k4], r = V4[64 + k4];
                    S[4 * k4] = S[4 * k4] * w.x + sa * ka.x + vv * kp.x; S[4 * k4 + 1] = S[4 * k4 + 1] * w.y + sa * ka.y + vv * kp.y;
                    S[4 * k4 + 2] = S[4 * k4 + 2] * w.z + sa * ka.z + vv * kp.z; S[4 * k4 + 3] = S[4 * k4 + 3] * w.w + sa * ka.w + vv * kp.w;
                    y += S[4 * k4] * r.x; y += S[4 * k4 + 1] * r.y; y += S[4 * k4 + 2] * r.z; y += S[4 * k4 + 3] * r.w; }
                YL[ts * 64 + lane] = y; }
        }
        __syncthreads();
        { const int cb = l * 384 + 64 * h + 4 * jg; const f32x4 y4 = *(const LAS f32x4*)(YL + t * 64 + 4 * jg);
          float sm = (y4.x + y4.y) + (y4.z + y4.w); sm += __shfl_xor(sm, 1); sm += __shfl_xor(sm, 2); sm += __shfl_xor(sm, 4); sm += __shfl_xor(sm, 8);
          const float mean = sm * (1.0f / 64.0f); const f32x4 d = y4 - mean;
          float vr = (d.x * d.x + d.y * d.y) + (d.z * d.z + d.w * d.w); vr += __shfl_xor(vr, 1); vr += __shfl_xor(vr, 2); vr += __shfl_xor(vr, 4); vr += __shfl_xor(vr, 8);
          const float rs = 1.0f / sqrtf(vr * (1.0f / 64.0f) + 64e-5f);
          const f32x4 rk = *(const f32x4*)(a.in[23] + cb), lw = *(const f32x4*)(a.in[24] + cb), lb = *(const f32x4*)(a.in[25] + cb), be = *(const f32x4*)(a.in[26] + l * 1024 + 640 + 64 * h + 4 * jg);
          float bs = 0.f; float r4[4], v4[4], g4[4];
#pragma unroll
          for (int j = 0; j < 4; ++j) { const int jj = 4 * jg + j; r4[j] = VEC[(t * 7 + 4) * 64 + jj]; v4[j] = VEC[(t * 7 + 5) * 64 + jj]; g4[j] = VEC[(t * 7 + 6) * 64 + jj]; bs += r4[j] * VEC[(t * 7 + 2) * 64 + jj] * rk[j]; }
          bs += __shfl_xor(bs, 1); bs += __shfl_xor(bs, 2); bs += __shfl_xor(bs, 4); bs += __shfl_xor(bs, 8);
          float o[4];
#pragma unroll
          for (int j = 0; j < 4; ++j) o[j] = ((d[j] * rs * lw[j] + lb[j]) + bs * v4[j]) * g4[j] * be[j];
          u32x2 w2; w2.x = pk2(o[0], o[1]); w2.y = pk2(o[2], o[3]);
          *(u32x2*)(Y + row * D_ + 640 + 64 * h + 4 * jg) = w2; }
        __syncthreads();
    }
}
__global__ void __launch_bounds__(512, 2) mk_fwd(Args a) {
    extern __shared__ __attribute__((aligned(16))) unsigned char shm[];
    LAS unsigned char* lds = (LAS unsigned char*)shm;
    cg::grid_group grid = cg::this_grid();
    if (a.ph_hi > 1000) grid.sync();
    { volatile LAS unsigned* stw = (volatile LAS unsigned*)(lds + LDS_BYTES - 16); if (threadIdx.x < 4) stw[threadIdx.x] = 0u; }
    __syncthreads();
    XcdBarrier xb = xcd_barrier_post((unsigned*)(a.ws + WS_BAR), (volatile LAS unsigned*)(lds + LDS_BYTES - 16));
    const int tid = otid(), wid = tid >> 6, lane = tid & 63, G = gridDim.x;
    unsigned char* ws = a.ws;
    bf16_t* Pb = (bf16_t*)(ws + WS_P); bf16_t* HY = (bf16_t*)(ws + WS_HY); float* MOD = (float*)(ws + WS_MOD);
#ifdef MK_PROBE
    unsigned long long t_prev = __builtin_amdgcn_s_memrealtime(), t_acc = 0;
#define PH_STAMP(n) { grid.sync(); const unsigned long long t_now = __builtin_amdgcn_s_memrealtime(); if ((MK_PROBE >> (n)) & 1) t_acc += t_now - t_prev; t_prev = t_now; }
#else
#define PH_STAMP(n)
#endif
#ifndef MK_SUB
#define MK_SUB 0
#endif
#ifndef MK_REP
#define MK_REP 0
#endif
#define PH_BEGIN(n) if (a.ph_lo <= (n) && (n) < a.ph_hi) { const int ph_cur = (n); (void)ph_cur; if ((n) > a.ph_lo) xcd_barrier(xb); for (int rep_ = 0; rep_ < (((MK_REP >> (n)) & 1) ? 2 : 1); ++rep_) {
#define PH_END } PH_STAMP(ph_cur) }
    PH_BEGIN(0) phase_pro(a, lds); PH_END
#pragma unroll
    for (int l = 0; l < 2; ++l) {
        const int p0 = 1 + 9 * l;
        const float* xin = (l == 0) ? a.in[0] : a.out;
        const float* modl = MOD + (size_t)l * 8 * 6144;
        PH_BEGIN(p0 + 0) phase_norm(xin, a.in[2] + l * D_, modl + 0, modl + 1024, HY); PH_END
        PH_BEGIN(p0 + 1) { pg8::Gemm g{HY, (const bf16_t*)(ws + WS_WIN + l * SZ_WIN), M_, PS_, D_}; pg8::StaticOrder S; S.init(M_, PS_, G, blockIdx.x); EpiP E{Pb, PS_};
                  pg8::gemm_phase<EpiP, pg8::StaticOrder>(lds, g, S, E, nullptr); } PH_END
        PH_BEGIN(p0 + 2) { for (int r_ = 0; r_ < ((MK_SUB & 1) ? 2 : 1); ++r_) for (int it = blockIdx.x; it < 1536; it += G) hgrn_item<0>(a, l, it, lds);
                  for (int r_ = 0; r_ < ((MK_SUB & 2) ? 2 : 1); ++r_) for (int it = blockIdx.x; it < 1536; it += G) rwkv_chunk<0>(a, l, it, lds);
                  for (int r_ = 0; r_ < ((MK_SUB & 4) ? 2 : 1); ++r_) for (int it = (otid() >> 6) * G + blockIdx.x; it < 1024; it += G * 8) rg_item<0>(a, l, it, otid() & 63); } PH_END
        PH_BEGIN(p0 + 3) { const int t3 = otid();
                  if (t3 < 64) { if ((int)blockIdx.x < 192) rwkv_scan(a, blockIdx.x >> 2, blockIdx.x & 3, t3); }
                  else { for (int e = blockIdx.x * 448 + (t3 - 64); e < 48 * 4096; e += G * 448) hgrn_scan(a, e);
                         for (int e = blockIdx.x * 448 + (t3 - 64); e < 2048; e += G * 448) rg_carry(a, e); } } PH_END
        PH_BEGIN(p0 + 4) { for (int r_ = 0; r_ < ((MK_SUB & 1) ? 2 : 1); ++r_) for (int it = blockIdx.x; it < 1536; it += G) hgrn_item<1>(a, l, it, lds);
                  for (int r_ = 0; r_ < ((MK_SUB & 2) ? 2 : 1); ++r_) for (int it = blockIdx.x; it < 1536; it += G) rwkv_chunk<1>(a, l, it, lds);
                  for (int r_ = 0; r_ < ((MK_SUB & 4) ? 2 : 1); ++r_) for (int it = (otid() >> 6) * G + blockIdx.x; it < 1024; it += G * 8) rg_item<1>(a, l, it, otid() & 63); } PH_END
        PH_BEGIN(p0 + 5) { pg8::Gemm g{HY, (const bf16_t*)(ws + WS_WOUT + l * SZ_WOUT), M_, D_, D_}; pg8::StaticOrder S; S.init(M_, D_, G, blockIdx.x); EpiRes E{xin, a.out, modl + 2048};
                  pg8::gemm_phase<EpiRes, pg8::StaticOrder>(lds, g, S, E, nullptr); } PH_END
        PH_BEGIN(p0 + 6) phase_norm(a.out, a.in[3] + l * D_, modl + 3072, modl + 4096, HY); PH_END
        PH_BEGIN(p0 + 7) { pg8::Gemm g{HY, (const bf16_t*)(ws + WS_WGU + l * SZ_WGU), M_, NGU_, D_}; pg8::StaticOrder S; S.init(M_, NGU_, G, blockIdx.x); EpiSwi E{Pb};
                  pg8::gemm_phase<EpiSwi, pg8::StaticOrder>(lds, g, S, E, nullptr); } PH_END
        PH_BEGIN(p0 + 8) { pg8::Gemm g{Pb, (const bf16_t*)(ws + WS_WD + l * SZ_WD), M_, D_, FF_}; pg8::StaticOrder S; S.init(M_, D_, G, blockIdx.x); EpiRes E{a.out, a.out, modl + 5120};
                  pg8::gemm_phase<EpiRes, pg8::StaticOrder>(lds, g, S, E, nullptr); } PH_END
    }
    PH_BEGIN(19) phase_final(a.out, a.in[31]); PH_END
#ifdef MK_PROBE
    if (blockIdx.x == 0 && threadIdx.x == 0) a.out[0] = (float)t_acc * 0.01f;
#endif
}
#ifndef MK_MULTI
#define MK_MULTI 0
#endif
extern "C" void kernel_launch(void* const* d_in, const int* in_sizes, int n_in, void* d_out, int out_size, void* d_ws, size_t ws_size, hipStream_t stream) {
    static int grid = 0;
    if (!grid) {
        if (n_in != 32 || ws_size < WS_END) { fprintf(stderr, "kernel_launch: bad args n_in %d ws %zu need %zu\n", n_in, ws_size, (size_t)WS_END); return; }
        hipFuncSetAttribute((const void*)mk_fwd, hipFuncAttributeMaxDynamicSharedMemorySize, LDS_BYTES);
        int dev = 0, cus = 0, per_cu = 0; hipGetDevice(&dev); hipDeviceGetAttribute(&cus, hipDeviceAttributeMultiprocessorCount, dev);
        hipOccupancyMaxActiveBlocksPerMultiprocessor(&per_cu, mk_fwd, 512, LDS_BYTES);
        if (per_cu < 1) { fprintf(stderr, "kernel_launch: occupancy 0\n"); per_cu = 1; }
        grid = cus;
    }
    Args a{}; for (int i = 0; i < 32; ++i) a.in[i] = (const float*)d_in[i];
    a.out = (float*)d_out; a.ws = (unsigned char*)d_ws;
#if MK_MULTI
    for (int ph = 0; ph < 20; ++ph) { a.ph_lo = ph; a.ph_hi = ph + 1; hipLaunchKernelGGL(mk_fwd, dim3(grid), dim3(512), LDS_BYTES, stream, a); }
#else
    a.ph_lo = 0; a.ph_hi = 20; void* args[] = {&a};
    if (hipMemsetAsync((char*)d_ws + WS_BAR, 0, XCD_BAR_WORDS * 4, stream) != hipSuccess) { fprintf(stderr, "memset failed\n"); return; }
    hipError_t e = hipLaunchCooperativeKernel((const void*)mk_fwd, dim3(grid), dim3(512), args, LDS_BYTES, stream);
    if (e != hipSuccess) fprintf(stderr, "cooperative launch failed: %s (grid %d)\n", hipGetErrorString(e), grid);
#endif
}
```

```cpp
#include <hip/hip_runtime.h>
#include <hip/hip_cooperative_groups.h>
#include <cstdio>
#include <cstdint>
namespace cg = cooperative_groups;
__device__ __forceinline__ int otid() { int t = threadIdx.x; asm volatile("" : "+v"(t)); return t; }
namespace pg8 {
#define PG8_LAS __attribute__((address_space(3)))
typedef unsigned short bf16_t;
typedef short bf16x8 __attribute__((ext_vector_type(8)));
typedef float f32x4 __attribute__((ext_vector_type(4)));
typedef unsigned u32x4 __attribute__((ext_vector_type(4)));
constexpr int BM = 256, BK = 64, HALF = 128, HTB = HALF * BK * 2  , STAGE_BYTES = 8 * HTB, NXCD = 8, WGM = 8;

__host__ __device__ __forceinline__ int lds_byte(int r, int c) { const int st = (r >> 4) * 2 + (c >> 5), rr = r & 15, cc = c & 31, ob = rr * 64 + cc * 2; return st * 1024 + (ob ^ (((ob >> 9) & 1) << 5)); }
__host__ __device__ __forceinline__ void stage_rc(int b, int& R, int& C) { const int st = b / 1024, sb = b % 1024, swz = sb ^ (((sb >> 9) & 1) << 5); R = (st >> 1) * 16 + swz / 64; C = (st & 1) * 32 + (swz % 64) / 2; }
__host__ __device__ __forceinline__ int perm32(int rho) { const int n = rho >> 4, i = rho & 15; return 8 * (i >> 2) + 4 * n + (i & 3); }

struct Unit { int pm, pn; };
struct Gemm { const bf16_t* A; const bf16_t* Bt; int M, N, K; };

struct StaticOrder {
    int nM, nN, nwg, G, c;
    __host__ __device__ void init(int M, int N, int G_, int c_) { nM = M / BM; nN = N / BM; nwg = nM * nN; G = G_; c = c_; }
    __host__ __device__ bool next(int i, Unit& u) const {
        const long L = (long)i * G + c; if (L >= nwg) return false;
        int wgid = (int)L; { const int q = nwg / NXCD, r = nwg % NXCD, xcd = wgid % NXCD, off = wgid / NXCD; wgid = (xcd < r ? xcd * (q + 1) : r * (q + 1) + (xcd - r) * q) + off; }
        const int nig = WGM * nN, gid = wgid / nig, fm = gid * WGM, gsz = (nM - fm) < WGM ? (nM - fm) : WGM;
        u.pm = fm + ((wgid % nig) % gsz); u.pn = (wgid % nig) / gsz; return true;
    }
    __device__ __forceinline__ void a_ready(const Unit&) const {}
    __device__ __forceinline__ void done(const Unit&) const {}
};
__device__ __forceinline__ unsigned cvt_pk_bf16(float lo, float hi) { unsigned r; asm volatile("v_cvt_pk_bf16_f32 %0, %1, %2" : "=v"(r) : "v"(lo), "v"(hi)); return r; }
template <class Epi, class Sched, bool STAMP = false>
__device__ __forceinline__ void gemm_phase(PG8_LAS unsigned char* lds, const Gemm g, const Sched& S, const Epi& E, unsigned long long* stamps) {
    const int tid = otid(), wid = __builtin_amdgcn_readfirstlane(tid >> 6), lane = tid & 63, wr = wid >> 2, wc = wid & 3, fr = lane & 15, fq = lane >> 4;
    const int K = g.K, nt = K / BK;
    unsigned voffA[2], voffB[2];
#pragma unroll
    for (int i = 0; i < 2; ++i) { int R, C; stage_rc(tid * 16 + i * 8192, R, C); const int Rb = Epi::PERM ? ((R & ~31) + perm32(R & 31)) : R;
        voffA[i] = (unsigned)(R * K + C) * 2u; voffB[i] = (unsigned)(Rb * K + C) * 2u; }
    const size_t kstep = (size_t)(BK * 2);
    const size_t hstep = (size_t)HALF * K * 2;
    const size_t tstep = 2 * hstep;
    const unsigned ldsw = (unsigned)wid * 1024u;
    const int aoff = lds_byte(wr * 64 + fr, fq * 8), boff = lds_byte(wc * 32 + fr, fq * 8);
#define PG8_SA(b, h) (((b) * 2 + (h)) * HTB)
#define PG8_SB(b, h) ((4 + (b) * 2 + (h)) * HTB)
#define PG8_STAGE(bufoff, gbase, voff) do { _Pragma("unroll") for (int _i = 0; _i < 2; ++_i) \
        __builtin_amdgcn_global_load_lds((const unsigned*)((const char*)(gbase) + (voff)[_i]), (PG8_LAS unsigned*)(lds + (bufoff) + ldsw + _i * 8192), 16, 0, 0); } while (0)
#define PG8_LDA(dst, b, h) do { _Pragma("unroll") for (int m = 0; m < 4; ++m) _Pragma("unroll") for (int k = 0; k < 2; ++k) dst[m][k] = *(const PG8_LAS bf16x8*)(lds + PG8_SA(b, h) + aoff + m * 2048 + k * 1024); } while (0)
#define PG8_LDB(dst, b, h) do { _Pragma("unroll") for (int n = 0; n < 2; ++n) _Pragma("unroll") for (int k = 0; k < 2; ++k) dst[n][k] = *(const PG8_LAS bf16x8*)(lds + PG8_SB(b, h) + boff + n * 2048 + k * 1024); } while (0)
#define PG8_MMA(ai, bj, At, Bt) do { __builtin_amdgcn_s_setprio(1); _Pragma("unroll") for (int m = 0; m < 4; ++m) _Pragma("unroll") for (int n = 0; n < 2; ++n) _Pragma("unroll") for (int k = 0; k < 2; ++k) \
        acc[ai][bj][m][n] = __builtin_amdgcn_mfma_f32_16x16x32_bf16(Bt[n][k], At[m][k], acc[ai][bj][m][n], 0, 0, 0); __builtin_amdgcn_s_setprio(0); } while (0)
#define PG8_WAIT_V(n) asm volatile("s_waitcnt vmcnt(" #n ")" ::: "memory")
#define PG8_WAIT_L(n) asm volatile("s_waitcnt lgkmcnt(" #n ")" ::: "memory")
#define PG8_BAR __builtin_amdgcn_s_barrier()
#define PG8_SCHED __builtin_amdgcn_sched_barrier(0)
    Unit cur, nxt; int ui = 0;
    if (!S.next(0, cur)) return;
    f32x4 acc[2][2][4][2];
#pragma unroll
    for (int a = 0; a < 2; ++a)
#pragma unroll
        for (int b = 0; b < 2; ++b)
#pragma unroll
            for (int m = 0; m < 4; ++m)
#pragma unroll
                for (int n = 0; n < 2; ++n) acc[a][b][m][n] = (f32x4){0.f, 0.f, 0.f, 0.f};
    bf16x8 At[4][2], B0[2][2], B1[2][2];
    const char* cA = (const char*)g.A + (size_t)cur.pm * tstep; const char* cB = (const char*)g.Bt + (size_t)cur.pn * tstep;
    S.a_ready(cur);
    PG8_STAGE(PG8_SB(0, 0), cB, voffB); PG8_STAGE(PG8_SA(0, 0), cA, voffA); PG8_STAGE(PG8_SB(0, 1), cB + hstep, voffB); PG8_STAGE(PG8_SA(0, 1), cA + hstep, voffA);
    if (wr == 1) PG8_BAR;
    PG8_WAIT_V(4); PG8_BAR;
    PG8_STAGE(PG8_SB(1, 0), cB + kstep, voffB); PG8_STAGE(PG8_SA(1, 0), cA + kstep, voffA); PG8_STAGE(PG8_SB(1, 1), cB + hstep + kstep, voffB);
    PG8_WAIT_V(6); PG8_BAR;
    for (;;) {
        const bool has_next = S.next(ui + 1, nxt);
        const char* nA = has_next ? (const char*)g.A + (size_t)nxt.pm * tstep : cA; const char* nB = has_next ? (const char*)g.Bt + (size_t)nxt.pn * tstep : cB;
        for (int t = 0; t < nt; t += 2) {
            const bool last = (t == nt - 2);
            const char* a1 = cA + (size_t)(t + 1) * kstep;
            const char* a2 = last ? nA : cA + (size_t)(t + 2) * kstep; const char* b2 = last ? nB : cB + (size_t)(t + 2) * kstep;
            const char* a3 = a2 + kstep; const char* b3 = b2 + kstep;
            if (last && has_next) S.a_ready(nxt);
            PG8_LDB(B0, 0, 0); PG8_SCHED; PG8_LDA(At, 0, 0); PG8_STAGE(PG8_SA(1, 1), a1 + hstep, voffA);
            PG8_WAIT_L(8); PG8_BAR; PG8_WAIT_L(0); PG8_MMA(0, 0, At, B0); PG8_BAR; PG8_SCHED;
            PG8_LDB(B1, 0, 1); PG8_STAGE(PG8_SB(0, 0), b2, voffB);
            PG8_BAR; PG8_WAIT_L(0); PG8_MMA(0, 1, At, B1); PG8_BAR;
            PG8_LDA(At, 0, 1); PG8_STAGE(PG8_SA(0, 0), a2, voffA);
            PG8_BAR; PG8_WAIT_L(0); PG8_MMA(1, 0, At, B0); PG8_BAR; PG8_SCHED;
            PG8_STAGE(PG8_SB(0, 1), b2 + hstep, voffB);
            PG8_WAIT_V(6); PG8_BAR; PG8_MMA(1, 1, At, B1); PG8_BAR;
            PG8_LDB(B0, 1, 0); PG8_SCHED; PG8_LDA(At, 1, 0); PG8_STAGE(PG8_SA(0, 1), a2 + hstep, voffA);
            PG8_WAIT_L(8); PG8_BAR; PG8_WAIT_L(0); PG8_MMA(0, 0, At, B0); PG8_BAR; PG8_SCHED;
            PG8_LDB(B1, 1, 1); PG8_STAGE(PG8_SB(1, 0), b3, voffB);
            PG8_BAR; PG8_WAIT_L(0); PG8_MMA(0, 1, At, B1); PG8_BAR;
            PG8_LDA(At, 1, 1); PG8_STAGE(PG8_SA(1, 0), a3, voffA);
            PG8_BAR; PG8_WAIT_L(0); PG8_MMA(1, 0, At, B0); PG8_BAR; PG8_SCHED;
            PG8_STAGE(PG8_SB(1, 1), b3 + hstep, voffB);
            PG8_WAIT_V(6); PG8_BAR; PG8_MMA(1, 1, At, B1); PG8_BAR;
        }
        if constexpr (!Epi::AFTER_DRAIN) { E(acc, cur, wr, wc, fr, fq); S.done(cur); }
        if (!has_next) break;
#pragma unroll
        for (int a = 0; a < 2; ++a)
#pragma unroll
            for (int b = 0; b < 2; ++b)
#pragma unroll
                for (int m = 0; m < 4; ++m)
#pragma unroll
                    for (int n = 0; n < 2; ++n) acc[a][b][m][n] = (f32x4){0.f, 0.f, 0.f, 0.f};
        cur = nxt; cA = nA; cB = nB; ++ui;
    }
    PG8_WAIT_V(0);
    if (wr == 0) PG8_BAR;
    PG8_BAR;
    if constexpr (Epi::AFTER_DRAIN) { E.fused(acc, cur, wr, wc, fr, fq, lds, wid, lane); S.done(cur); }
#undef PG8_SA
#undef PG8_SB
#undef PG8_STAGE
#undef PG8_LDA
#undef PG8_LDB
#undef PG8_MMA
#undef PG8_WAIT_V
#undef PG8_WAIT_L
#undef PG8_BAR
#undef PG8_SCHED
}
}
using pg8::bf16_t; using pg8::bf16x8; using pg8::f32x4; using pg8::u32x4;
#define LAS __attribute__((address_space(3)))
typedef float f32x2 __attribute__((ext_vector_type(2)));
typedef unsigned u32x2 __attribute__((ext_vector_type(2)));
typedef short s16x4 __attribute__((ext_vector_type(4)));

constexpr int M_ = 16384, D_ = 1024, T_ = 2048, NB_ = 8, PS_ = 3584, PW_ = 3456, FF_ = 2816, NGU_ = 5632;
constexpr int PAX = 0, PAY = 256, PBQ = 512, PBF = 896, PBV = 1280, PBG = 1664, PC = 2048;
constexpr int LDS_BYTES = 144 * 1024;
constexpr size_t SZ_WIN = (size_t)PS_ * D_ * 2, SZ_WOUT = (size_t)D_ * D_ * 2, SZ_WGU = (size_t)NGU_ * D_ * 2, SZ_WD = (size_t)D_ * FF_ * 2;
constexpr size_t WS_WIN = 0, WS_WOUT = WS_WIN + 2 * SZ_WIN, WS_WGU = WS_WOUT + 2 * SZ_WOUT, WS_WD = WS_WGU + 2 * SZ_WGU;
constexpr size_t WS_MOD = WS_WD + 2 * SZ_WD;
constexpr size_t WS_P = WS_MOD + 2 * 8 * 6144 * 4;
constexpr size_t WS_HY = WS_P + (size_t)M_ * PS_ * 2;
constexpr size_t WS_RGA = WS_HY + (size_t)M_ * D_ * 2;
constexpr size_t WS_HKV = WS_RGA + 3 * 8 * 32 * 256 * 4;
constexpr size_t WS_HDEC = WS_HKV + (size_t)1536 * 4096 * 2;
constexpr size_t WS_RM = WS_HDEC + (size_t)1536 * 64 * 4;
constexpr size_t WS_RN = WS_RM + (size_t)1536 * 4096 * 2;
constexpr size_t WS_RGAM = WS_RN + (size_t)1536 * 4096 * 2;
constexpr size_t WS_LORA = WS_RGAM + (size_t)1536 * 64 * 4;
constexpr size_t WS_RGW = WS_LORA + (size_t)2 * 98304 * 2;
constexpr size_t WS_RGL = WS_RGW + 65536 * 2;
constexpr size_t WS_RGB = WS_RGL + (size_t)M_ * 256 * 2;
constexpr size_t WS_BAR = WS_RGB + (size_t)M_ * 256 * 2;
constexpr size_t WS_END = WS_BAR + 16384;

struct Args { const float* in[32]; float* out; unsigned char* ws; int ph_lo, ph_hi; };

typedef __bf16 bf16n2 __attribute__((ext_vector_type(2)));
__device__ __forceinline__ unsigned pk2(float lo, float hi) { bf16n2 v; v.x = (__bf16)lo; v.y = (__bf16)hi; return __builtin_bit_cast(unsigned, v); }
__device__ __forceinline__ unsigned f2bf(float f) { return pk2(f, f) & 0xffffu; }
__device__ __forceinline__ float bf2f(unsigned short b) { return __builtin_bit_cast(float, ((unsigned)b) << 16); }
__device__ __forceinline__ float bflo(unsigned w) { return __builtin_bit_cast(float, w << 16); }
__device__ __forceinline__ float bfhi(unsigned w) { return __builtin_bit_cast(float, w & 0xffff0000u); }
__device__ __forceinline__ float wave_sum(float v) {
#pragma unroll
    for (int o = 1; o < 64; o <<= 1) v += __shfl_xor(v, o);
    return v;
}
__device__ __forceinline__ float rcp_(float x) { return __builtin_amdgcn_rcpf(x); }
__device__ __forceinline__ float rsq_(float x) { return __builtin_amdgcn_rsqf(x); }
__device__ __forceinline__ float sigmoidf_(float x) { return rcp_(1.0f + __expf(-x)); }
#define LDS_WAIT() asm volatile("s_waitcnt lgkmcnt(0)" ::: "memory")

struct EpiP {
    static constexpr bool PERM = true, AFTER_DRAIN = false;
    bf16_t* O; int ldc;
    __device__ __forceinline__ void operator()(const f32x4 (&acc)[2][2][4][2], const pg8::Unit& u, int wr, int wc, int fr, int fq) const {
        const int row0 = u.pm * 256 + wr * 64 + fr, col0 = u.pn * 256 + wc * 32 + 8 * fq;
#pragma unroll
        for (int ai = 0; ai < 2; ++ai)
#pragma unroll
            for (int m = 0; m < 4; ++m) { bf16_t* rowp = O + (size_t)(row0 + ai * 128 + m * 16) * ldc + col0;
#pragma unroll
                for (int bj = 0; bj < 2; ++bj) { const f32x4 v0 = acc[ai][bj][m][0], v1 = acc[ai][bj][m][1]; u32x4 w;
                    w.x = pg8::cvt_pk_bf16(v0[0], v0[1]); w.y = pg8::cvt_pk_bf16(v0[2], v0[3]); w.z = pg8::cvt_pk_bf16(v1[0], v1[1]); w.w = pg8::cvt_pk_bf16(v1[2], v1[3]);
                    *(u32x4*)(rowp + bj * 128) = w; } }
    }
};
struct EpiRes {
    static constexpr bool PERM = false, AFTER_DRAIN = false;
    const float* base; float* out; const float* gate;
    __device__ __forceinline__ void operator()(const f32x4 (&acc)[2][2][4][2], const pg8::Unit& u, int wr, int wc, int fr, int fq) const {
        const int row0 = u.pm * 256 + wr * 64 + fr, col0 = u.pn * 256 + wc * 32 + 4 * fq, b = u.pm >> 3;
        f32x4 gv[2][2];
#pragma unroll
        for (int bj = 0; bj < 2; ++bj)
#pragma unroll
            for (int n = 0; n < 2; ++n) gv[bj][n] = *(const f32x4*)(gate + (size_t)b * 6144 + col0 + bj * 128 + n * 16);
#pragma unroll
        for (int ai = 0; ai < 2; ++ai)
#pragma unroll
            for (int m = 0; m < 4; ++m) { const size_t ro = (size_t)(row0 + ai * 128 + m * 16) * 1024 + col0;
#pragma unroll
                for (int bj = 0; bj < 2; ++bj)
#pragma unroll
                    for (int n = 0; n < 2; ++n) { const f32x4 bv = *(const f32x4*)(base + ro + bj * 128 + n * 16);
                        *(f32x4*)(out + ro + bj * 128 + n * 16) = bv + gv[bj][n] * acc[ai][bj][m][n]; } }
    }
};
struct EpiSwi {
    static constexpr bool PERM = true, AFTER_DRAIN = false;
    bf16_t* O;
    __device__ __forceinline__ void operator()(const f32x4 (&acc)[2][2][4][2], const pg8::Unit& u, int wr, int wc, int fr, int fq) const {
        const int row0 = u.pm * 256 + wr * 64 + fr, col0 = u.pn * 128 + wc * 32 + 8 * fq;
#pragma unroll
        for (int ai = 0; ai < 2; ++ai)
#pragma unroll
            for (int m = 0; m < 4; ++m) { bf16_t* rowp = O + (size_t)(row0 + ai * 128 + m * 16) * FF_ + col0; float o[8];
#pragma unroll
                for (int n = 0; n < 2; ++n)
#pragma unroll
                    for (int i = 0; i < 4; ++i) { const float g = acc[ai][0][m][n][i], up = acc[ai][1][m][n][i]; o[4 * n + i] = g * sigmoidf_(g) * up; }
                u32x4 w; w.x = pg8::cvt_pk_bf16(o[0], o[1]); w.y = pg8::cvt_pk_bf16(o[2], o[3]); w.z = pg8::cvt_pk_bf16(o[4], o[5]); w.w = pg8::cvt_pk_bf16(o[6], o[7]);
                *(u32x4*)rowp = w; }
    }
};

__device__ __forceinline__ void transpose_item(const float* W, int K, int N, bf16_t* WT, int mode, LAS float* scr, int item, int lane) {
    const int nblk = N / 32, kb = item / nblk, nb = item % nblk, k0 = 64 * kb, n0 = 32 * nb;
#pragma unroll 8
    for (int i = 0; i < 32; ++i) { const int kk = 2 * i + (lane >> 5); scr[kk * 33 + (lane & 31)] = W[(size_t)(k0 + kk) * N + n0 + (lane & 31)]; }
    LDS_WAIT(); asm volatile("" ::: "memory");
    const int c = lane & 7;
#pragma unroll
    for (int j = 0; j < 4; ++j) { const int nl = (lane >> 3) + 8 * j, n = n0 + nl; const LAS float* s = scr + (8 * c) * 33 + nl;
        const int row = (mode == 0) ? n : (256 * (n >> 7) + (n & 127) + (mode == 2 ? 128 : 0));
        u32x4 o; o.x = pk2(s[0 * 33], s[1 * 33]); o.y = pk2(s[2 * 33], s[3 * 33]); o.z = pk2(s[4 * 33], s[5 * 33]); o.w = pk2(s[6 * 33], s[7 * 33]);
        *(u32x4*)(WT + (size_t)row * K + k0 + 8 * c) = o; }
    LDS_WAIT(); asm volatile("" ::: "memory");
}
__device__ __forceinline__ void phase_pro(const Args& a, LAS unsigned char* lds) {
    const int tid = otid(), wid = tid >> 6, lane = tid & 63;
    unsigned char* ws = a.ws;
    LAS float* CS = (LAS float*)lds;
    LAS float* RED = (LAS float*)(lds + 32768);
    if ((int)blockIdx.x < 192) {
        for (int i = tid; i < 8192; i += 512) { const float cv = a.in[1][i]; CS[i] = cv * sigmoidf_(cv); }
        __syncthreads();
    }
    for (int item = blockIdx.x; item < 192; item += gridDim.x) {
        const int l = item / 96, cgp = item % 96, col = cgp * 64 + lane;
        const float* aw = a.in[4] + (size_t)l * 1024 * 6144;
        float acc[8];
#pragma unroll
        for (int b = 0; b < 8; ++b) acc[b] = 0.f;
        for (int k = wid * 128; k < wid * 128 + 128; ++k) { const float w = aw[(size_t)k * 6144 + col];
#pragma unroll
            for (int b = 0; b < 8; ++b) acc[b] += CS[b * 1024 + k] * w; }
#pragma unroll
        for (int b = 0; b < 8; ++b) RED[(wid * 8 + b) * 64 + lane] = acc[b];
        __syncthreads();
        { const int b = wid; float s = 0.f;
#pragma unroll
          for (int w = 0; w < 8; ++w) s += RED[(w * 8 + b) * 64 + lane];
          ((float*)(ws + WS_MOD))[(size_t)(l * 8 + b) * 6144 + col] = s + a.in[5][l * 6144 + col]; }
        __syncthreads();
    }
    LAS float* scr = (LAS float*)(lds + 65536 + wid * 8448);
    const int gw = blockIdx.x * 8 + wid, NGW = gridDim.x * 8;
    constexpr int I_IN = 16 * (PW_ / 32), I_OUT = 16 * 32, I_G = 16 * (FF_ / 32), I_D = (FF_ / 64) * 32, I_L = I_IN + I_OUT + 2 * I_G + I_D;
    for (int it = gw; it < 2 * I_L; it += NGW) {
        const int l = it / I_L; int r = it % I_L;
        if (r < I_IN) { transpose_item(a.in[6] + (size_t)l * D_ * PW_, D_, PW_, (bf16_t*)(ws + WS_WIN + l * SZ_WIN), 0, scr, r, lane); continue; } r -= I_IN;
        if (r < I_OUT) { transpose_item(a.in[27] + (size_t)l * D_ * D_, D_, D_, (bf16_t*)(ws + WS_WOUT + l * SZ_WOUT), 0, scr, r, lane); continue; } r -= I_OUT;
        if (r < I_G) { transpose_item(a.in[28] + (size_t)l * D_ * FF_, D_, FF_, (bf16_t*)(ws + WS_WGU + l * SZ_WGU), 1, scr, r, lane); continue; } r -= I_G;
        if (r < I_G) { transpose_item(a.in[29] + (size_t)l * D_ * FF_, D_, FF_, (bf16_t*)(ws + WS_WGU + l * SZ_WGU), 2, scr, r, lane); continue; } r -= I_G;
        transpose_item(a.in[30] + (size_t)l * FF_ * D_, FF_, D_, (bf16_t*)(ws + WS_WD + l * SZ_WD), 0, scr, r, lane);
    }
    for (int e = blockIdx.x * 512 + tid; e < 2 * 98304; e += gridDim.x * 512) { const int l = e / 98304; int r = e % 98304; float v;
        if (r < 24576) { const int cidx = r >> 6, i = r & 63; v = a.in[17][((size_t)l * 64 + i) * 384 + cidx]; }
        else if (r < 49152) { const int r2 = r - 24576, cidx = r2 >> 6, i = r2 & 63; v = a.in[19][((size_t)l * 64 + i) * 384 + cidx]; }
        else { const int r2 = r - 49152, cidx = r2 >> 7, i = r2 & 127; v = a.in[20][((size_t)l * 128 + i) * 384 + cidx]; }
        ((bf16_t*)(ws + WS_LORA))[e] = (bf16_t)f2bf(v); }
    for (int e = blockIdx.x * 512 + tid; e < 65536; e += gridDim.x * 512) { const int i = e & 63, j = (e >> 6) & 63, gate = (e >> 12) & 1, lg = e >> 13;
        ((bf16_t*)(ws + WS_RGW))[e] = (bf16_t)f2bf(a.in[gate ? 11 : 9][((size_t)lg * 64 + i) * 64 + j]); }
    for (int i = blockIdx.x * 512 + tid; i < 2 * 16384; i += gridDim.x * 512) { const int l = i >> 14, e = i & 16383;
        *(u32x4*)(ws + WS_WIN + l * SZ_WIN + (size_t)PW_ * D_ * 2 + (size_t)e * 16) = (u32x4){0u, 0u, 0u, 0u}; }
}
__device__ __forceinline__ void phase_norm(const float* xin, const float* gain, const float* sh, const float* sc, bf16_t* H) {
    const int tid = otid(), wid = tid >> 6, lane = tid & 63, gw = blockIdx.x * 8 + wid, NGW = gridDim.x * 8;
    for (int row = gw; row < M_; row += NGW) { const int b = row >> 11;
        const f32x4* xr = (const f32x4*)(xin + (size_t)row * D_) + lane; f32x4 v[4]; float ss = 0.f;
#pragma unroll
        for (int j = 0; j < 4; ++j) { v[j] = xr[64 * j]; ss += (v[j].x * v[j].x + v[j].y * v[j].y) + (v[j].z * v[j].z + v[j].w * v[j].w); }
        const float rs = rsq_(wave_sum(ss) * (1.0f / D_) + 1e-6f);
#pragma unroll
        for (int j = 0; j < 4; ++j) { const int col = 4 * lane + 256 * j;
            const f32x4 g = *(const f32x4*)(gain + col), s1 = *(const f32x4*)(sc + (size_t)b * 6144 + col), s0 = *(const f32x4*)(sh + (size_t)b * 6144 + col);
            const f32x4 h = v[j] * rs * g * (s1 + 1.0f) + s0;
            u32x2 w; w.x = pk2(h.x, h.y); w.y = pk2(h.z, h.w); *(u32x2*)(H + (size_t)row * D_ + col) = w; }
    }
}
__device__ __forceinline__ void phase_final(float* x, const float* gain) {
    const int tid = otid(), wid = tid >> 6, lane = tid & 63, gw = blockIdx.x * 8 + wid, NGW = gridDim.x * 8;
    for (int row = gw; row < M_; row += NGW) {
        f32x4* xr = (f32x4*)(x + (size_t)row * D_) + lane; f32x4 v[4]; float ss = 0.f;
#pragma unroll
        for (int j = 0; j < 4; ++j) { v[j] = xr[64 * j]; ss += (v[j].x * v[j].x + v[j].y * v[j].y) + (v[j].z * v[j].z + v[j].w * v[j].w); }
        const float rs = rsq_(wave_sum(ss) * (1.0f / D_) + 1e-6f);
#pragma unroll
        for (int j = 0; j < 4; ++j) { const f32x4 g = *(const f32x4*)(gain + 4 * lane + 256 * j); xr[64 * j] = v[j] * rs * g; }
    }
}
#define XB_TMO      128
#define XB_XCNT(j)  (256  + 64 * (j))
#define XB_XSUB(j)  (1280 + 64 * (j))
#define XB_XGEN(j)  (2304 + 64 * (j))
#define XB_TOP      3328
#define XB_TOPGEN   3392
#define XCD_BAR_WORDS 3456
#define XB_SPIN_CAP (1u << 18)

__device__ __forceinline__ unsigned xb_ld(unsigned* p)              { return __hip_atomic_load(p, __ATOMIC_RELAXED, __HIP_MEMORY_SCOPE_AGENT); }
__device__ __forceinline__ unsigned xb_add(unsigned* p, unsigned v) { return __hip_atomic_fetch_add(p, v, __ATOMIC_RELAXED, __HIP_MEMORY_SCOPE_AGENT); }
__device__ __forceinline__ unsigned xb_xcc_id() { return (unsigned)__builtin_amdgcn_s_getreg((3 << 11) | 20) & 0xFu; }
#define XB_SPIN(cond, bar) do { unsigned _sp = 0; while (cond) { __builtin_amdgcn_s_sleep(1); \
    if ((++_sp & 255u) == 0u) { if (xb_ld(&(bar)[XB_TMO])) break; if (_sp > XB_SPIN_CAP) { atomicAdd(&(bar)[XB_TMO], 1u); break; } } } } while (0)

struct XcdBarrier {
    unsigned* bar; unsigned x;
    volatile LAS unsigned* st;
};

__device__ __forceinline__ XcdBarrier xcd_barrier_post(unsigned* bar, volatile LAS unsigned* st) {
    XcdBarrier b; b.bar = bar; b.x = xb_xcc_id(); b.st = st;
    if (threadIdx.x == 0) (void)xb_add(&bar[XB_XCNT(b.x)], 1u);
    return b;
}
__device__ __forceinline__ void xcd_barrier_complete(unsigned* bar, unsigned x, unsigned& nloc, unsigned& nx) {
    const unsigned G = gridDim.x * gridDim.y * gridDim.z;
    unsigned sum, cnt, mine, sp = 0u;
    for (;;) {
        sum = 0u; cnt = 0u; mine = 0u;
#pragma unroll
        for (unsigned j = 0; j < 16; ++j) { const unsigned c = xb_ld(&bar[XB_XCNT(j)]); sum += c; cnt += (c > 0u) ? 1u : 0u; mine = (j == x) ? c : mine; }
        if (sum == G) break;
        __builtin_amdgcn_s_sleep(1);
        if ((++sp & 255u) == 0u) { if (xb_ld(&bar[XB_TMO])) break; if (sp > XB_SPIN_CAP) { atomicAdd(&bar[XB_TMO], 1u); break; } }
    }
    nloc = mine > 0u ? mine : 1u; nx = cnt > 0u ? cnt : 1u;
}

__device__ __forceinline__ void xcd_barrier(const XcdBarrier& b) {
    asm volatile("s_waitcnt vmcnt(0)" ::: "memory");
    __syncthreads();
    if (threadIdx.x == 0) {
        unsigned* bar = b.bar;
        __builtin_amdgcn_s_waitcnt(0);
        unsigned nloc = b.st[0], nx = b.st[1];
        if (nloc == 0u) { xcd_barrier_complete(bar, b.x, nloc, nx); b.st[0] = nloc; b.st[1] = nx; }
        const unsigned old = xb_add(&bar[XB_XSUB(b.x)], 1u);
        const unsigned gen = old / nloc;
        if (old + 1u == (gen + 1u) * nloc) {
            __builtin_amdgcn_fence(__ATOMIC_RELEASE, "agent");
            asm volatile("s_waitcnt vmcnt(0)" ::: "memory");
            const unsigned og = xb_add(&bar[XB_TOP], 1u);
            const unsigned tg = og / nx;
            if (og + 1u == (tg + 1u) * nx) xb_add(&bar[XB_TOPGEN], 1u);
            else XB_SPIN(xb_ld(&bar[XB_TOPGEN]) == tg, bar);
            __builtin_amdgcn_fence(__ATOMIC_ACQUIRE, "agent");
            xb_add(&bar[XB_XGEN(b.x)], 1u);
            asm volatile("s_waitcnt vmcnt(0)" ::: "memory");
        } else {
            XB_SPIN(xb_ld(&bar[XB_XGEN(b.x)]) == gen, bar);
            __builtin_amdgcn_fence(__ATOMIC_ACQUIRE, "agent");
            asm volatile("s_waitcnt vmcnt(0)" ::: "memory");
        }
    }
    __syncthreads();
}

__device__ __forceinline__ float gelu_tanh(float x) { const float u = 0.7978845608f * (x + 0.044715f * x * x * x); const float e = __expf(2.0f * u); const float th = 1.0f - 2.0f * rcp_(e + 1.0f); return 0.5f * x * (1.0f + th); }
template <int MODE>
__device__ __forceinline__ void rg_item(const Args& a, int l, int item, int lane) {
    const int g = item & 3, c = (item >> 2) & 31, b = item >> 7, ch = 64 * g + lane, row0 = b * T_ + 64 * c;
    const bf16_t* P = (const bf16_t*)(a.ws + WS_P);
    float* AGG = (float*)(a.ws + WS_RGA);
    float Wr[64], Wi[64];
#pragma unroll
    for (int i = 0; i < 64; ++i) { Wr[i] = a.in[9][((size_t)(l * 4 + g) * 64 + i) * 64 + lane]; Wi[i] = a.in[11][((size_t)(l * 4 + g) * 64 + i) * 64 + lane]; }
    const float cw0 = a.in[7][(l * 4 + 0) * 256 + ch], cw1 = a.in[7][(l * 4 + 1) * 256 + ch], cw2 = a.in[7][(l * 4 + 2) * 256 + ch], cw3 = a.in[7][(l * 4 + 3) * 256 + ch];
    const float cb = a.in[8][l * 256 + ch], rb = a.in[10][l * 256 + ch], ib = a.in[12][l * 256 + ch], lam = a.in[13][l * 256 + ch];
    const float sp = log1pf(__expf(-lam));
    float xm3 = 0.f, xm2 = 0.f, xm1 = 0.f;
    if (c > 0) { xm3 = bf2f(P[(size_t)(row0 - 3) * PS_ + PAX + ch]); xm2 = bf2f(P[(size_t)(row0 - 2) * PS_ + PAX + ch]); xm1 = bf2f(P[(size_t)(row0 - 1) * PS_ + PAX + ch]); }
    float h = 0.f, Ap = 1.f, beta = 0.f;
    if (MODE == 1) { h = AGG[2 * 65536 + (b * 32 + c) * 256 + ch]; beta = a.in[26][l * 1024 + ch]; }
    bf16_t* Y = (bf16_t*)(a.ws + WS_HY);
    unsigned short xn[8], yn[8];
#pragma unroll
    for (int i = 0; i < 8; ++i) { xn[i] = P[(size_t)(row0 + i) * PS_ + PAX + ch]; yn[i] = (MODE == 1) ? P[(size_t)(row0 + i) * PS_ + PAY + ch] : (unsigned short)0; }
#pragma unroll 1
    for (int tg = 0; tg < 8; ++tg) {
        unsigned short xr[8], yr[8];
#pragma unroll
        for (int i = 0; i < 8; ++i) { xr[i] = xn[i]; yr[i] = yn[i]; }
        if (tg < 7) {
#pragma unroll
            for (int i = 0; i < 8; ++i) { xn[i] = P[(size_t)(row0 + 8 * tg + 8 + i) * PS_ + PAX + ch]; if (MODE == 1) yn[i] = P[(size_t)(row0 + 8 * tg + 8 + i) * PS_ + PAY + ch]; } }
#pragma unroll
        for (int i8 = 0; i8 < 8; ++i8) { const int t = 8 * tg + i8;
        const float xc = bf2f(xr[i8]);
        const float u = cb + cw0 * xm3 + cw1 * xm2 + cw2 * xm1 + cw3 * xc;
        xm3 = xm2; xm2 = xm1; xm1 = xc;
        float rp = rb, ip = ib;
#pragma unroll
        for (int i = 0; i < 64; ++i) { const float ui = __builtin_bit_cast(float, __builtin_amdgcn_readlane(__builtin_bit_cast(int, u), i)); rp += ui * Wr[i]; ip += ui * Wi[i]; }
        const float r = sigmoidf_(rp), ig = sigmoidf_(ip);
        const float log_a = -8.0f * r * sp, av = __expf(log_a);
        const float x2 = 2.0f * log_a; const float em = (x2 > -0.25f) ? -x2 * (1.0f + 0.5f * x2 * (1.0f + (1.0f / 3.0f) * x2 * (1.0f + 0.25f * x2 * (1.0f + 0.2f * x2)))) : 1.0f - __expf(x2);
        float mult = __builtin_amdgcn_sqrtf(em); if (c == 0 && t == 0) mult = 1.0f;
        const float bv = mult * ig * u;
        h = av * h + bv;
        if (MODE == 0) Ap *= av;
        else { const float ya = bf2f(yr[i8]); const float y = h * gelu_tanh(ya);
            const float ss = wave_sum(y * y); const float o = y * rsq_(ss * (1.0f / 64.0f) + 1e-6f) * beta;
            Y[(size_t)(row0 + t) * D_ + ch] = (bf16_t)f2bf(o); }
        }
    }
    if (MODE == 0) { AGG[(b * 32 + c) * 256 + ch] = Ap; AGG[65536 + (b * 32 + c) * 256 + ch] = h; }
}
__device__ __forceinline__ void rg_carry(const Args& a, int gid) {
    float* AGG = (float*)(a.ws + WS_RGA); const int b = gid >> 8, ch = gid & 255; float H = 0.f; float Av[32], Bv[32];
#pragma unroll
    for (int c = 0; c < 32; ++c) { const int i = (b * 32 + c) * 256 + ch; Av[c] = AGG[i]; Bv[c] = AGG[65536 + i]; }
#pragma unroll
    for (int c = 0; c < 32; ++c) { const int i = (b * 32 + c) * 256 + ch; AGG[2 * 65536 + i] = H; H = Av[c] * H + Bv[c]; }
}
__device__ __forceinline__ f32x4 mfma16(bf16x8 x, bf16x8 y, f32x4 c) { return __builtin_amdgcn_mfma_f32_16x16x32_bf16(x, y, c, 0, 0, 0); }
constexpr int LST = 72;
template <int MODE>
__device__ __forceinline__ void hgrn_item(const Args& a, int l, int item, LAS unsigned char* lds) {
    const int tid = otid(), wid = tid >> 6, lane = tid & 63, fr = lane & 15, fq = lane >> 4;
    const int c = item & 31, bh = item >> 5, h = bh % 6, b = bh / 6, row0 = b * T_ + 64 * c;
    const bf16_t* P = (const bf16_t*)(a.ws + WS_P);
    bf16_t* KVT = (bf16_t*)(a.ws + WS_HKV) + (size_t)item * 4096;
    LAS float* PART = (LAS float*)lds;
    LAS float* RHO = (LAS float*)(lds + 2048);
    LAS float* BC = (LAS float*)(lds + 4096);
    LAS bf16_t* L0 = (LAS bf16_t*)(lds + 20480);
    LAS bf16_t* L1 = (LAS bf16_t*)(lds + 29696);
    LAS bf16_t* L2 = (LAS bf16_t*)(lds + 38912);
    LAS bf16_t* VT = (LAS bf16_t*)(lds + 48128);
    LAS bf16_t* AM = (LAS bf16_t*)(lds + 57344);
    LAS float* SS = (LAS float*)(lds + 66560);
    const int k = lane, pt = wid;
    const float* hl = a.in[14];
    float lbv = 0.f; if (l == 1) lbv = rcp_(1.0f + __expf(hl[64 * h + k] - hl[384 + 64 * h + k]));
    float bc[8], kvv[8]; float s = 0.f;
#pragma unroll
    for (int i = 0; i < 8; ++i) { const float z = bf2f(P[(size_t)(row0 + 8 * pt + i) * PS_ + PBF + 64 * h + k]);
        const float sg = rcp_(1.0f + __expf(-z)); const float f = fmaxf(lbv + (1.0f - lbv) * sg, 1e-37f);
        s += __logf(f); bc[i] = s; kvv[i] = (1.0f - lbv) * rcp_(1.0f + __expf(z)); }
    PART[pt * 64 + k] = s;
    { unsigned short vv[8];
#pragma unroll
      for (int i = 0; i < 8; ++i) vv[i] = P[(size_t)(row0 + 8 * pt + i) * PS_ + PBV + 64 * h + k];
      u32x4 w; w.x = vv[0] | ((unsigned)vv[1] << 16); w.y = vv[2] | ((unsigned)vv[3] << 16); w.z = vv[4] | ((unsigned)vv[5] << 16); w.w = vv[6] | ((unsigned)vv[7] << 16);
      *(LAS u32x4*)(VT + k * LST + 8 * pt) = w; }
    __syncthreads();
    float off = 0.f, tot = 0.f, rho = 0.f;
#pragma unroll
    for (int p = 0; p < 8; ++p) { const float v = PART[p * 64 + k]; if (p < pt) off += v; if (p < 4) rho += v; tot += v; }
#pragma unroll
    for (int i = 0; i < 8; ++i) bc[i] += off;
    if (MODE == 0) {
        u32x4 w; float e[8];
#pragma unroll
        for (int i = 0; i < 8; ++i) e[i] = kvv[i] * __expf(tot - bc[i]);
        w.x = pk2(e[0], e[1]); w.y = pk2(e[2], e[3]); w.z = pk2(e[4], e[5]); w.w = pk2(e[6], e[7]);
        *(LAS u32x4*)(L0 + k * LST + 8 * pt) = w;
        if (pt == 0) ((float*)(a.ws + WS_HDEC))[(size_t)item * 64 + k] = __expf(tot);
        __syncthreads();
        const int kt = wid >> 1;
#pragma unroll
        for (int q = 0; q < 2; ++q) { const int vt = 2 * (wid & 1) + q; f32x4 acc = {0.f, 0.f, 0.f, 0.f};
#pragma unroll
            for (int ks = 0; ks < 2; ++ks) { const bf16x8 x = *(const LAS bf16x8*)(L0 + (16 * kt + fr) * LST + 32 * ks + 8 * fq), y = *(const LAS bf16x8*)(VT + (16 * vt + fr) * LST + 32 * ks + 8 * fq);
                acc = mfma16(x, y, acc); }
            u32x2 w2; w2.x = pk2(acc[0], acc[1]); w2.y = pk2(acc[2], acc[3]);
            *(u32x2*)(KVT + (16 * vt + fr) * 64 + 16 * kt + 4 * fq) = w2; }
        __syncthreads();
    } else {
#pragma unroll
        for (int i = 0; i < 8; ++i) BC[(8 * pt + i) * 64 + k] = bc[i];
        if (pt == 0) RHO[k] = rho;
        __syncthreads();
        { const int t2 = tid >> 3, kg = tid & 7;
          const u32x4 qw = *(const u32x4*)(P + (size_t)(row0 + t2) * PS_ + PBQ + 64 * h + 8 * kg), zw = *(const u32x4*)(P + (size_t)(row0 + t2) * PS_ + PBF + 64 * h + 8 * kg);
          float q[8], z[8], qp[8], qt[8], kt_[8];
          q[0] = bflo(qw.x); q[1] = bfhi(qw.x); q[2] = bflo(qw.y); q[3] = bfhi(qw.y); q[4] = bflo(qw.z); q[5] = bfhi(qw.z); q[6] = bflo(qw.w); q[7] = bfhi(qw.w);
          z[0] = bflo(zw.x); z[1] = bfhi(zw.x); z[2] = bflo(zw.y); z[3] = bfhi(zw.y); z[4] = bflo(zw.z); z[5] = bfhi(zw.z); z[6] = bflo(zw.w); z[7] = bfhi(zw.w);
#pragma unroll
          for (int i = 0; i < 8; ++i) { const int kk = 8 * kg + i; float lb2 = 0.f; if (l == 1) lb2 = rcp_(1.0f + __expf(hl[64 * h + kk] - hl[384 + 64 * h + kk]));
              const float kvl = (1.0f - lb2) * rcp_(1.0f + __expf(z[i])); const float bcv = BC[t2 * 64 + kk], rh = RHO[kk]; const float qs = q[i] * 0.125f;
              qp[i] = qs * __expf(bcv); qt[i] = qs * __expf(bcv - rh); kt_[i] = kvl * __expf(rh - bcv); }
          u32x4 w; w.x = pk2(qp[0], qp[1]); w.y = pk2(qp[2], qp[3]); w.z = pk2(qp[4], qp[5]); w.w = pk2(qp[6], qp[7]); *(LAS u32x4*)(L0 + t2 * LST + 8 * kg) = w;
          w.x = pk2(qt[0], qt[1]); w.y = pk2(qt[2], qt[3]); w.z = pk2(qt[4], qt[5]); w.w = pk2(qt[6], qt[7]); *(LAS u32x4*)(L1 + t2 * LST + 8 * kg) = w;
          w.x = pk2(kt_[0], kt_[1]); w.y = pk2(kt_[2], kt_[3]); w.z = pk2(kt_[4], kt_[5]); w.w = pk2(kt_[6], kt_[7]); *(LAS u32x4*)(L2 + t2 * LST + 8 * kg) = w; }
        __syncthreads();
        const int tt = wid >> 1;
#pragma unroll
        for (int q = 0; q < 2; ++q) { const int st = 2 * (wid & 1) + q; f32x4 acc = {0.f, 0.f, 0.f, 0.f};
            if (st <= tt) {
#pragma unroll
                for (int ks = 0; ks < 2; ++ks) { const bf16x8 x = *(const LAS bf16x8*)(L2 + (16 * st + fr) * LST + 32 * ks + 8 * fq), y = *(const LAS bf16x8*)(L1 + (16 * tt + fr) * LST + 32 * ks + 8 * fq);
                    acc = mfma16(x, y, acc); }
                const int t = 16 * tt + fr;
#pragma unroll
                for (int j = 0; j < 4; ++j) { const int sidx = 16 * st + 4 * fq + j; if (sidx > t) acc[j] = 0.f; }
            }
            u32x2 w2; w2.x = pk2(acc[0], acc[1]); w2.y = pk2(acc[2], acc[3]);
            *(LAS u32x2*)(AM + (16 * tt + fr) * LST + 16 * st + 4 * fq) = w2; }
        __syncthreads();
        f32x4 o[2]; float ss = 0.f;
#pragma unroll
        for (int q = 0; q < 2; ++q) { const int vt = 2 * (wid & 1) + q; f32x4 acc = {0.f, 0.f, 0.f, 0.f};
#pragma unroll
            for (int ks = 0; ks < 2; ++ks) { const bf16x8 x = *(const bf16x8*)(KVT + (16 * vt + fr) * 64 + 32 * ks + 8 * fq), y = *(const LAS bf16x8*)(L0 + (16 * tt + fr) * LST + 32 * ks + 8 * fq);
                acc = mfma16(x, y, acc); }
#pragma unroll
            for (int ks = 0; ks < 2; ++ks) { const bf16x8 x = *(const LAS bf16x8*)(VT + (16 * vt + fr) * LST + 32 * ks + 8 * fq), y = *(const LAS bf16x8*)(AM + (16 * tt + fr) * LST + 32 * ks + 8 * fq);
                acc = mfma16(x, y, acc); }
            o[q] = acc; ss += (acc[0] * acc[0] + acc[1] * acc[1]) + (acc[2] * acc[2] + acc[3] * acc[3]); }
        ss += __shfl_xor(ss, 16); ss += __shfl_xor(ss, 32);
        if (fq == 0) SS[wid * 16 + fr] = ss;
        __syncthreads();
        const float tot2 = SS[wid * 16 + fr] + SS[(wid ^ 1) * 16 + fr];
        const float rs = rsq_(tot2 * (1.0f / 64.0f) + 1e-6f);
        bf16_t* Y = (bf16_t*)(a.ws + WS_HY);
#pragma unroll
        for (int q = 0; q < 2; ++q) { const int vt = 2 * (wid & 1) + q, t = 16 * tt + fr, cv = 64 * h + 16 * vt + 4 * fq;
            const u32x2 gw2 = *(const u32x2*)(P + (size_t)(row0 + t) * PS_ + PBG + cv);
            const f32x4 be = *(const f32x4*)(a.in[26] + l * 1024 + 256 + cv);
            float gg[4] = {bflo(gw2.x), bfhi(gw2.x), bflo(gw2.y), bfhi(gw2.y)}; float r[4];
#pragma unroll
            for (int j = 0; j < 4; ++j) r[j] = o[q][j] * rs * (gg[j] * sigmoidf_(gg[j])) * be[j];
            u32x2 w2; w2.x = pk2(r[0], r[1]); w2.y = pk2(r[2], r[3]);
            *(u32x2*)(Y + (size_t)(row0 + t) * D_ + 256 + cv) = w2; }
        __syncthreads();
    }
}
__device__ __forceinline__ void hgrn_scan(const Args& a, int e) {
    bf16_t* KVT = (bf16_t*)(a.ws + WS_HKV); const float* DEC = (const float*)(a.ws + WS_HDEC);
    const int bh = e >> 12, vk = e & 4095, k = vk & 63; float S = 0.f; unsigned short kv[32]; float dc[32];
#pragma unroll
    for (int c = 0; c < 32; ++c) { kv[c] = KVT[((size_t)(bh * 32 + c) << 12) + vk]; dc[c] = DEC[(bh * 32 + c) * 64 + k]; }
#pragma unroll
    for (int c = 0; c < 32; ++c) { KVT[((size_t)(bh * 32 + c) << 12) + vk] = (bf16_t)f2bf(S); S = dc[c] * S + bf2f(kv[c]); }
}
__device__ __forceinline__ f32x4 mfma16k16(s16x4 x, s16x4 y, f32x4 c) { return __builtin_amdgcn_mfma_f32_16x16x16bf16_1k(x, y, c, 0, 0, 0); }
__device__ __forceinline__ s16x4 pack4(f32x4 v) { u32x2 w; w.x = pk2(v[0], v[1]); w.y = pk2(v[2], v[3]); return __builtin_bit_cast(s16x4, w); }
__device__ __forceinline__ void unpack8(const u32x4 w, float* o) { o[0] = bflo(w.x); o[1] = bfhi(w.x); o[2] = bflo(w.y); o[3] = bfhi(w.y); o[4] = bflo(w.z); o[5] = bfhi(w.z); o[6] = bflo(w.w); o[7] = bfhi(w.w); }
__device__ __forceinline__ u32x4 pack8(const float* e) { u32x4 w; w.x = pk2(e[0], e[1]); w.y = pk2(e[2], e[3]); w.z = pk2(e[4], e[5]); w.w = pk2(e[6], e[7]); return w; }
__device__ __forceinline__ void shift8(const bf16_t* P, size_t row, bool has_prev, int col, const float* mu, float* o) {
    const u32x4 cw = *(const u32x4*)(P + row * PS_ + PC + col); u32x4 pw = {0u, 0u, 0u, 0u}; if (has_prev) pw = *(const u32x4*)(P + (row - 1) * PS_ + PC + col);
    float c[8], p[8]; unpack8(cw, c); unpack8(pw, p); const f32x4 m0 = *(const f32x4*)(mu + col), m1 = *(const f32x4*)(mu + col + 4);
#pragma unroll
    for (int i = 0; i < 8; ++i) o[i] = c[i] + (p[i] - c[i]) * (i < 4 ? m0[i] : m1[i - 4]);
}
constexpr int RW_LIN = 0, RW_LINS = 264;
constexpr int RW_RH = 0, RW_YL = 18432, RW_YLS = 68;
constexpr int RW_CUM = 33792, RW_PART = 50176;
constexpr int RW_LO = 52224, RW_LOS = 68;
constexpr int RW_AT = 52224, RW_BD = 61440, RW_KD = 70656, RW_RT = 79872, RW_BTT = 89088, RW_KTT = 98304, RW_VT = 107520, RW_NAB = 116736, RW_AK = 125952;
constexpr int RW_ARB = RW_BTT, RW_ARK = RW_KTT;
constexpr int RW_NABF = 135168, RW_TII = 139264;
template <int MODE>
__device__ __forceinline__ void rwkv_chunk(const Args& a, int l, int item, LAS unsigned char* lds) {
    const int tid = otid(), wid = tid >> 6, lane = tid & 63, fr = lane & 15, fq = lane >> 4;
    const int c = item & 31, bh = item >> 5, h = bh % 6, b = bh / 6;
    const size_t row0 = (size_t)b * T_ + 64 * c;
    const bf16_t* P = (const bf16_t*)(a.ws + WS_P);
    const bf16_t* LW = (const bf16_t*)(a.ws + WS_LORA) + (size_t)l * 98304;
    const float* mu = a.in[15] + l * 1408;
    LAS bf16_t* LIN = (LAS bf16_t*)(lds + RW_LIN);
    LAS float* CUM = (LAS float*)(lds + RW_CUM); LAS float* PART = (LAS float*)(lds + RW_PART); LAS float* LO = (LAS float*)(lds + RW_LO);
    LAS bf16_t* AT = (LAS bf16_t*)(lds + RW_AT); LAS bf16_t* BD = (LAS bf16_t*)(lds + RW_BD); LAS bf16_t* KD = (LAS bf16_t*)(lds + RW_KD); LAS bf16_t* RT = (LAS bf16_t*)(lds + RW_RT);
    LAS bf16_t* BTT = (LAS bf16_t*)(lds + RW_BTT); LAS bf16_t* KTT = (LAS bf16_t*)(lds + RW_KTT); LAS bf16_t* VT = (LAS bf16_t*)(lds + RW_VT);
    LAS bf16_t* NAB = (LAS bf16_t*)(lds + RW_NAB); LAS bf16_t* AK = (LAS bf16_t*)(lds + RW_AK); LAS bf16_t* ARB = (LAS bf16_t*)(lds + RW_ARB); LAS bf16_t* ARK = (LAS bf16_t*)(lds + RW_ARK);
    LAS float* NABF = (LAS float*)(lds + RW_NABF); LAS bf16_t* TII = (LAS bf16_t*)(lds + RW_TII);
    const int t2 = tid >> 3, kg = tid & 7; const size_t row = row0 + t2; const bool has_prev = (c > 0) || (t2 > 0);
    {
#pragma unroll
        for (int q = 0; q < 4; ++q) { float ps[8]; const int col = 32 * kg + 8 * q; shift8(P, row, has_prev, 1152 + col, mu, ps);
#pragma unroll
            for (int i = 0; i < 8; ++i) { if (kg < 2) { const float e = __expf(2.0f * ps[i]); ps[i] = 1.0f - 2.0f * rcp_(e + 1.0f); } else if (kg >= 4) ps[i] = sigmoidf_(ps[i]); }
            *(LAS u32x4*)(LIN + t2 * RW_LINS + col) = pack8(ps); }
    }
    float rr[8], kx[8], vx[8];
    shift8(P, row, has_prev, 64 * h + 8 * kg, mu, rr); shift8(P, row, has_prev, 384 + 64 * h + 8 * kg, mu, kx); shift8(P, row, has_prev, 768 + 64 * h + 8 * kg, mu, vx);
    __syncthreads();
    { const int tt = wid >> 1;
#pragma unroll
      for (int q = 0; q < 2; ++q) { const int ct = 2 * (wid & 1) + q; const int crow = 64 * h + 16 * ct + fr;
          f32x4 aw = {0.f, 0.f, 0.f, 0.f}, aa = {0.f, 0.f, 0.f, 0.f}, ag = {0.f, 0.f, 0.f, 0.f};
#pragma unroll
          for (int ks = 0; ks < 2; ++ks) { const bf16x8 x = *(const LAS bf16x8*)(LIN + (16 * tt + fr) * RW_LINS + 32 * ks + 8 * fq), y = *(const bf16x8*)(LW + (size_t)crow * 64 + 32 * ks + 8 * fq); aw = mfma16(x, y, aw); }
#pragma unroll
          for (int ks = 0; ks < 2; ++ks) { const bf16x8 x = *(const LAS bf16x8*)(LIN + (16 * tt + fr) * RW_LINS + 64 + 32 * ks + 8 * fq), y = *(const bf16x8*)(LW + 24576 + (size_t)crow * 64 + 32 * ks + 8 * fq); aa = mfma16(x, y, aa); }
#pragma unroll
          for (int ks = 0; ks < 4; ++ks) { const bf16x8 x = *(const LAS bf16x8*)(LIN + (16 * tt + fr) * RW_LINS + 128 + 32 * ks + 8 * fq), y = *(const bf16x8*)(LW + 49152 + (size_t)crow * 128 + 32 * ks + 8 * fq); ag = mfma16(x, y, ag); }
#pragma unroll
          for (int j = 0; j < 4; ++j) { const int o = (16 * tt + 4 * fq + j) * RW_LOS + 16 * ct + fr; LO[o] = aw[j]; LO[64 * RW_LOS + o] = aa[j]; LO[2 * 64 * RW_LOS + o] = ag[j]; } }
    }
    __syncthreads();
    float gg[8], lw[8], be[8], al[8], kp[8]; float rkt = 0.f;
    { const int cb = l * 384 + 64 * h + 8 * kg; float wa[8], av[8];
      *(f32x4*)&wa[0] = *(const LAS f32x4*)(LO + t2 * RW_LOS + 8 * kg); *(f32x4*)&wa[4] = *(const LAS f32x4*)(LO + t2 * RW_LOS + 8 * kg + 4);
      *(f32x4*)&av[0] = *(const LAS f32x4*)(LO + 64 * RW_LOS + t2 * RW_LOS + 8 * kg); *(f32x4*)&av[4] = *(const LAS f32x4*)(LO + 64 * RW_LOS + t2 * RW_LOS + 8 * kg + 4);
      *(f32x4*)&gg[0] = *(const LAS f32x4*)(LO + 128 * RW_LOS + t2 * RW_LOS + 8 * kg); *(f32x4*)&gg[4] = *(const LAS f32x4*)(LO + 128 * RW_LOS + t2 * RW_LOS + 8 * kg + 4);
      float ssq = 0.f, kkr[8]; float p_w0[8], p_a0[8], p_kk[8], p_ka[8], p_rk[8];
      *(f32x4*)&p_w0[0] = *(const f32x4*)(a.in[16] + cb); *(f32x4*)&p_w0[4] = *(const f32x4*)(a.in[16] + cb + 4);
      *(f32x4*)&p_a0[0] = *(const f32x4*)(a.in[18] + cb); *(f32x4*)&p_a0[4] = *(const f32x4*)(a.in[18] + cb + 4);
      *(f32x4*)&p_kk[0] = *(const f32x4*)(a.in[21] + cb); *(f32x4*)&p_kk[4] = *(const f32x4*)(a.in[21] + cb + 4);
      *(f32x4*)&p_ka[0] = *(const f32x4*)(a.in[22] + cb); *(f32x4*)&p_ka[4] = *(const f32x4*)(a.in[22] + cb + 4);
      *(f32x4*)&p_rk[0] = *(const f32x4*)(a.in[23] + cb); *(f32x4*)&p_rk[4] = *(const f32x4*)(a.in[23] + cb + 4);
#pragma unroll
      for (int i = 0; i < 8; ++i) { const float wp = wa[i] + p_w0[i]; const float w = -__logf(1.0f + __expf(-wp)) - 0.5f; lw[i] = -__expf(w);
          const float aa = sigmoidf_(av[i] + p_a0[i]);
          kkr[i] = kx[i] * p_kk[i]; ssq += kkr[i] * kkr[i];
          kp[i] = kx[i] * (1.0f + (aa - 1.0f) * p_ka[i]); be[i] = aa;
          rkt += rr[i] * kp[i] * p_rk[i]; }
      ssq += __shfl_xor(ssq, 1); ssq += __shfl_xor(ssq, 2); ssq += __shfl_xor(ssq, 4);
      rkt += __shfl_xor(rkt, 1); rkt += __shfl_xor(rkt, 2); rkt += __shfl_xor(rkt, 4);
      const float rn = rsq_(ssq + 1e-12f);
#pragma unroll
      for (int i = 0; i < 8; ++i) { const float kk = kkr[i] * rn; al[i] = -kk; be[i] = kk * be[i]; }
#pragma unroll
      for (int i = 0; i < 8; ++i) CUM[t2 * 64 + 8 * kg + i] = lw[i];
    }
    __syncthreads();
    { const int k = lane, pt = wid; float s = 0.f; float cv[8];
#pragma unroll
      for (int i = 0; i < 8; ++i) { s += CUM[(8 * pt + i) * 64 + k]; cv[i] = s; }
      PART[pt * 64 + k] = s;
      __syncthreads();
      float off = 0.f;
#pragma unroll
      for (int p = 0; p < 8; ++p) { const float v = PART[p * 64 + k]; if (p < pt) off += v; }
#pragma unroll
      for (int i = 0; i < 8; ++i) CUM[(8 * pt + i) * 64 + k] = cv[i] + off;
    }
    __syncthreads();
    { float cu[8], cl[8], e[8];
      *(f32x4*)&cu[0] = *(const LAS f32x4*)(CUM + t2 * 64 + 8 * kg); *(f32x4*)&cu[4] = *(const LAS f32x4*)(CUM + t2 * 64 + 8 * kg + 4);
      *(f32x4*)&cl[0] = *(const LAS f32x4*)(CUM + 63 * 64 + 8 * kg); *(f32x4*)&cl[4] = *(const LAS f32x4*)(CUM + 63 * 64 + 8 * kg + 4);
#pragma unroll
      for (int i = 0; i < 8; ++i) e[i] = al[i] * __expf(cu[i] - lw[i]);
      *(LAS u32x4*)(AT + t2 * LST + 8 * kg) = pack8(e);
      float en[8];
#pragma unroll
      for (int i = 0; i < 8; ++i) en[i] = __expf(-cu[i]);
#pragma unroll
      for (int i = 0; i < 8; ++i) e[i] = be[i] * en[i];
      *(LAS u32x4*)(BD + t2 * LST + 8 * kg) = pack8(e);
#pragma unroll
      for (int i = 0; i < 8; ++i) e[i] = kp[i] * en[i];
      *(LAS u32x4*)(KD + t2 * LST + 8 * kg) = pack8(e);
      if (MODE == 1) {
#pragma unroll
          for (int i = 0; i < 8; ++i) e[i] = rr[i] * __expf(cu[i]);
          *(LAS u32x4*)(RT + t2 * LST + 8 * kg) = pack8(e);
      } else {
#pragma unroll
          for (int i = 0; i < 8; ++i) { const float ed = __expf(cl[i] - cu[i]); BTT[(8 * kg + i) * LST + t2] = (bf16_t)f2bf(be[i] * ed); KTT[(8 * kg + i) * LST + t2] = (bf16_t)f2bf(kp[i] * ed); }
          if (t2 == 63) {
#pragma unroll
              for (int i = 0; i < 8; ++i) ((float*)(a.ws + WS_RGAM))[(size_t)item * 64 + 8 * kg + i] = __expf(cl[i]); }
      }
#pragma unroll
      for (int i = 0; i < 8; ++i) VT[(8 * kg + i) * LST + t2] = (bf16_t)f2bf(vx[i]);
    }
    __syncthreads();
    { const int tt = wid >> 1;
#pragma unroll
      for (int q = 0; q < 2; ++q) { const int st = 2 * (wid & 1) + q;
          f32x4 ab = {0.f, 0.f, 0.f, 0.f}, ak = {0.f, 0.f, 0.f, 0.f}, rb = {0.f, 0.f, 0.f, 0.f}, rk = {0.f, 0.f, 0.f, 0.f};
          if (st <= tt) {
#pragma unroll
              for (int ks = 0; ks < 2; ++ks) { const int ao = (16 * st + fr) * LST + 32 * ks + 8 * fq, bo = (16 * tt + fr) * LST + 32 * ks + 8 * fq;
                  const bf16x8 xb = *(const LAS bf16x8*)(BD + ao), xk = *(const LAS bf16x8*)(KD + ao), ya = *(const LAS bf16x8*)(AT + bo);
                  ab = mfma16(xb, ya, ab); ak = mfma16(xk, ya, ak);
                  if (MODE == 1) { const bf16x8 yr = *(const LAS bf16x8*)(RT + bo); rb = mfma16(xb, yr, rb); rk = mfma16(xk, yr, rk); } }
              const int t = 16 * tt + fr;
#pragma unroll
              for (int j = 0; j < 4; ++j) { const int s = 16 * st + 4 * fq + j; if (s >= t) { ab[j] = 0.f; ak[j] = 0.f; } if (s > t) { rb[j] = 0.f; rk[j] = 0.f; } }
              if (st == tt) *(LAS f32x4*)(NABF + tt * 256 + fr * 16 + 4 * fq) = ab;
          }
          const int o = (16 * tt + fr) * LST + 16 * st + 4 * fq;
          *(LAS s16x4*)(NAB + o) = pack4(ab); *(LAS s16x4*)(AK + o) = pack4(ak);
          if (MODE == 1) { *(LAS s16x4*)(ARB + o) = pack4(rb); *(LAS s16x4*)(ARK + o) = pack4(rk); } }
    }
    __syncthreads();
    f32x4 R[4];
    if (wid == 0) { const int blk = fq, j = fr; float Tc[16];
#pragma unroll
        for (int i = 0; i < 16; ++i) { float acc = (i == j) ? 1.0f : 0.0f;
#pragma unroll
            for (int m = 0; m < 16; ++m) if (m < i) acc += NABF[blk * 256 + i * 16 + m] * Tc[m];
            Tc[i] = acc; TII[blk * 256 + i * 16 + j] = (bf16_t)f2bf(acc); }
    }
    if (wid >= 4) { const int vt = wid - 4;
#pragma unroll
        for (int I = 0; I < 4; ++I) { f32x4 acc = {0.f, 0.f, 0.f, 0.f};
#pragma unroll
            for (int ks = 0; ks < 2; ++ks) { const bf16x8 x = *(const LAS bf16x8*)(AK + (16 * I + fr) * LST + 32 * ks + 8 * fq), y = *(const LAS bf16x8*)(VT + (16 * vt + fr) * LST + 32 * ks + 8 * fq); acc = mfma16(x, y, acc); }
            R[I] = acc; }
    } else {
#pragma unroll
        for (int I = 0; I < 4; ++I)
#pragma unroll
            for (int j = 0; j < 4; ++j) R[I][j] = bf2f(AT[(16 * I + 4 * fq + j) * LST + 16 * wid + fr]);
    }
    __syncthreads();
    s16x4 Xb[4];
#pragma unroll
    for (int I = 0; I < 4; ++I) { f32x4 acc = R[I];
#pragma unroll
        for (int J = 0; J < 4; ++J) if (J < I) acc = mfma16k16(*(const LAS s16x4*)(NAB + (16 * I + fr) * LST + 16 * J + 4 * fq), Xb[J], acc);
        const f32x4 z = {0.f, 0.f, 0.f, 0.f};
        const f32x4 x = mfma16k16(*(const LAS s16x4*)(TII + I * 256 + fr * 16 + 4 * fq), pack4(acc), z);
        Xb[I] = pack4(x); }
    s16x4 Vf[4];
    if (wid >= 4) {
#pragma unroll
        for (int J = 0; J < 4; ++J) Vf[J] = *(const LAS s16x4*)(VT + (16 * (wid - 4) + fr) * LST + 16 * J + 4 * fq); }
    if (MODE == 0) {
#pragma unroll
        for (int kt = 0; kt < 4; ++kt) { f32x4 acc = {0.f, 0.f, 0.f, 0.f};
#pragma unroll
            for (int J = 0; J < 4; ++J) acc = mfma16k16(*(const LAS s16x4*)(BTT + (16 * kt + fr) * LST + 16 * J + 4 * fq), Xb[J], acc);
            if (wid >= 4) {
#pragma unroll
                for (int J = 0; J < 4; ++J) acc = mfma16k16(*(const LAS s16x4*)(KTT + (16 * kt + fr) * LST + 16 * J + 4 * fq), Vf[J], acc);
                *(s16x4*)((bf16_t*)(a.ws + WS_RN) + (size_t)item * 4096 + ((kt * 4 + (wid - 4)) * 64 + lane) * 4) = pack4(acc);
            } else { bf16_t* RM = (bf16_t*)(a.ws + WS_RM) + (size_t)item * 4096;
#pragma unroll
                for (int j = 0; j < 4; ++j) RM[(16 * kt + 4 * fq + j) * 64 + 16 * wid + fr] = (bf16_t)f2bf(acc[j]); } }
        __syncthreads();
    } else {
        LAS bf16_t* RH = (LAS bf16_t*)(lds + RW_RH); LAS float* YL = (LAS float*)(lds + RW_YL);
        f32x4 yh[4];
#pragma unroll
        for (int tt = 0; tt < 4; ++tt) { f32x4 acc = {0.f, 0.f, 0.f, 0.f};
            if (wid < 4) {
#pragma unroll
                for (int j = 0; j < 4; ++j) acc[j] = bf2f(RT[(16 * tt + 4 * fq + j) * LST + 16 * wid + fr]); }
#pragma unroll
            for (int J = 0; J < 4; ++J) if (J <= tt) acc = mfma16k16(*(const LAS s16x4*)(ARB + (16 * tt + fr) * LST + 16 * J + 4 * fq), Xb[J], acc);
            if (wid >= 4) {
#pragma unroll
                for (int J = 0; J < 4; ++J) if (J <= tt) acc = mfma16k16(*(const LAS s16x4*)(ARK + (16 * tt + fr) * LST + 16 * J + 4 * fq), Vf[J], acc);
                yh[tt] = acc;
            } else {
#pragma unroll
                for (int j = 0; j < 4; ++j) RH[(16 * tt + 4 * fq + j) * LST + 16 * wid + fr] = (bf16_t)f2bf(acc[j]); } }
        __syncthreads();
        if (wid >= 4) { const int vt = wid - 4; s16x4 S0[4];
#pragma unroll
            for (int kt = 0; kt < 4; ++kt) S0[kt] = *(const s16x4*)((const bf16_t*)(a.ws + WS_RN) + (size_t)item * 4096 + ((kt * 4 + vt) * 64 + lane) * 4);
#pragma unroll
            for (int tt = 0; tt < 4; ++tt) { f32x4 acc = yh[tt];
#pragma unroll
                for (int kt = 0; kt < 4; ++kt) acc = mfma16k16(*(const LAS s16x4*)(RH + (16 * tt + fr) * LST + 16 * kt + 4 * fq), S0[kt], acc);
#pragma unroll
                for (int j = 0; j < 4; ++j) YL[(16 * tt + 4 * fq + j) * RW_YLS + 16 * vt + fr] = acc[j]; } }
        __syncthreads();
        { const int cb = l * 384 + 64 * h + 8 * kg; float y[8];
          *(f32x4*)&y[0] = *(const LAS f32x4*)(YL + t2 * RW_YLS + 8 * kg); *(f32x4*)&y[4] = *(const LAS f32x4*)(YL + t2 * RW_YLS + 8 * kg + 4);
          float sm = 0.f;
#pragma unroll
          for (int i = 0; i < 8; ++i) sm += y[i];
          sm += __shfl_xor(sm, 1); sm += __shfl_xor(sm, 2); sm += __shfl_xor(sm, 4);
          const float mean = sm * (1.0f / 64.0f); float vr = 0.f;
#pragma unroll
          for (int i = 0; i < 8; ++i) { y[i] -= mean; vr += y[i] * y[i]; }
          vr += __shfl_xor(vr, 1); vr += __shfl_xor(vr, 2); vr += __shfl_xor(vr, 4);
          const float rs = rsq_(vr * (1.0f / 64.0f) + 64e-5f); float o[8]; float p_lw[8], p_lb[8], p_be[8];
          *(f32x4*)&p_lw[0] = *(const f32x4*)(a.in[24] + cb); *(f32x4*)&p_lw[4] = *(const f32x4*)(a.in[24] + cb + 4);
          *(f32x4*)&p_lb[0] = *(const f32x4*)(a.in[25] + cb); *(f32x4*)&p_lb[4] = *(const f32x4*)(a.in[25] + cb + 4);
          *(f32x4*)&p_be[0] = *(const f32x4*)(a.in[26] + l * 1024 + 640 + 64 * h + 8 * kg); *(f32x4*)&p_be[4] = *(const f32x4*)(a.in[26] + l * 1024 + 640 + 64 * h + 8 * kg + 4);
#pragma unroll
          for (int i = 0; i < 8; ++i) o[i] = ((y[i] * rs * p_lw[i] + p_lb[i]) + rkt * vx[i]) * gg[i] * p_be[i];
          *(u32x4*)((bf16_t*)(a.ws + WS_HY) + row * D_ + 640 + 64 * h + 8 * kg) = pack8(o); }
        __syncthreads();
    }
}
__device__ __forceinline__ void rwkv_scan(const Args& a, int bh, int vt, int lane) {
    const int fr = lane & 15, fq = lane >> 4;
    const bf16_t* RM = (const bf16_t*)(a.ws + WS_RM); bf16_t* RN = (bf16_t*)(a.ws + WS_RN); const float* GAM = (const float*)(a.ws + WS_RGAM);
    f32x4 S[4];
#pragma unroll
    for (int k = 0; k < 4; ++k) S[k] = (f32x4){0.f, 0.f, 0.f, 0.f};
    s16x4 Mn[4][4]; s16x4 Nn[4]; f32x4 gn[4];
#define RWS_LOAD(cc) { const size_t it_ = (size_t)bh * 32 + (cc); _Pragma("unroll") for (int kt = 0; kt < 4; ++kt) { _Pragma("unroll") for (int k2 = 0; k2 < 4; ++k2) Mn[kt][k2] = *(const s16x4*)(RM + it_ * 4096 + (16 * kt + fr) * 64 + 16 * k2 + 4 * fq); \
            Nn[kt] = *(const s16x4*)(RN + it_ * 4096 + ((kt * 4 + vt) * 64 + lane) * 4); gn[kt] = *(const f32x4*)(GAM + it_ * 64 + 16 * kt + 4 * fq); } }
    RWS_LOAD(0)
#pragma unroll 1
    for (int c = 0; c < 32; ++c) { const size_t item = (size_t)bh * 32 + c;
        s16x4 Mf[4][4]; s16x4 Nf[4]; f32x4 gam[4];
#pragma unroll
        for (int kt = 0; kt < 4; ++kt) { Nf[kt] = Nn[kt]; gam[kt] = gn[kt];
#pragma unroll
            for (int k2 = 0; k2 < 4; ++k2) Mf[kt][k2] = Mn[kt][k2]; }
        if (c < 31) RWS_LOAD(c + 1)
        s16x4 Sb[4];
#pragma unroll
        for (int k = 0; k < 4; ++k) { Sb[k] = pack4(S[k]); *(s16x4*)(RN + item * 4096 + ((k * 4 + vt) * 64 + lane) * 4) = Sb[k]; }
#pragma unroll
        for (int kt = 0; kt < 4; ++kt) { const u32x2 nw = __builtin_bit_cast(u32x2, Nf[kt]);
            f32x4 acc = gam[kt] * S[kt] + (f32x4){bflo(nw.x), bfhi(nw.x), bflo(nw.y), bfhi(nw.y)};
#pragma unroll
            for (int k2 = 0; k2 < 4; ++k2) acc = mfma16k16(Mf[kt][k2], Sb[k2], acc);
            S[kt] = acc; }
    }
#undef RWS_LOAD
}
constexpr int RG_US = 264;
constexpr int RG_U = 0, RG_LA = 33792, RG_LB = 67584, RG_AG = 101376;
constexpr int RG_YS = 260, RG_YB = 0, RG_AG1 = 66560;
__device__ __forceinline__ float rg_em(float x2) { return (x2 > -0.25f) ? -x2 * (1.0f + 0.5f * x2 * (1.0f + (1.0f / 3.0f) * x2 * (1.0f + 0.25f * x2 * (1.0f + 0.2f * x2)))) : 1.0f - __expf(x2); }
__device__ __forceinline__ void rg2_mode0(const Args& a, int l, int item, LAS unsigned char* lds) {
    const int tid = otid(), wid = tid >> 6, lane = tid & 63, fr = lane & 15, fq = lane >> 4;
    const int c = item & 31, b = item >> 5; const size_t row0 = (size_t)b * T_ + 64 * c;
    const bf16_t* P = (const bf16_t*)(a.ws + WS_P);
    LAS bf16_t* U = (LAS bf16_t*)(lds + RG_U); LAS bf16_t* LA = (LAS bf16_t*)(lds + RG_LA); LAS bf16_t* LB = (LAS bf16_t*)(lds + RG_LB); LAS float* AG = (LAS float*)(lds + RG_AG);
    const int ch = tid & 255, hf = tid >> 8, t0 = 32 * hf;
    { const float cw0 = a.in[7][(l * 4 + 0) * 256 + ch], cw1 = a.in[7][(l * 4 + 1) * 256 + ch], cw2 = a.in[7][(l * 4 + 2) * 256 + ch], cw3 = a.in[7][(l * 4 + 3) * 256 + ch], cb = a.in[8][l * 256 + ch];
      float xm3 = 0.f, xm2 = 0.f, xm1 = 0.f;
      if (c > 0 || hf > 0) { xm3 = bf2f(P[(row0 + t0 - 3) * PS_ + PAX + ch]); xm2 = bf2f(P[(row0 + t0 - 2) * PS_ + PAX + ch]); xm1 = bf2f(P[(row0 + t0 - 1) * PS_ + PAX + ch]); }
      unsigned short xr[32];
#pragma unroll
      for (int i = 0; i < 32; ++i) xr[i] = P[(row0 + t0 + i) * PS_ + PAX + ch];
#pragma unroll
      for (int i = 0; i < 32; ++i) { const float xc = bf2f(xr[i]); const float u = cb + cw0 * xm3 + cw1 * xm2 + cw2 * xm1 + cw3 * xc; xm3 = xm2; xm2 = xm1; xm1 = xc;
          U[(t0 + i) * RG_US + ch] = (bf16_t)f2bf(u); } }
    __syncthreads();
    { const int g = wid >> 1; const bf16_t* WT = (const bf16_t*)(a.ws + WS_RGW) + (size_t)(l * 4 + g) * 2 * 4096;
#pragma unroll
      for (int q = 0; q < 2; ++q) { const int tt = 2 * (wid & 1) + q;
          bf16x8 ua[2];
#pragma unroll
          for (int ks = 0; ks < 2; ++ks) ua[ks] = *(const LAS bf16x8*)(U + (16 * tt + fr) * RG_US + 64 * g + 32 * ks + 8 * fq);
#pragma unroll
          for (int jt = 0; jt < 4; ++jt) { f32x4 ar = {0.f, 0.f, 0.f, 0.f}, ai = {0.f, 0.f, 0.f, 0.f};
#pragma unroll
              for (int ks = 0; ks < 2; ++ks) { const bf16x8 wr = *(const bf16x8*)(WT + (16 * jt + fr) * 64 + 32 * ks + 8 * fq), wi = *(const bf16x8*)(WT + 4096 + (16 * jt + fr) * 64 + 32 * ks + 8 * fq);
                  ar = mfma16(ua[ks], wr, ar); ai = mfma16(ua[ks], wi, ai); }
              const int chj = 64 * g + 16 * jt + fr;
              const float rb = a.in[10][l * 256 + chj], ib = a.in[12][l * 256 + chj], sp8 = -8.0f * __logf(1.0f + __expf(-a.in[13][l * 256 + chj]));
#pragma unroll
              for (int j = 0; j < 4; ++j) { const int t = 16 * tt + 4 * fq + j;
                  const float r = sigmoidf_(ar[j] + rb), ig = sigmoidf_(ai[j] + ib);
                  const float log_a = bf2f((unsigned short)f2bf(r * sp8));
                  float mult = __builtin_amdgcn_sqrtf(rg_em(2.0f * log_a)); if (c == 0 && t == 0) mult = 1.0f;
                  const float u = bf2f(U[t * RG_US + chj]);
                  LA[t * RG_US + chj] = (bf16_t)f2bf(log_a); LB[t * RG_US + chj] = (bf16_t)f2bf(mult * ig * u); } } }
    }
    __syncthreads();
    { bf16_t* GLA = (bf16_t*)(a.ws + WS_RGL); bf16_t* GLB = (bf16_t*)(a.ws + WS_RGB);
      float h = 0.f, sl = 0.f;
#pragma unroll 8
      for (int i = 0; i < 32; ++i) { const unsigned short la = LA[(t0 + i) * RG_US + ch], lb = LB[(t0 + i) * RG_US + ch];
          GLA[(row0 + t0 + i) * 256 + ch] = la; GLB[(row0 + t0 + i) * 256 + ch] = lb;
          const float lg = bf2f(la); sl += lg; h = __expf(lg) * h + bf2f(lb); }
      AG[(hf * 256 + ch) * 2] = sl; AG[(hf * 256 + ch) * 2 + 1] = h;
      __syncthreads();
      if (hf == 0) { const float s1 = AG[(256 + ch) * 2], h1 = AG[(256 + ch) * 2 + 1]; float* AGG = (float*)(a.ws + WS_RGA);
          AGG[(b * 32 + c) * 256 + ch] = __expf(sl + s1); AGG[65536 + (b * 32 + c) * 256 + ch] = __expf(s1) * h + h1; } }
    __syncthreads();
}
__device__ __forceinline__ void rg2_mode1(const Args& a, int l, int item, LAS unsigned char* lds) {
    const int tid = otid();
    const int c = item & 31, b = item >> 5; const size_t row0 = (size_t)b * T_ + 64 * c;
    const bf16_t* P = (const bf16_t*)(a.ws + WS_P); const bf16_t* GLA = (const bf16_t*)(a.ws + WS_RGL); const bf16_t* GLB = (const bf16_t*)(a.ws + WS_RGB);
    LAS float* YB = (LAS float*)(lds + RG_YB); LAS float* AG = (LAS float*)(lds + RG_AG1);
    const int ch = tid & 255, hf = tid >> 8, t0 = 32 * hf;
    unsigned short la[32], lb[32], ya[32];
#pragma unroll
    for (int i = 0; i < 32; ++i) { la[i] = GLA[(row0 + t0 + i) * 256 + ch]; lb[i] = GLB[(row0 + t0 + i) * 256 + ch]; ya[i] = P[(row0 + t0 + i) * PS_ + PAY + ch]; }
    const float carry = ((const float*)(a.ws + WS_RGA))[2 * 65536 + (b * 32 + c) * 256 + ch];
    float av[32];
    { float h = 0.f, sl = 0.f;
#pragma unroll
      for (int i = 0; i < 32; ++i) { const float lg = bf2f(la[i]); sl += lg; av[i] = __expf(lg); h = av[i] * h + bf2f(lb[i]); }
      if (hf == 0) { AG[ch * 2] = sl; AG[ch * 2 + 1] = h; } }
    __syncthreads();
    { float h = carry; if (hf == 1) h = __expf(AG[ch * 2]) * carry + AG[ch * 2 + 1];
#pragma unroll
      for (int i = 0; i < 32; ++i) { h = av[i] * h + bf2f(lb[i]); YB[(t0 + i) * RG_YS + ch] = h * gelu_tanh(bf2f(ya[i])); } }
    __syncthreads();
    { const int t = tid >> 3, gs = tid & 7, cbase = 32 * gs; float y[32]; float ss = 0.f;
#pragma unroll
      for (int q = 0; q < 8; ++q) { *(f32x4*)&y[4 * q] = *(const LAS f32x4*)(YB + t * RG_YS + cbase + 4 * q); }
#pragma unroll
      for (int i = 0; i < 32; ++i) ss += y[i] * y[i];
      ss += __shfl_xor(ss, 1);
      const float rs = rsq_(ss * (1.0f / 64.0f) + 1e-6f);
      bf16_t* Y = (bf16_t*)(a.ws + WS_HY) + (row0 + t) * D_ + cbase; const float* be = a.in[26] + l * 1024 + cbase;
#pragma unroll
      for (int q = 0; q < 4; ++q) { float o[8]; const f32x4 b0 = *(const f32x4*)(be + 8 * q), b1 = *(const f32x4*)(be + 8 * q + 4);
#pragma unroll
          for (int i = 0; i < 8; ++i) o[i] = y[8 * q + i] * rs * (i < 4 ? b0[i] : b1[i - 4]);
          *(u32x4*)(Y + 8 * q) = pack8(o); } }
    __syncthreads();
}
__device__ __forceinline__ float shiftmix(const bf16_t* P, size_t row, int tglob, int col, float mu) {
    const float cur = bf2f(P[row * PS_ + PC + col]); const float prev = (tglob > 0) ? bf2f(P[(row - 1) * PS_ + PC + col]) : 0.f; return cur + (prev - cur) * mu; }
__device__ __forceinline__ void rwkv_seq(const Args& a, int l, int bh, LAS unsigned char* lds) {
    const int tid = otid(), wid = tid >> 6, lane = tid & 63, h = bh % 6, b = bh / 6;
    const bf16_t* P = (const bf16_t*)(a.ws + WS_P); bf16_t* Y = (bf16_t*)(a.ws + WS_HY);
    LAS float* LIN = (LAS float*)lds;
    LAS float* VEC = (LAS float*)(lds + 32768);
    LAS float* YL = (LAS float*)(lds + 90112);
    const float* mu = a.in[15] + l * 1408;
    float S[64];
#pragma unroll
    for (int k = 0; k < 64; ++k) S[k] = 0.f;
    const int t = tid >> 4, jg = tid & 15;
#pragma unroll 1
    for (int tb = 0; tb < T_; tb += 32) {
        const size_t row = (size_t)b * T_ + tb + t; const int tglob = tb + t;
#pragma unroll 4
        for (int i = 0; i < 16; ++i) { const int col = 16 * jg + i; const float ps = shiftmix(P, row, tglob, 1152 + col, mu[1152 + col]);
            float v; if (col < 64) { const float e = __expf(2.0f * ps); v = 1.0f - 2.0f / (e + 1.0f); } else if (col < 128) v = ps; else v = sigmoidf_(ps);
            LIN[t * 256 + col] = v; }
        __syncthreads();
        { const int cb = l * 384 + 64 * h + 4 * jg;
          f32x4 wacc = *(const f32x4*)(a.in[16] + cb), aacc = *(const f32x4*)(a.in[18] + cb), gacc = {0.f, 0.f, 0.f, 0.f};
          const float* wu = a.in[17] + (size_t)l * 64 * 384 + 64 * h + 4 * jg; const float* au = a.in[19] + (size_t)l * 64 * 384 + 64 * h + 4 * jg; const float* gu = a.in[20] + (size_t)l * 128 * 384 + 64 * h + 4 * jg;
#pragma unroll 4
          for (int i = 0; i < 64; ++i) { const float x = LIN[t * 256 + i]; wacc += x * *(const f32x4*)(wu + (size_t)i * 384); }
#pragma unroll 4
          for (int i = 0; i < 64; ++i) { const float x = LIN[t * 256 + 64 + i]; aacc += x * *(const f32x4*)(au + (size_t)i * 384); }
#pragma unroll 4
          for (int i = 0; i < 128; ++i) { const float x = LIN[t * 256 + 128 + i]; gacc += x * *(const f32x4*)(gu + (size_t)i * 384); }
          float kk[4], kp[4], aa[4], dec[4], rr[4], vv[4]; float ssq = 0.f;
#pragma unroll
          for (int j = 0; j < 4; ++j) { const int hc = 64 * h + 4 * jg + j;
              const float wp = wacc[j]; const float w = -log1pf(__expf(-wp)) - 0.5f; dec[j] = __expf(-__expf(w));
              aa[j] = sigmoidf_(aacc[j]);
              rr[j] = shiftmix(P, row, tglob, hc, mu[hc]); const float kx = shiftmix(P, row, tglob, 384 + hc, mu[384 + hc]); vv[j] = shiftmix(P, row, tglob, 768 + hc, mu[768 + hc]);
              kk[j] = kx * a.in[21][l * 384 + hc]; ssq += kk[j] * kk[j];
              kp[j] = kx * (1.0f + (aa[j] - 1.0f) * a.in[22][l * 384 + hc]); }
          ssq += __shfl_xor(ssq, 1); ssq += __shfl_xor(ssq, 2); ssq += __shfl_xor(ssq, 4); ssq += __shfl_xor(ssq, 8);
          const float rn = 1.0f / sqrtf(ssq + 1e-12f);
#pragma unroll
          for (int j = 0; j < 4; ++j) { const int jj = 4 * jg + j; const float kn = kk[j] * rn;
              VEC[(t * 7 + 0) * 64 + jj] = kn; VEC[(t * 7 + 1) * 64 + jj] = dec[j]; VEC[(t * 7 + 2) * 64 + jj] = kp[j]; VEC[(t * 7 + 3) * 64 + jj] = kn * aa[j];
              VEC[(t * 7 + 4) * 64 + jj] = rr[j]; VEC[(t * 7 + 5) * 64 + jj] = vv[j]; VEC[(t * 7 + 6) * 64 + jj] = gacc[j]; } }
        __syncthreads();
        if (wid == 0) {
#pragma unroll 1
            for (int ts = 0; ts < 32; ++ts) { const LAS f32x4* V4 = (const LAS f32x4*)(VEC + ts * 7 * 64);
                const float vv = VEC[(ts * 7 + 5) * 64 + lane]; float sa = 0.f;
#pragma unroll
                for (int k4 = 0; k4 < 16; ++k4) { const f32x4 q = V4[k4]; sa += S[4 * k4] * q.x; sa += S[4 * k4 + 1] * q.y; sa += S[4 * k4 + 2] * q.z; sa += S[4 * k4 + 3] * q.w; }
                sa = -sa; float y = 0.f;
#pragma unroll
                for (int k4 = 0; k4 < 16; ++k4) { const f32x4 w = V4[16 + k4], kp = V4[32 + k4], ka = V4[48 + k4], r = V4[64 + k4];
                    S[4 * k4] = S[4 * k4] * w.x + sa * ka.x + vv * kp.x; S[4 * k4 + 1] = S[4 * k4 + 1] * w.y + sa * ka.y + vv * kp.y;
                    S[4 * k4 + 2] = S[4 * k4 + 2] * w.z + sa * ka.z + vv * kp.z; S[4 * k4 + 3] = S[4 * k4 + 3] * w.w + sa * ka.w + vv * kp.w;
                    y += S[4 * k4] * r.x; y += S[4 * k4 + 1] * r.y; y += S[4 * k4 + 2] * r.z; y += S[4 * k4 + 3] * r.w; }
                YL[ts * 64 + lane] = y; }
        }
        __syncthreads();
        { const int cb = l * 384 + 64 * h + 4 * jg; const f32x4 y4 = *(const LAS f32x4*)(YL + t * 64 + 4 * jg);
          float sm = (y4.x + y4.y) + (y4.z + y4.w); sm += __shfl_xor(sm, 1); sm += __shfl_xor(sm, 2); sm += __shfl_xor(sm, 4); sm += __shfl_xor(sm, 8);
          const float mean = sm * (1.0f / 64.0f); const f32x4 d = y4 - mean;
          float vr = (d.x * d.x + d.y * d.y) + (d.z * d.z + d.w * d.w); vr += __shfl_xor(vr, 1); vr += __shfl_xor(vr, 2); vr += __shfl_xor(vr, 4); vr += __shfl_xor(vr, 8);
          const float rs = 1.0f / sqrtf(vr * (1.0f / 64.0f) + 64e-5f);
          const f32x4 rk = *(const f32x4*)(a.in[23] + cb), lw = *(const f32x4*)(a.in[24] + cb), lb = *(const f32x4*)(a.in[25] + cb), be = *(const f32x4*)(a.in[26] + l * 1024 + 640 + 64 * h + 4 * jg);
          float bs = 0.f; float r4[4], v4[4], g4[4];
#pragma unroll
          for (int j = 0; j < 4; ++j) { const int jj = 4 * jg + j; r4[j] = VEC[(t * 7 + 4) * 64 + jj]; v4[j] = VEC[(t * 7 + 5) * 64 + jj]; g4[j] = VEC[(t * 7 + 6) * 64 + jj]; bs += r4[j] * VEC[(t * 7 + 2) * 64 + jj] * rk[j]; }
          bs += __shfl_xor(bs, 1); bs += __shfl_xor(bs, 2); bs += __shfl_xor(bs, 4); bs += __shfl_xor(bs, 8);
          float o[4];
#pragma unroll
          for (int j = 0; j < 4; ++j) o[j] = ((d[j] * rs * lw[j] + lb[j]) + bs * v4[j]) * g4[j] * be[j];
          u32x2 w2; w2.x = pk2(o[0], o[1]); w2.y = pk2(o[2], o[3]);
          *(u32x2*)(Y + row * D_ + 640 + 64 * h + 4 * jg) = w2; }
        __syncthreads();
    }
}
__global__ void __launch_bounds__(512, 2) mk_fwd(Args a) {
    extern __shared__ __attribute__((aligned(16))) unsigned char shm[];
    LAS unsigned char* lds = (LAS unsigned char*)shm;
    cg::grid_group grid = cg::this_grid();
    if (a.ph_hi > 1000) grid.sync();
    { volatile LAS unsigned* stw = (volatile LAS unsigned*)(lds + LDS_BYTES - 16); if (threadIdx.x < 4) stw[threadIdx.x] = 0u; }
    __syncthreads();
    XcdBarrier xb = xcd_barrier_post((unsigned*)(a.ws + WS_BAR), (volatile LAS unsigned*)(lds + LDS_BYTES - 16));
    const int tid = otid(), wid = tid >> 6, lane = tid & 63, G = gridDim.x;
    unsigned char* ws = a.ws;
    bf16_t* Pb = (bf16_t*)(ws + WS_P); bf16_t* HY = (bf16_t*)(ws + WS_HY); float* MOD = (float*)(ws + WS_MOD);
#ifdef MK_PROBE
    unsigned long long t_prev = __builtin_amdgcn_s_memrealtime(), t_acc = 0;
#define PH_STAMP(n) { grid.sync(); const unsigned long long t_now = __builtin_amdgcn_s_memrealtime(); if ((MK_PROBE >> (n)) & 1) t_acc += t_now - t_prev; t_prev = t_now; }
#else
#define PH_STAMP(n)
#endif
#ifndef MK_SUB
#define MK_SUB 0
#endif
#ifndef MK_REP
#define MK_REP 0
#endif
#define PH_BEGIN(n) if (a.ph_lo <= (n) && (n) < a.ph_hi) { const int ph_cur = (n); (void)ph_cur; if ((n) > a.ph_lo) xcd_barrier(xb); for (int rep_ = 0; rep_ < (((MK_REP >> (n)) & 1) ? 2 : 1); ++rep_) {
#define PH_END } PH_STAMP(ph_cur) }
    PH_BEGIN(0) phase_pro(a, lds); PH_END
#pragma unroll
    for (int l = 0; l < 2; ++l) {
        const int p0 = 1 + 9 * l;
        const float* xin = (l == 0) ? a.in[0] : a.out;
        const float* modl = MOD + (size_t)l * 8 * 6144;
        PH_BEGIN(p0 + 0) phase_norm(xin, a.in[2] + l * D_, modl + 0, modl + 1024, HY); PH_END
        PH_BEGIN(p0 + 1) { pg8::Gemm g{HY, (const bf16_t*)(ws + WS_WIN + l * SZ_WIN), M_, PS_, D_}; pg8::StaticOrder S; S.init(M_, PS_, G, blockIdx.x); EpiP E{Pb, PS_};
                  pg8::gemm_phase<EpiP, pg8::StaticOrder>(lds, g, S, E, nullptr); } PH_END
        PH_BEGIN(p0 + 2) { for (int r_ = 0; r_ < ((MK_SUB & 1) ? 2 : 1); ++r_) for (int it = blockIdx.x; it < 1536; it += G) hgrn_item<0>(a, l, it, lds);
                  for (int r_ = 0; r_ < ((MK_SUB & 2) ? 2 : 1); ++r_) for (int it = blockIdx.x; it < 1536; it += G) rwkv_chunk<0>(a, l, it, lds);
                  for (int r_ = 0; r_ < ((MK_SUB & 4) ? 2 : 1); ++r_) for (int it = blockIdx.x; it < 256; it += G) rg2_mode0(a, l, it, lds); } PH_END
        PH_BEGIN(p0 + 3) { const int t3 = otid();
                  if (t3 < 64) { if ((int)blockIdx.x < 192) rwkv_scan(a, blockIdx.x >> 2, blockIdx.x & 3, t3); }
                  else { for (int e = blockIdx.x * 448 + (t3 - 64); e < 48 * 4096; e += G * 448) hgrn_scan(a, e);
                         for (int e = blockIdx.x * 448 + (t3 - 64); e < 2048; e += G * 448) rg_carry(a, e); } } PH_END
        PH_BEGIN(p0 + 4) { for (int r_ = 0; r_ < ((MK_SUB & 1) ? 2 : 1); ++r_) for (int it = blockIdx.x; it < 1536; it += G) hgrn_item<1>(a, l, it, lds);
                  for (int r_ = 0; r_ < ((MK_SUB & 2) ? 2 : 1); ++r_) for (int it = blockIdx.x; it < 1536; it += G) rwkv_chunk<1>(a, l, it, lds);
                  for (int r_ = 0; r_ < ((MK_SUB & 4) ? 2 : 1); ++r_) for (int it = blockIdx.x; it < 256; it += G) rg2_mode1(a, l, it, lds); } PH_END
        PH_BEGIN(p0 + 5) { pg8::Gemm g{HY, (const bf16_t*)(ws + WS_WOUT + l * SZ_WOUT), M_, D_, D_}; pg8::StaticOrder S; S.init(M_, D_, G, blockIdx.x); EpiRes E{xin, a.out, modl + 2048};
                  pg8::gemm_phase<EpiRes, pg8::StaticOrder>(lds, g, S, E, nullptr); } PH_END
        PH_BEGIN(p0 + 6) phase_norm(a.out, a.in[3] + l * D_, modl + 3072, modl + 4096, HY); PH_END
        PH_BEGIN(p0 + 7) { pg8::Gemm g{HY, (const bf16_t*)(ws + WS_WGU + l * SZ_WGU), M_, NGU_, D_}; pg8::StaticOrder S; S.init(M_, NGU_, G, blockIdx.x); EpiSwi E{Pb};
                  pg8::gemm_phase<EpiSwi, pg8::StaticOrder>(lds, g, S, E, nullptr); } PH_END
        PH_BEGIN(p0 + 8) { pg8::Gemm g{Pb, (const bf16_t*)(ws + WS_WD + l * SZ_WD), M_, D_, FF_}; pg8::StaticOrder S; S.init(M_, D_, G, blockIdx.x); EpiRes E{a.out, a.out, modl + 5120};
                  pg8::gemm_phase<EpiRes, pg8::StaticOrder>(lds, g, S, E, nullptr); } PH_END
    }
    PH_BEGIN(19) phase_final(a.out, a.in[31]); PH_END
#ifdef MK_PROBE
    if (blockIdx.x == 0 && threadIdx.x == 0) a.out[0] = (float)t_acc * 0.01f;
#endif
}
#ifndef MK_MULTI
#define MK_MULTI 0
#endif
extern "C" void kernel_launch(void* const* d_in, const int* in_sizes, int n_in, void* d_out, int out_size, void* d_ws, size_t ws_size, hipStream_t stream) {
    static int grid = 0;
    if (!grid) {
        if (n_in != 32 || ws_size < WS_END) { fprintf(stderr, "kernel_launch: bad args n_in %d ws %zu need %zu\n", n_in, ws_size, (size_t)WS_END); return; }
        hipFuncSetAttribute((const void*)mk_fwd, hipFuncAttributeMaxDynamicSharedMemorySize, LDS_BYTES);
        int dev = 0, cus = 0, per_cu = 0; hipGetDevice(&dev); hipDeviceGetAttribute(&cus, hipDeviceAttributeMultiprocessorCount, dev);
        hipOccupancyMaxActiveBlocksPerMultiprocessor(&per_cu, mk_fwd, 512, LDS_BYTES);
        if (per_cu < 1) { fprintf(stderr, "kernel_launch: occupancy 0\n"); per_cu = 1; }
        grid = cus;
    }
    Args a{}; for (int i = 0; i < 32; ++i) a.in[i] = (const float*)d_in[i];
    a.out = (float*)d_out; a.ws = (unsigned char*)d_ws;
#if MK_MULTI
    for (int ph = 0; ph < 20; ++ph) { a.ph_lo = ph; a.ph_hi = ph + 1; hipLaunchKernelGGL(mk_fwd, dim3(grid), dim3(512), LDS_BYTES, stream, a); }
#else
    a.ph_lo = 0; a.ph_hi = 20; void* args[] = {&a};
    if (hipMemsetAsync((char*)d_ws + WS_BAR, 0, XCD_BAR_WORDS * 4, stream) != hipSuccess) { fprintf(stderr, "memset failed\n"); return; }
    hipError_t e = hipLaunchCooperativeKernel((const void*)mk_fwd, dim3(grid), dim3(512), args, LDS_BYTES, stream);
    if (e != hipSuccess) fprintf(stderr, "cooperative launch failed: %s (grid %d)\n", hipGetErrorString(e), grid);
#endif
}
```

```cpp
#include <hip/hip_runtime.h>
#include <hip/hip_cooperative_groups.h>
#include <cstdio>
#include <cstdint>
namespace cg = cooperative_groups;
__device__ __forceinline__ int otid() { int t = threadIdx.x; asm volatile("" : "+v"(t)); return t; }
namespace pg8 {
#define PG8_LAS __attribute__((address_space(3)))
typedef unsigned short bf16_t;
typedef short bf16x8 __attribute__((ext_vector_type(8)));
typedef float f32x4 __attribute__((ext_vector_type(4)));
typedef unsigned u32x4 __attribute__((ext_vector_type(4)));
constexpr int BM = 256, BK = 64, HALF = 128, HTB = HALF * BK * 2  , STAGE_BYTES = 8 * HTB, NXCD = 8, WGM = 8;

__host__ __device__ __forceinline__ int lds_byte(int r, int c) { const int st = (r >> 4) * 2 + (c >> 5), rr = r & 15, cc = c & 31, ob = rr * 64 + cc * 2; return st * 1024 + (ob ^ (((ob >> 9) & 1) << 5)); }
__host__ __device__ __forceinline__ void stage_rc(int b, int& R, int& C) { const int st = b / 1024, sb = b % 1024, swz = sb ^ (((sb >> 9) & 1) << 5); R = (st >> 1) * 16 + swz / 64; C = (st & 1) * 32 + (swz % 64) / 2; }
__host__ __device__ __forceinline__ int perm32(int rho) { const int n = rho >> 4, i = rho & 15; return 8 * (i >> 2) + 4 * n + (i & 3); }

struct Unit { int pm, pn; };
struct Gemm { const bf16_t* A; const bf16_t* Bt; int M, N, K; };

struct StaticOrder {
    int nM, nN, nwg, G, c;
    __host__ __device__ void init(int M, int N, int G_, int c_) { nM = M / BM; nN = N / BM; nwg = nM * nN; G = G_; c = c_; }
    __host__ __device__ bool next(int i, Unit& u) const {
        const long L = (long)i * G + c; if (L >= nwg) return false;
        int wgid = (int)L; { const int q = nwg / NXCD, r = nwg % NXCD, xcd = wgid % NXCD, off = wgid / NXCD; wgid = (xcd < r ? xcd * (q + 1) : r * (q + 1) + (xcd - r) * q) + off; }
        const int nig = WGM * nN, gid = wgid / nig, fm = gid * WGM, gsz = (nM - fm) < WGM ? (nM - fm) : WGM;
        u.pm = fm + ((wgid % nig) % gsz); u.pn = (wgid % nig) / gsz; return true;
    }
    __device__ __forceinline__ void a_ready(const Unit&) const {}
    __device__ __forceinline__ void done(const Unit&) const {}
};
__device__ __forceinline__ unsigned cvt_pk_bf16(float lo, float hi) { unsigned r; asm volatile("v_cvt_pk_bf16_f32 %0, %1, %2" : "=v"(r) : "v"(lo), "v"(hi)); return r; }
template <class Epi, class Sched, bool STAMP = false>
__device__ __forceinline__ void gemm_phase(PG8_LAS unsigned char* lds, const Gemm g, const Sched& S, const Epi& E, unsigned long long* stamps) {
    const int tid = otid(), wid = __builtin_amdgcn_readfirstlane(tid >> 6), lane = tid & 63, wr = wid >> 2, wc = wid & 3, fr = lane & 15, fq = lane >> 4;
    const int K = g.K, nt = K / BK;
    unsigned voffA[2], voffB[2];
#pragma unroll
    for (int i = 0; i < 2; ++i) { int R, C; stage_rc(tid * 16 + i * 8192, R, C); const int Rb = Epi::PERM ? ((R & ~31) + perm32(R & 31)) : R;
        voffA[i] = (unsigned)(R * K + C) * 2u; voffB[i] = (unsigned)(Rb * K + C) * 2u; }
    const size_t kstep = (size_t)(BK * 2);
    const size_t hstep = (size_t)HALF * K * 2;
    const size_t tstep = 2 * hstep;
    const unsigned ldsw = (unsigned)wid * 1024u;
    const int aoff = lds_byte(wr * 64 + fr, fq * 8), boff = lds_byte(wc * 32 + fr, fq * 8);
#define PG8_SA(b, h) (((b) * 2 + (h)) * HTB)
#define PG8_SB(b, h) ((4 + (b) * 2 + (h)) * HTB)
#define PG8_STAGE(bufoff, gbase, voff) do { _Pragma("unroll") for (int _i = 0; _i < 2; ++_i) \
        __builtin_amdgcn_global_load_lds((const unsigned*)((const char*)(gbase) + (voff)[_i]), (PG8_LAS unsigned*)(lds + (bufoff) + ldsw + _i * 8192), 16, 0, 0); } while (0)
#define PG8_LDA(dst, b, h) do { _Pragma("unroll") for (int m = 0; m < 4; ++m) _Pragma("unroll") for (int k = 0; k < 2; ++k) dst[m][k] = *(const PG8_LAS bf16x8*)(lds + PG8_SA(b, h) + aoff + m * 2048 + k * 1024); } while (0)
#define PG8_LDB(dst, b, h) do { _Pragma("unroll") for (int n = 0; n < 2; ++n) _Pragma("unroll") for (int k = 0; k < 2; ++k) dst[n][k] = *(const PG8_LAS bf16x8*)(lds + PG8_SB(b, h) + boff + n * 2048 + k * 1024); } while (0)
#define PG8_MMA(ai, bj, At, Bt) do { __builtin_amdgcn_s_setprio(1); _Pragma("unroll") for (int m = 0; m < 4; ++m) _Pragma("unroll") for (int n = 0; n < 2; ++n) _Pragma("unroll") for (int k = 0; k < 2; ++k) \
        acc[ai][bj][m][n] = __builtin_amdgcn_mfma_f32_16x16x32_bf16(Bt[n][k], At[m][k], acc[ai][bj][m][n], 0, 0, 0); __builtin_amdgcn_s_setprio(0); } while (0)
#define PG8_WAIT_V(n) asm volatile("s_waitcnt vmcnt(" #n ")" ::: "memory")
#define PG8_WAIT_L(n) asm volatile("s_waitcnt lgkmcnt(" #n ")" ::: "memory")
#define PG8_BAR __builtin_amdgcn_s_barrier()
#define PG8_SCHED __builtin_amdgcn_sched_barrier(0)
    Unit cur, nxt; int ui = 0;
    if (!S.next(0, cur)) return;
    f32x4 acc[2][2][4][2];
#pragma unroll
    for (int a = 0; a < 2; ++a)
#pragma unroll
        for (int b = 0; b < 2; ++b)
#pragma unroll
            for (int m = 0; m < 4; ++m)
#pragma unroll
                for (int n = 0; n < 2; ++n) acc[a][b][m][n] = (f32x4){0.f, 0.f, 0.f, 0.f};
    bf16x8 At[4][2], B0[2][2], B1[2][2];
    const char* cA = (const char*)g.A + (size_t)cur.pm * tstep; const char* cB = (const char*)g.Bt + (size_t)cur.pn * tstep;
    S.a_ready(cur);
    PG8_STAGE(PG8_SB(0, 0), cB, voffB); PG8_STAGE(PG8_SA(0, 0), cA, voffA); PG8_STAGE(PG8_SB(0, 1), cB + hstep, voffB); PG8_STAGE(PG8_SA(0, 1), cA + hstep, voffA);
    if (wr == 1) PG8_BAR;
    PG8_WAIT_V(4); PG8_BAR;
    PG8_STAGE(PG8_SB(1, 0), cB + kstep, voffB); PG8_STAGE(PG8_SA(1, 0), cA + kstep, voffA); PG8_STAGE(PG8_SB(1, 1), cB + hstep + kstep, voffB);
    PG8_WAIT_V(6); PG8_BAR;
    for (;;) {
        const bool has_next = S.next(ui + 1, nxt);
        const char* nA = has_next ? (const char*)g.A + (size_t)nxt.pm * tstep : cA; const char* nB = has_next ? (const char*)g.Bt + (size_t)nxt.pn * tstep : cB;
        for (int t = 0; t < nt; t += 2) {
            const bool last = (t == nt - 2);
            const char* a1 = cA + (size_t)(t + 1) * kstep;
            const char* a2 = last ? nA : cA + (size_t)(t + 2) * kstep; const char* b2 = last ? nB : cB + (size_t)(t + 2) * kstep;
            const char* a3 = a2 + kstep; const char* b3 = b2 + kstep;
            if (last && has_next) S.a_ready(nxt);
            PG8_LDB(B0, 0, 0); PG8_SCHED; PG8_LDA(At, 0, 0); PG8_STAGE(PG8_SA(1, 1), a1 + hstep, voffA);
            PG8_WAIT_L(8); PG8_BAR; PG8_WAIT_L(0); PG8_MMA(0, 0, At, B0); PG8_BAR; PG8_SCHED;
            PG8_LDB(B1, 0, 1); PG8_STAGE(PG8_SB(0, 0), b2, voffB);
            PG8_BAR; PG8_WAIT_L(0); PG8_MMA(0, 1, At, B1); PG8_BAR;
            PG8_LDA(At, 0, 1); PG8_STAGE(PG8_SA(0, 0), a2, voffA);
            PG8_BAR; PG8_WAIT_L(0); PG8_MMA(1, 0, At, B0); PG8_BAR; PG8_SCHED;
            PG8_STAGE(PG8_SB(0, 1), b2 + hstep, voffB);
            PG8_WAIT_V(6); PG8_BAR; PG8_MMA(1, 1, At, B1); PG8_BAR;
            PG8_LDB(B0, 1, 0); PG8_SCHED; PG8_LDA(At, 1, 0); PG8_STAGE(PG8_SA(0, 1), a2 + hstep, voffA);
            PG8_WAIT_L(8); PG8_BAR; PG8_WAIT_L(0); PG8_MMA(0, 0, At, B0); PG8_BAR; PG8_SCHED;
            PG8_LDB(B1, 1, 1); PG8_STAGE(PG8_SB(1, 0), b3, voffB);
            PG8_BAR; PG8_WAIT_L(0); PG8_MMA(0, 1, At, B1); PG8_BAR;
            PG8_LDA(At, 1, 1); PG8_STAGE(PG8_SA(1, 0), a3, voffA);
            PG8_BAR; PG8_WAIT_L(0); PG8_MMA(1, 0, At, B0); PG8_BAR; PG8_SCHED;
            PG8_STAGE(PG8_SB(1, 1), b3 + hstep, voffB);
            PG8_WAIT_V(6); PG8_BAR; PG8_MMA(1, 1, At, B1); PG8_BAR;
        }
        if constexpr (!Epi::AFTER_DRAIN) { E(acc, cur, wr, wc, fr, fq); S.done(cur); }
        if (!has_next) break;
#pragma unroll
        for (int a = 0; a < 2; ++a)
#pragma unroll
            for (int b = 0; b < 2; ++b)
#pragma unroll
                for (int m = 0; m < 4; ++m)
#pragma unroll
                    for (int n = 0; n < 2; ++n) acc[a][b][m][n] = (f32x4){0.f, 0.f, 0.f, 0.f};
        cur = nxt; cA = nA; cB = nB; ++ui;
    }
    PG8_WAIT_V(0);
    if (wr == 0) PG8_BAR;
    PG8_BAR;
    if constexpr (Epi::AFTER_DRAIN) { E.fused(acc, cur, wr, wc, fr, fq, lds, wid, lane); S.done(cur); }
#undef PG8_SA
#undef PG8_SB
#undef PG8_STAGE
#undef PG8_LDA
#undef PG8_LDB
#undef PG8_MMA
#undef PG8_WAIT_V
#undef PG8_WAIT_L
#undef PG8_BAR
#undef PG8_SCHED
}
}
using pg8::bf16_t; using pg8::bf16x8; using pg8::f32x4; using pg8::u32x4;
#define LAS __attribute__((address_space(3)))
typedef float f32x2 __attribute__((ext_vector_type(2)));
typedef unsigned u32x2 __attribute__((ext_vector_type(2)));
typedef short s16x4 __attribute__((ext_vector_type(4)));

constexpr int M_ = 16384, D_ = 1024, T_ = 2048, NB_ = 8, PS_ = 3584, PW_ = 3456, FF_ = 2816, NGU_ = 5632;
constexpr int PAX = 0, PAY = 256, PBQ = 512, PBF = 896, PBV = 1280, PBG = 1664, PC = 2048;
constexpr int LDS_BYTES = 144 * 1024;
constexpr size_t SZ_WIN = (size_t)PS_ * D_ * 2, SZ_WOUT = (size_t)D_ * D_ * 2, SZ_WGU = (size_t)NGU_ * D_ * 2, SZ_WD = (size_t)D_ * FF_ * 2;
constexpr size_t WS_WIN = 0, WS_WOUT = WS_WIN + 2 * SZ_WIN, WS_WGU = WS_WOUT + 2 * SZ_WOUT, WS_WD = WS_WGU + 2 * SZ_WGU;
constexpr size_t WS_MOD = WS_WD + 2 * SZ_WD;
constexpr size_t WS_P = WS_MOD + 2 * 8 * 6144 * 4;
constexpr size_t WS_HY = WS_P + (size_t)M_ * PS_ * 2;
constexpr size_t WS_RGA = WS_HY + (size_t)M_ * D_ * 2;
constexpr size_t WS_HKV = WS_RGA + 3 * 8 * 32 * 256 * 4;
constexpr size_t WS_HDEC = WS_HKV + (size_t)1536 * 4096 * 2;
constexpr size_t WS_RM = WS_HDEC + (size_t)1536 * 64 * 4;
constexpr size_t WS_RN = WS_RM + (size_t)1536 * 4096 * 2;
constexpr size_t WS_RGAM = WS_RN + (size_t)1536 * 4096 * 2;
constexpr size_t WS_LORA = WS_RGAM + (size_t)1536 * 64 * 4;
constexpr size_t WS_RGW = WS_LORA + (size_t)2 * 98304 * 2;
constexpr size_t WS_RGL = WS_RGW + 65536 * 2;
constexpr size_t WS_RGB = WS_RGL + (size_t)M_ * 256 * 2;
constexpr size_t WS_BAR = WS_RGB + (size_t)M_ * 256 * 2;
constexpr size_t WS_END = WS_BAR + 16384;

struct Args { const float* in[32]; float* out; unsigned char* ws; int ph_lo, ph_hi; };

typedef __bf16 bf16n2 __attribute__((ext_vector_type(2)));
__device__ __forceinline__ unsigned pk2(float lo, float hi) { bf16n2 v; v.x = (__bf16)lo; v.y = (__bf16)hi; return __builtin_bit_cast(unsigned, v); }
__device__ __forceinline__ unsigned f2bf(float f) { return pk2(f, f) & 0xffffu; }
__device__ __forceinline__ float bf2f(unsigned short b) { return __builtin_bit_cast(float, ((unsigned)b) << 16); }
__device__ __forceinline__ float bflo(unsigned w) { return __builtin_bit_cast(float, w << 16); }
__device__ __forceinline__ float bfhi(unsigned w) { return __builtin_bit_cast(float, w & 0xffff0000u); }
__device__ __forceinline__ float wave_sum(float v) {
#pragma unroll
    for (int o = 1; o < 64; o <<= 1) v += __shfl_xor(v, o);
    return v;
}
__device__ __forceinline__ float rcp_(float x) { return __builtin_amdgcn_rcpf(x); }
__device__ __forceinline__ float rsq_(float x) { return __builtin_amdgcn_rsqf(x); }
__device__ __forceinline__ float sigmoidf_(float x) { return rcp_(1.0f + __expf(-x)); }
#define LDS_WAIT() asm volatile("s_waitcnt lgkmcnt(0)" ::: "memory")

struct EpiP {
    static constexpr bool PERM = true, AFTER_DRAIN = false;
    bf16_t* O; int ldc;
    __device__ __forceinline__ void operator()(const f32x4 (&acc)[2][2][4][2], const pg8::Unit& u, int wr, int wc, int fr, int fq) const {
        const int row0 = u.pm * 256 + wr * 64 + fr, col0 = u.pn * 256 + wc * 32 + 8 * fq;
#pragma unroll
        for (int ai = 0; ai < 2; ++ai)
#pragma unroll
            for (int m = 0; m < 4; ++m) { bf16_t* rowp = O + (size_t)(row0 + ai * 128 + m * 16) * ldc + col0;
#pragma unroll
                for (int bj = 0; bj < 2; ++bj) { const f32x4 v0 = acc[ai][bj][m][0], v1 = acc[ai][bj][m][1]; u32x4 w;
                    w.x = pg8::cvt_pk_bf16(v0[0], v0[1]); w.y = pg8::cvt_pk_bf16(v0[2], v0[3]); w.z = pg8::cvt_pk_bf16(v1[0], v1[1]); w.w = pg8::cvt_pk_bf16(v1[2], v1[3]);
                    *(u32x4*)(rowp + bj * 128) = w; } }
    }
};
struct EpiRes {
    static constexpr bool PERM = false, AFTER_DRAIN = false;
    const float* base; float* out; const float* gate;
    __device__ __forceinline__ void operator()(const f32x4 (&acc)[2][2][4][2], const pg8::Unit& u, int wr, int wc, int fr, int fq) const {
        const int row0 = u.pm * 256 + wr * 64 + fr, col0 = u.pn * 256 + wc * 32 + 4 * fq, b = u.pm >> 3;
        f32x4 gv[2][2];
#pragma unroll
        for (int bj = 0; bj < 2; ++bj)
#pragma unroll
            for (int n = 0; n < 2; ++n) gv[bj][n] = *(const f32x4*)(gate + (size_t)b * 6144 + col0 + bj * 128 + n * 16);
#pragma unroll
        for (int ai = 0; ai < 2; ++ai)
#pragma unroll
            for (int m = 0; m < 4; ++m) { const size_t ro = (size_t)(row0 + ai * 128 + m * 16) * 1024 + col0;
#pragma unroll
                for (int bj = 0; bj < 2; ++bj)
#pragma unroll
                    for (int n = 0; n < 2; ++n) { const f32x4 bv = *(const f32x4*)(base + ro + bj * 128 + n * 16);
                        *(f32x4*)(out + ro + bj * 128 + n * 16) = bv + gv[bj][n] * acc[ai][bj][m][n]; } }
    }
};
struct EpiSwi {
    static constexpr bool PERM = true, AFTER_DRAIN = false;
    bf16_t* O;
    __device__ __forceinline__ void operator()(const f32x4 (&acc)[2][2][4][2], const pg8::Unit& u, int wr, int wc, int fr, int fq) const {
        const int row0 = u.pm * 256 + wr * 64 + fr, col0 = u.pn * 128 + wc * 32 + 8 * fq;
#pragma unroll
        for (int ai = 0; ai < 2; ++ai)
#pragma unroll
            for (int m = 0; m < 4; ++m) { bf16_t* rowp = O + (size_t)(row0 + ai * 128 + m * 16) * FF_ + col0; float o[8];
#pragma unroll
                for (int n = 0; n < 2; ++n)
#pragma unroll
                    for (int i = 0; i < 4; ++i) { const float g = acc[ai][0][m][n][i], up = acc[ai][1][m][n][i]; o[4 * n + i] = g * sigmoidf_(g) * up; }
                u32x4 w; w.x = pg8::cvt_pk_bf16(o[0], o[1]); w.y = pg8::cvt_pk_bf16(o[2], o[3]); w.z = pg8::cvt_pk_bf16(o[4], o[5]); w.w = pg8::cvt_pk_bf16(o[6], o[7]);
                *(u32x4*)rowp = w; }
    }
};

__device__ __forceinline__ void transpose_item(const float* W, int K, int N, bf16_t* WT, int mode, LAS float* scr, int item, int lane) {
    const int nblk = N / 32, kb = item / nblk, nb = item % nblk, k0 = 64 * kb, n0 = 32 * nb;
#pragma unroll 8
    for (int i = 0; i < 32; ++i) { const int kk = 2 * i + (lane >> 5); scr[kk * 33 + (lane & 31)] = W[(size_t)(k0 + kk) * N + n0 + (lane & 31)]; }
    LDS_WAIT(); asm volatile("" ::: "memory");
    const int c = lane & 7;
#pragma unroll
    for (int j = 0; j < 4; ++j) { const int nl = (lane >> 3) + 8 * j, n = n0 + nl; const LAS float* s = scr + (8 * c) * 33 + nl;
        const int row = (mode == 0) ? n : (256 * (n >> 7) + (n & 127) + (mode == 2 ? 128 : 0));
        u32x4 o; o.x = pk2(s[0 * 33], s[1 * 33]); o.y = pk2(s[2 * 33], s[3 * 33]); o.z = pk2(s[4 * 33], s[5 * 33]); o.w = pk2(s[6 * 33], s[7 * 33]);
        *(u32x4*)(WT + (size_t)row * K + k0 + 8 * c) = o; }
    LDS_WAIT(); asm volatile("" ::: "memory");
}
__device__ __forceinline__ void phase_pro(const Args& a, LAS unsigned char* lds) {
    const int tid = otid(), wid = tid >> 6, lane = tid & 63;
    unsigned char* ws = a.ws;
    LAS float* CS = (LAS float*)lds;
    LAS float* RED = (LAS float*)(lds + 32768);
    if ((int)blockIdx.x < 192) {
        for (int i = tid; i < 8192; i += 512) { const float cv = a.in[1][i]; CS[i] = cv * sigmoidf_(cv); }
        __syncthreads();
    }
    for (int item = blockIdx.x; item < 192; item += gridDim.x) {
        const int l = item / 96, cgp = item % 96, col = cgp * 64 + lane;
        const float* aw = a.in[4] + (size_t)l * 1024 * 6144;
        float acc[8];
#pragma unroll
        for (int b = 0; b < 8; ++b) acc[b] = 0.f;
        for (int k = wid * 128; k < wid * 128 + 128; ++k) { const float w = aw[(size_t)k * 6144 + col];
#pragma unroll
            for (int b = 0; b < 8; ++b) acc[b] += CS[b * 1024 + k] * w; }
#pragma unroll
        for (int b = 0; b < 8; ++b) RED[(wid * 8 + b) * 64 + lane] = acc[b];
        __syncthreads();
        { const int b = wid; float s = 0.f;
#pragma unroll
          for (int w = 0; w < 8; ++w) s += RED[(w * 8 + b) * 64 + lane];
          ((float*)(ws + WS_MOD))[(size_t)(l * 8 + b) * 6144 + col] = s + a.in[5][l * 6144 + col]; }
        __syncthreads();
    }
    LAS float* scr = (LAS float*)(lds + 65536 + wid * 8448);
    const int gw = blockIdx.x * 8 + wid, NGW = gridDim.x * 8;
    constexpr int I_IN = 16 * (PW_ / 32), I_OUT = 16 * 32, I_G = 16 * (FF_ / 32), I_D = (FF_ / 64) * 32, I_L = I_IN + I_OUT + 2 * I_G + I_D;
    for (int it = gw; it < 2 * I_L; it += NGW) {
        const int l = it / I_L; int r = it % I_L;
        if (r < I_IN) { transpose_item(a.in[6] + (size_t)l * D_ * PW_, D_, PW_, (bf16_t*)(ws + WS_WIN + l * SZ_WIN), 0, scr, r, lane); continue; } r -= I_IN;
        if (r < I_OUT) { transpose_item(a.in[27] + (size_t)l * D_ * D_, D_, D_, (bf16_t*)(ws + WS_WOUT + l * SZ_WOUT), 0, scr, r, lane); continue; } r -= I_OUT;
        if (r < I_G) { transpose_item(a.in[28] + (size_t)l * D_ * FF_, D_, FF_, (bf16_t*)(ws + WS_WGU + l * SZ_WGU), 1, scr, r, lane); continue; } r -= I_G;
        if (r < I_G) { transpose_item(a.in[29] + (size_t)l * D_ * FF_, D_, FF_, (bf16_t*)(ws + WS_WGU + l * SZ_WGU), 2, scr, r, lane); continue; } r -= I_G;
        transpose_item(a.in[30] + (size_t)l * FF_ * D_, FF_, D_, (bf16_t*)(ws + WS_WD + l * SZ_WD), 0, scr, r, lane);
    }
    for (int e = blockIdx.x * 512 + tid; e < 2 * 98304; e += gridDim.x * 512) { const int l = e / 98304; int r = e % 98304; float v;
        if (r < 24576) { const int cidx = r >> 6, i = r & 63; v = a.in[17][((size_t)l * 64 + i) * 384 + cidx]; }
        else if (r < 49152) { const int r2 = r - 24576, cidx = r2 >> 6, i = r2 & 63; v = a.in[19][((size_t)l * 64 + i) * 384 + cidx]; }
        else { const int r2 = r - 49152, cidx = r2 >> 7, i = r2 & 127; v = a.in[20][((size_t)l * 128 + i) * 384 + cidx]; }
        ((bf16_t*)(ws + WS_LORA))[e] = (bf16_t)f2bf(v); }
    for (int e = blockIdx.x * 512 + tid; e < 65536; e += gridDim.x * 512) { const int i = e & 63, j = (e >> 6) & 63, gate = (e >> 12) & 1, lg = e >> 13;
        ((bf16_t*)(ws + WS_RGW))[e] = (bf16_t)f2bf(a.in[gate ? 11 : 9][((size_t)lg * 64 + i) * 64 + j]); }
    for (int i = blockIdx.x * 512 + tid; i < 2 * 16384; i += gridDim.x * 512) { const int l = i >> 14, e = i & 16383;
        *(u32x4*)(ws + WS_WIN + l * SZ_WIN + (size_t)PW_ * D_ * 2 + (size_t)e * 16) = (u32x4){0u, 0u, 0u, 0u}; }
}
__device__ __forceinline__ void phase_norm(const float* xin, const float* gain, const float* sh, const float* sc, bf16_t* H) {
    const int tid = otid(), wid = tid >> 6, lane = tid & 63, gw = blockIdx.x * 8 + wid, NGW = gridDim.x * 8;
    for (int row = gw; row < M_; row += NGW) { const int b = row >> 11;
        const f32x4* xr = (const f32x4*)(xin + (size_t)row * D_) + lane; f32x4 v[4]; float ss = 0.f;
#pragma unroll
        for (int j = 0; j < 4; ++j) { v[j] = xr[64 * j]; ss += (v[j].x * v[j].x + v[j].y * v[j].y) + (v[j].z * v[j].z + v[j].w * v[j].w); }
        const float rs = rsq_(wave_sum(ss) * (1.0f / D_) + 1e-6f);
#pragma unroll
        for (int j = 0; j < 4; ++j) { const int col = 4 * lane + 256 * j;
            const f32x4 g = *(const f32x4*)(gain + col), s1 = *(const f32x4*)(sc + (size_t)b * 6144 + col), s0 = *(const f32x4*)(sh + (size_t)b * 6144 + col);
            const f32x4 h = v[j] * rs * g * (s1 + 1.0f) + s0;
            u32x2 w; w.x = pk2(h.x, h.y); w.y = pk2(h.z, h.w); *(u32x2*)(H + (size_t)row * D_ + col) = w; }
    }
}
__device__ __forceinline__ void phase_final(float* x, const float* gain) {
    const int tid = otid(), wid = tid >> 6, lane = tid & 63, gw = blockIdx.x * 8 + wid, NGW = gridDim.x * 8;
    for (int row = gw; row < M_; row += NGW) {
        f32x4* xr = (f32x4*)(x + (size_t)row * D_) + lane; f32x4 v[4]; float ss = 0.f;
#pragma unroll
        for (int j = 0; j < 4; ++j) { v[j] = xr[64 * j]; ss += (v[j].x * v[j].x + v[j].y * v[j].y) + (v[j].z * v[j].z + v[j].w * v[j].w); }
        const float rs = rsq_(wave_sum(ss) * (1.0f / D_) + 1e-6f);
#pragma unroll
        for (int j = 0; j < 4; ++j) { const f32x4 g = *(const f32x4*)(gain + 4 * lane + 256 * j); xr[64 * j] = v[j] * rs * g; }
    }
}
#define XB_TMO      128
#define XB_XCNT(j)  (256  + 64 * (j))
#define XB_XSUB(j)  (1280 + 64 * (j))
#define XB_XGEN(j)  (2304 + 64 * (j))
#define XB_TOP      3328
#define XB_TOPGEN   3392
#define XCD_BAR_WORDS 3456
#define XB_SPIN_CAP (1u << 18)

__device__ __forceinline__ unsigned xb_ld(unsigned* p)              { return __hip_atomic_load(p, __ATOMIC_RELAXED, __HIP_MEMORY_SCOPE_AGENT); }
__device__ __forceinline__ unsigned xb_add(unsigned* p, unsigned v) { return __hip_atomic_fetch_add(p, v, __ATOMIC_RELAXED, __HIP_MEMORY_SCOPE_AGENT); }
__device__ __forceinline__ unsigned xb_xcc_id() { return (unsigned)__builtin_amdgcn_s_getreg((3 << 11) | 20) & 0xFu; }
#define XB_SPIN(cond, bar) do { unsigned _sp = 0; while (cond) { __builtin_amdgcn_s_sleep(1); \
    if ((++_sp & 255u) == 0u) { if (xb_ld(&(bar)[XB_TMO])) break; if (_sp > XB_SPIN_CAP) { atomicAdd(&(bar)[XB_TMO], 1u); break; } } } } while (0)

struct XcdBarrier {
    unsigned* bar; unsigned x;
    volatile LAS unsigned* st;
};

__device__ __forceinline__ XcdBarrier xcd_barrier_post(unsigned* bar, volatile LAS unsigned* st) {
    XcdBarrier b; b.bar = bar; b.x = xb_xcc_id(); b.st = st;
    if (threadIdx.x == 0) (void)xb_add(&bar[XB_XCNT(b.x)], 1u);
    return b;
}
__device__ __forceinline__ void xcd_barrier_complete(unsigned* bar, unsigned x, unsigned& nloc, unsigned& nx) {
    const unsigned G = gridDim.x * gridDim.y * gridDim.z;
    unsigned sum, cnt, mine, sp = 0u;
    for (;;) {
        sum = 0u; cnt = 0u; mine = 0u;
#pragma unroll
        for (unsigned j = 0; j < 16; ++j) { const unsigned c = xb_ld(&bar[XB_XCNT(j)]); sum += c; cnt += (c > 0u) ? 1u : 0u; mine = (j == x) ? c : mine; }
        if (sum == G) break;
        __builtin_amdgcn_s_sleep(1);
        if ((++sp & 255u) == 0u) { if (xb_ld(&bar[XB_TMO])) break; if (sp > XB_SPIN_CAP) { atomicAdd(&bar[XB_TMO], 1u); break; } }
    }
    nloc = mine > 0u ? mine : 1u; nx = cnt > 0u ? cnt : 1u;
}

__device__ __forceinline__ void xcd_barrier(const XcdBarrier& b) {
    asm volatile("s_waitcnt vmcnt(0)" ::: "memory");
    __syncthreads();
    if (threadIdx.x == 0) {
        unsigned* bar = b.bar;
        __builtin_amdgcn_s_waitcnt(0);
        unsigned nloc = b.st[0], nx = b.st[1];
        if (nloc == 0u) { xcd_barrier_complete(bar, b.x, nloc, nx); b.st[0] = nloc; b.st[1] = nx; }
        const unsigned old = xb_add(&bar[XB_XSUB(b.x)], 1u);
        const unsigned gen = old / nloc;
        if (old + 1u == (gen + 1u) * nloc) {
            __builtin_amdgcn_fence(__ATOMIC_RELEASE, "agent");
            asm volatile("s_waitcnt vmcnt(0)" ::: "memory");
            const unsigned og = xb_add(&bar[XB_TOP], 1u);
            const unsigned tg = og / nx;
            if (og + 1u == (tg + 1u) * nx) xb_add(&bar[XB_TOPGEN], 1u);
            else XB_SPIN(xb_ld(&bar[XB_TOPGEN]) == tg, bar);
            __builtin_amdgcn_fence(__ATOMIC_ACQUIRE, "agent");
            xb_add(&bar[XB_XGEN(b.x)], 1u);
            asm volatile("s_waitcnt vmcnt(0)" ::: "memory");
        } else {
            XB_SPIN(xb_ld(&bar[XB_XGEN(b.x)]) == gen, bar);
            __builtin_amdgcn_fence(__ATOMIC_ACQUIRE, "agent");
            asm volatile("s_waitcnt vmcnt(0)" ::: "memory");
        }
    }
    __syncthreads();
}

__device__ __forceinline__ float gelu_tanh(float x) { const float u = 0.7978845608f * (x + 0.044715f * x * x * x); const float e = __expf(2.0f * u); const float th = 1.0f - 2.0f * rcp_(e + 1.0f); return 0.5f * x * (1.0f + th); }
template <int MODE>
__device__ __forceinline__ void rg_item(const Args& a, int l, int item, int lane) {
    const int g = item & 3, c = (item >> 2) & 31, b = item >> 7, ch = 64 * g + lane, row0 = b * T_ + 64 * c;
    const bf16_t* P = (const bf16_t*)(a.ws + WS_P);
    float* AGG = (float*)(a.ws + WS_RGA);
    float Wr[64], Wi[64];
#pragma unroll
    for (int i = 0; i < 64; ++i) { Wr[i] = a.in[9][((size_t)(l * 4 + g) * 64 + i) * 64 + lane]; Wi[i] = a.in[11][((size_t)(l * 4 + g) * 64 + i) * 64 + lane]; }
    const float cw0 = a.in[7][(l * 4 + 0) * 256 + ch], cw1 = a.in[7][(l * 4 + 1) * 256 + ch], cw2 = a.in[7][(l * 4 + 2) * 256 + ch], cw3 = a.in[7][(l * 4 + 3) * 256 + ch];
    const float cb = a.in[8][l * 256 + ch], rb = a.in[10][l * 256 + ch], ib = a.in[12][l * 256 + ch], lam = a.in[13][l * 256 + ch];
    const float sp = log1pf(__expf(-lam));
    float xm3 = 0.f, xm2 = 0.f, xm1 = 0.f;
    if (c > 0) { xm3 = bf2f(P[(size_t)(row0 - 3) * PS_ + PAX + ch]); xm2 = bf2f(P[(size_t)(row0 - 2) * PS_ + PAX + ch]); xm1 = bf2f(P[(size_t)(row0 - 1) * PS_ + PAX + ch]); }
    float h = 0.f, Ap = 1.f, beta = 0.f;
    if (MODE == 1) { h = AGG[2 * 65536 + (b * 32 + c) * 256 + ch]; beta = a.in[26][l * 1024 + ch]; }
    bf16_t* Y = (bf16_t*)(a.ws + WS_HY);
    unsigned short xn[8], yn[8];
#pragma unroll
    for (int i = 0; i < 8; ++i) { xn[i] = P[(size_t)(row0 + i) * PS_ + PAX + ch]; yn[i] = (MODE == 1) ? P[(size_t)(row0 + i) * PS_ + PAY + ch] : (unsigned short)0; }
#pragma unroll 1
    for (int tg = 0; tg < 8; ++tg) {
        unsigned short xr[8], yr[8];
#pragma unroll
        for (int i = 0; i < 8; ++i) { xr[i] = xn[i]; yr[i] = yn[i]; }
        if (tg < 7) {
#pragma unroll
            for (int i = 0; i < 8; ++i) { xn[i] = P[(size_t)(row0 + 8 * tg + 8 + i) * PS_ + PAX + ch]; if (MODE == 1) yn[i] = P[(size_t)(row0 + 8 * tg + 8 + i) * PS_ + PAY + ch]; } }
#pragma unroll
        for (int i8 = 0; i8 < 8; ++i8) { const int t = 8 * tg + i8;
        const float xc = bf2f(xr[i8]);
        const float u = cb + cw0 * xm3 + cw1 * xm2 + cw2 * xm1 + cw3 * xc;
        xm3 = xm2; xm2 = xm1; xm1 = xc;
        float rp = rb, ip = ib;
#pragma unroll
        for (int i = 0; i < 64; ++i) { const float ui = __builtin_bit_cast(float, __builtin_amdgcn_readlane(__builtin_bit_cast(int, u), i)); rp += ui * Wr[i]; ip += ui * Wi[i]; }
        const float r = sigmoidf_(rp), ig = sigmoidf_(ip);
        const float log_a = -8.0f * r * sp, av = __expf(log_a);
        const float x2 = 2.0f * log_a; const float em = (x2 > -0.25f) ? -x2 * (1.0f + 0.5f * x2 * (1.0f + (1.0f / 3.0f) * x2 * (1.0f + 0.25f * x2 * (1.0f + 0.2f * x2)))) : 1.0f - __expf(x2);
        float mult = __builtin_amdgcn_sqrtf(em); if (c == 0 && t == 0) mult = 1.0f;
        const float bv = mult * ig * u;
        h = av * h + bv;
        if (MODE == 0) Ap *= av;
        else { const float ya = bf2f(yr[i8]); const float y = h * gelu_tanh(ya);
            const float ss = wave_sum(y * y); const float o = y * rsq_(ss * (1.0f / 64.0f) + 1e-6f) * beta;
            Y[(size_t)(row0 + t) * D_ + ch] = (bf16_t)f2bf(o); }
        }
    }
    if (MODE == 0) { AGG[(b * 32 + c) * 256 + ch] = Ap; AGG[65536 + (b * 32 + c) * 256 + ch] = h; }
}
__device__ __forceinline__ void rg_carry(const Args& a, int gid) {
    float* AGG = (float*)(a.ws + WS_RGA); const int b = gid >> 8, ch = gid & 255; float H = 0.f; float Av[32], Bv[32];
#pragma unroll
    for (int c = 0; c < 32; ++c) { const int i = (b * 32 + c) * 256 + ch; Av[c] = AGG[i]; Bv[c] = AGG[65536 + i]; }
#pragma unroll
    for (int c = 0; c < 32; ++c) { const int i = (b * 32 + c) * 256 + ch; AGG[2 * 65536 + i] = H; H = Av[c] * H + Bv[c]; }
}
__device__ __forceinline__ f32x4 mfma16(bf16x8 x, bf16x8 y, f32x4 c) { return __builtin_amdgcn_mfma_f32_16x16x32_bf16(x, y, c, 0, 0, 0); }
constexpr int LST = 72;
template <int MODE>
__device__ __forceinline__ void hgrn_item(const Args& a, int l, int item, LAS unsigned char* lds) {
    const int tid = otid(), wid = tid >> 6, lane = tid & 63, fr = lane & 15, fq = lane >> 4;
    const int c = item & 31, bh = item >> 5, h = bh % 6, b = bh / 6, row0 = b * T_ + 64 * c;
    const bf16_t* P = (const bf16_t*)(a.ws + WS_P);
    bf16_t* KVT = (bf16_t*)(a.ws + WS_HKV) + (size_t)item * 4096;
    LAS float* PART = (LAS float*)lds;
    LAS float* RHO = (LAS float*)(lds + 2048);
    LAS float* BC = (LAS float*)(lds + 4096);
    LAS bf16_t* L0 = (LAS bf16_t*)(lds + 20480);
    LAS bf16_t* L1 = (LAS bf16_t*)(lds + 29696);
    LAS bf16_t* L2 = (LAS bf16_t*)(lds + 38912);
    LAS bf16_t* VT = (LAS bf16_t*)(lds + 48128);
    LAS bf16_t* AM = (LAS bf16_t*)(lds + 57344);
    LAS float* SS = (LAS float*)(lds + 66560);
    const int k = lane, pt = wid;
    const float* hl = a.in[14];
    float lbv = 0.f; if (l == 1) lbv = rcp_(1.0f + __expf(hl[64 * h + k] - hl[384 + 64 * h + k]));
    float bc[8], kvv[8]; float s = 0.f;
#pragma unroll
    for (int i = 0; i < 8; ++i) { const float z = bf2f(P[(size_t)(row0 + 8 * pt + i) * PS_ + PBF + 64 * h + k]);
        const float sg = rcp_(1.0f + __expf(-z)); const float f = fmaxf(lbv + (1.0f - lbv) * sg, 1e-37f);
        s += __logf(f); bc[i] = s; kvv[i] = (1.0f - lbv) * rcp_(1.0f + __expf(z)); }
    PART[pt * 64 + k] = s;
    { unsigned short vv[8];
#pragma unroll
      for (int i = 0; i < 8; ++i) vv[i] = P[(size_t)(row0 + 8 * pt + i) * PS_ + PBV + 64 * h + k];
      u32x4 w; w.x = vv[0] | ((unsigned)vv[1] << 16); w.y = vv[2] | ((unsigned)vv[3] << 16); w.z = vv[4] | ((unsigned)vv[5] << 16); w.w = vv[6] | ((unsigned)vv[7] << 16);
      *(LAS u32x4*)(VT + k * LST + 8 * pt) = w; }
    __syncthreads();
    float off = 0.f, tot = 0.f, rho = 0.f;
#pragma unroll
    for (int p = 0; p < 8; ++p) { const float v = PART[p * 64 + k]; if (p < pt) off += v; if (p < 4) rho += v; tot += v; }
#pragma unroll
    for (int i = 0; i < 8; ++i) bc[i] += off;
    if (MODE == 0) {
        u32x4 w; float e[8];
#pragma unroll
        for (int i = 0; i < 8; ++i) e[i] = kvv[i] * __expf(tot - bc[i]);
        w.x = pk2(e[0], e[1]); w.y = pk2(e[2], e[3]); w.z = pk2(e[4], e[5]); w.w = pk2(e[6], e[7]);
        *(LAS u32x4*)(L0 + k * LST + 8 * pt) = w;
        if (pt == 0) ((float*)(a.ws + WS_HDEC))[(size_t)item * 64 + k] = __expf(tot);
        __syncthreads();
        const int kt = wid >> 1;
#pragma unroll
        for (int q = 0; q < 2; ++q) { const int vt = 2 * (wid & 1) + q; f32x4 acc = {0.f, 0.f, 0.f, 0.f};
#pragma unroll
            for (int ks = 0; ks < 2; ++ks) { const bf16x8 x = *(const LAS bf16x8*)(L0 + (16 * kt + fr) * LST + 32 * ks + 8 * fq), y = *(const LAS bf16x8*)(VT + (16 * vt + fr) * LST + 32 * ks + 8 * fq);
                acc = mfma16(x, y, acc); }
            u32x2 w2; w2.x = pk2(acc[0], acc[1]); w2.y = pk2(acc[2], acc[3]);
            *(u32x2*)(KVT + (16 * vt + fr) * 64 + 16 * kt + 4 * fq) = w2; }
        __syncthreads();
    } else {
#pragma unroll
        for (int i = 0; i < 8; ++i) BC[(8 * pt + i) * 64 + k] = bc[i];
        if (pt == 0) RHO[k] = rho;
        __syncthreads();
        { const int t2 = tid >> 3, kg = tid & 7;
          const u32x4 qw = *(const u32x4*)(P + (size_t)(row0 + t2) * PS_ + PBQ + 64 * h + 8 * kg), zw = *(const u32x4*)(P + (size_t)(row0 + t2) * PS_ + PBF + 64 * h + 8 * kg);
          float q[8], z[8], qp[8], qt[8], kt_[8];
          q[0] = bflo(qw.x); q[1] = bfhi(qw.x); q[2] = bflo(qw.y); q[3] = bfhi(qw.y); q[4] = bflo(qw.z); q[5] = bfhi(qw.z); q[6] = bflo(qw.w); q[7] = bfhi(qw.w);
          z[0] = bflo(zw.x); z[1] = bfhi(zw.x); z[2] = bflo(zw.y); z[3] = bfhi(zw.y); z[4] = bflo(zw.z); z[5] = bfhi(zw.z); z[6] = bflo(zw.w); z[7] = bfhi(zw.w);
#pragma unroll
          for (int i = 0; i < 8; ++i) { const int kk = 8 * kg + i; float lb2 = 0.f; if (l == 1) lb2 = rcp_(1.0f + __expf(hl[64 * h + kk] - hl[384 + 64 * h + kk]));
              const float kvl = (1.0f - lb2) * rcp_(1.0f + __expf(z[i])); const float bcv = BC[t2 * 64 + kk], rh = RHO[kk]; const float qs = q[i] * 0.125f;
              qp[i] = qs * __expf(bcv); qt[i] = qs * __expf(bcv - rh); kt_[i] = kvl * __expf(rh - bcv); }
          u32x4 w; w.x = pk2(qp[0], qp[1]); w.y = pk2(qp[2], qp[3]); w.z = pk2(qp[4], qp[5]); w.w = pk2(qp[6], qp[7]); *(LAS u32x4*)(L0 + t2 * LST + 8 * kg) = w;
          w.x = pk2(qt[0], qt[1]); w.y = pk2(qt[2], qt[3]); w.z = pk2(qt[4], qt[5]); w.w = pk2(qt[6], qt[7]); *(LAS u32x4*)(L1 + t2 * LST + 8 * kg) = w;
          w.x = pk2(kt_[0], kt_[1]); w.y = pk2(kt_[2], kt_[3]); w.z = pk2(kt_[4], kt_[5]); w.w = pk2(kt_[6], kt_[7]); *(LAS u32x4*)(L2 + t2 * LST + 8 * kg) = w; }
        __syncthreads();
        const int tt = wid >> 1;
#pragma unroll
        for (int q = 0; q < 2; ++q) { const int st = 2 * (wid & 1) + q; f32x4 acc = {0.f, 0.f, 0.f, 0.f};
            if (st <= tt) {
#pragma unroll
                for (int ks = 0; ks < 2; ++ks) { const bf16x8 x = *(const LAS bf16x8*)(L2 + (16 * st + fr) * LST + 32 * ks + 8 * fq), y = *(const LAS bf16x8*)(L1 + (16 * tt + fr) * LST + 32 * ks + 8 * fq);
                    acc = mfma16(x, y, acc); }
                const int t = 16 * tt + fr;
#pragma unroll
                for (int j = 0; j < 4; ++j) { const int sidx = 16 * st + 4 * fq + j; if (sidx > t) acc[j] = 0.f; }
            }
            u32x2 w2; w2.x = pk2(acc[0], acc[1]); w2.y = pk2(acc[2], acc[3]);
            *(LAS u32x2*)(AM + (16 * tt + fr) * LST + 16 * st + 4 * fq) = w2; }
        __syncthreads();
        f32x4 o[2]; float ss = 0.f;
#pragma unroll
        for (int q = 0; q < 2; ++q) { const int vt = 2 * (wid & 1) + q; f32x4 acc = {0.f, 0.f, 0.f, 0.f};
#pragma unroll
            for (int ks = 0; ks < 2; ++ks) { const bf16x8 x = *(const bf16x8*)(KVT + (16 * vt + fr) * 64 + 32 * ks + 8 * fq), y = *(const LAS bf16x8*)(L0 + (16 * tt + fr) * LST + 32 * ks + 8 * fq);
                acc = mfma16(x, y, acc); }
#pragma unroll
            for (int ks = 0; ks < 2; ++ks) { const bf16x8 x = *(const LAS bf16x8*)(VT + (16 * vt + fr) * LST + 32 * ks + 8 * fq), y = *(const LAS bf16x8*)(AM + (16 * tt + fr) * LST + 32 * ks + 8 * fq);
                acc = mfma16(x, y, acc); }
            o[q] = acc; ss += (acc[0] * acc[0] + acc[1] * acc[1]) + (acc[2] * acc[2] + acc[3] * acc[3]); }
        ss += __shfl_xor(ss, 16); ss += __shfl_xor(ss, 32);
        if (fq == 0) SS[wid * 16 + fr] = ss;
        __syncthreads();
        const float tot2 = SS[wid * 16 + fr] + SS[(wid ^ 1) * 16 + fr];
        const float rs = rsq_(tot2 * (1.0f / 64.0f) + 1e-6f);
        bf16_t* Y = (bf16_t*)(a.ws + WS_HY);
#pragma unroll
        for (int q = 0; q < 2; ++q) { const int vt = 2 * (wid & 1) + q, t = 16 * tt + fr, cv = 64 * h + 16 * vt + 4 * fq;
            const u32x2 gw2 = *(const u32x2*)(P + (size_t)(row0 + t) * PS_ + PBG + cv);
            const f32x4 be = *(const f32x4*)(a.in[26] + l * 1024 + 256 + cv);
            float gg[4] = {bflo(gw2.x), bfhi(gw2.x), bflo(gw2.y), bfhi(gw2.y)}; float r[4];
#pragma unroll
            for (int j = 0; j < 4; ++j) r[j] = o[q][j] * rs * (gg[j] * sigmoidf_(gg[j])) * be[j];
            u32x2 w2; w2.x = pk2(r[0], r[1]); w2.y = pk2(r[2], r[3]);
            *(u32x2*)(Y + (size_t)(row0 + t) * D_ + 256 + cv) = w2; }
        __syncthreads();
    }
}
__device__ __forceinline__ void hgrn_scan(const Args& a, int e) {
    bf16_t* KVT = (bf16_t*)(a.ws + WS_HKV); const float* DEC = (const float*)(a.ws + WS_HDEC);
    const int bh = e >> 12, vk = e & 4095, k = vk & 63; float S = 0.f; unsigned short kv[32]; float dc[32];
#pragma unroll
    for (int c = 0; c < 32; ++c) { kv[c] = KVT[((size_t)(bh * 32 + c) << 12) + vk]; dc[c] = DEC[(bh * 32 + c) * 64 + k]; }
#pragma unroll
    for (int c = 0; c < 32; ++c) { KVT[((size_t)(bh * 32 + c) << 12) + vk] = (bf16_t)f2bf(S); S = dc[c] * S + bf2f(kv[c]); }
}
__device__ __forceinline__ f32x4 mfma16k16(s16x4 x, s16x4 y, f32x4 c) { return __builtin_amdgcn_mfma_f32_16x16x16bf16_1k(x, y, c, 0, 0, 0); }
__device__ __forceinline__ s16x4 pack4(f32x4 v) { u32x2 w; w.x = pk2(v[0], v[1]); w.y = pk2(v[2], v[3]); return __builtin_bit_cast(s16x4, w); }
__device__ __forceinline__ void unpack8(const u32x4 w, float* o) { o[0] = bflo(w.x); o[1] = bfhi(w.x); o[2] = bflo(w.y); o[3] = bfhi(w.y); o[4] = bflo(w.z); o[5] = bfhi(w.z); o[6] = bflo(w.w); o[7] = bfhi(w.w); }
__device__ __forceinline__ u32x4 pack8(const float* e) { u32x4 w; w.x = pk2(e[0], e[1]); w.y = pk2(e[2], e[3]); w.z = pk2(e[4], e[5]); w.w = pk2(e[6], e[7]); return w; }
__device__ __forceinline__ void shift8(const bf16_t* P, size_t row, bool has_prev, int col, const float* mu, float* o) {
    const u32x4 cw = *(const u32x4*)(P + row * PS_ + PC + col); u32x4 pw = {0u, 0u, 0u, 0u}; if (has_prev) pw = *(const u32x4*)(P + (row - 1) * PS_ + PC + col);
    float c[8], p[8]; unpack8(cw, c); unpack8(pw, p); const f32x4 m0 = *(const f32x4*)(mu + col), m1 = *(const f32x4*)(mu + col + 4);
#pragma unroll
    for (int i = 0; i < 8; ++i) o[i] = c[i] + (p[i] - c[i]) * (i < 4 ? m0[i] : m1[i - 4]);
}
constexpr int RW_LIN = 0, RW_LINS = 264;
constexpr int RW_RH = 52224, RW_YL = 61440, RW_YLS = 68;
constexpr int RW_CUM = 33792, RW_PART = 50176;
constexpr int RW_LO = 52224, RW_LOS = 68;
constexpr int RW_AT = 52224, RW_BD = 61440, RW_KD = 70656, RW_RT = 79872, RW_BTT = 89088, RW_KTT = 98304, RW_VT = 107520, RW_NAB = 116736, RW_AK = 125952;
constexpr int RW_ARB = RW_BTT, RW_ARK = RW_KTT;
constexpr int RW_NABF = 135168, RW_TII = 139264;
template <int MODE>
__device__ __forceinline__ void rwkv_chunk(const Args& a, int l, int bc, LAS unsigned char* lds) {
    const int tid = otid(), wid = tid >> 6, lane = tid & 63, fr = lane & 15, fq = lane >> 4;
    const int c = bc & 31, b = bc >> 5;
    const size_t row0 = (size_t)b * T_ + 64 * c;
    const bf16_t* P = (const bf16_t*)(a.ws + WS_P);
    const bf16_t* LW = (const bf16_t*)(a.ws + WS_LORA) + (size_t)l * 98304;
    const float* mu = a.in[15] + l * 1408;
    LAS bf16_t* LIN = (LAS bf16_t*)(lds + RW_LIN);
    LAS float* CUM = (LAS float*)(lds + RW_CUM); LAS float* PART = (LAS float*)(lds + RW_PART); LAS float* LO = (LAS float*)(lds + RW_LO);
    LAS bf16_t* AT = (LAS bf16_t*)(lds + RW_AT); LAS bf16_t* BD = (LAS bf16_t*)(lds + RW_BD); LAS bf16_t* KD = (LAS bf16_t*)(lds + RW_KD); LAS bf16_t* RT = (LAS bf16_t*)(lds + RW_RT);
    LAS bf16_t* BTT = (LAS bf16_t*)(lds + RW_BTT); LAS bf16_t* KTT = (LAS bf16_t*)(lds + RW_KTT); LAS bf16_t* VT = (LAS bf16_t*)(lds + RW_VT);
    LAS bf16_t* NAB = (LAS bf16_t*)(lds + RW_NAB); LAS bf16_t* AK = (LAS bf16_t*)(lds + RW_AK); LAS bf16_t* ARB = (LAS bf16_t*)(lds + RW_ARB); LAS bf16_t* ARK = (LAS bf16_t*)(lds + RW_ARK);
    LAS float* NABF = (LAS float*)(lds + RW_NABF); LAS bf16_t* TII = (LAS bf16_t*)(lds + RW_TII);
    const int t2 = tid >> 3, kg = tid & 7; const size_t row = row0 + t2; const bool has_prev = (c > 0) || (t2 > 0);
    { const float cA = (kg < 2) ? 2.0f : 1.0f, cC = (kg < 2) ? -1.0f : 0.0f; const bool ident = (kg == 2 || kg == 3);
#pragma unroll
        for (int q = 0; q < 4; ++q) { float ps[8]; const int col = 32 * kg + 8 * q; shift8(P, row, has_prev, 1152 + col, mu, ps);
#pragma unroll
            for (int i = 0; i < 8; ++i) { const float sg = cA * rcp_(1.0f + __expf(-cA * ps[i])) + cC; ps[i] = ident ? ps[i] : sg; }
            *(LAS u32x4*)(LIN + t2 * RW_LINS + col) = pack8(ps); }
    }
#pragma unroll 1
    for (int h = 0; h < 6; ++h) {
    const int item = ((b * 6 + h) << 5) + c;
    float rr[8], kx[8], vx[8];
    shift8(P, row, has_prev, 64 * h + 8 * kg, mu, rr); shift8(P, row, has_prev, 384 + 64 * h + 8 * kg, mu, kx); shift8(P, row, has_prev, 768 + 64 * h + 8 * kg, mu, vx);
    __syncthreads();
    { const int tt = wid >> 1;
#pragma unroll
      for (int q = 0; q < 2; ++q) { const int ct = 2 * (wid & 1) + q; const int crow = 64 * h + 16 * ct + fr;
          f32x4 aw = {0.f, 0.f, 0.f, 0.f}, aa = {0.f, 0.f, 0.f, 0.f}, ag = {0.f, 0.f, 0.f, 0.f};
#pragma unroll
          for (int ks = 0; ks < 2; ++ks) { const bf16x8 x = *(const LAS bf16x8*)(LIN + (16 * tt + fr) * RW_LINS + 32 * ks + 8 * fq), y = *(const bf16x8*)(LW + (size_t)crow * 64 + 32 * ks + 8 * fq); aw = mfma16(x, y, aw); }
#pragma unroll
          for (int ks = 0; ks < 2; ++ks) { const bf16x8 x = *(const LAS bf16x8*)(LIN + (16 * tt + fr) * RW_LINS + 64 + 32 * ks + 8 * fq), y = *(const bf16x8*)(LW + 24576 + (size_t)crow * 64 + 32 * ks + 8 * fq); aa = mfma16(x, y, aa); }
#pragma unroll
          for (int ks = 0; ks < 4; ++ks) { const bf16x8 x = *(const LAS bf16x8*)(LIN + (16 * tt + fr) * RW_LINS + 128 + 32 * ks + 8 * fq), y = *(const bf16x8*)(LW + 49152 + (size_t)crow * 128 + 32 * ks + 8 * fq); ag = mfma16(x, y, ag); }
#pragma unroll
          for (int j = 0; j < 4; ++j) { const int o = (16 * tt + 4 * fq + j) * RW_LOS + 16 * ct + fr; LO[o] = aw[j]; LO[64 * RW_LOS + o] = aa[j]; LO[2 * 64 * RW_LOS + o] = ag[j]; } }
    }
    __syncthreads();
    float gg[8], lw[8], be[8], al[8], kp[8]; float rkt = 0.f;
    { const int cb = l * 384 + 64 * h + 8 * kg; float wa[8], av[8];
      *(f32x4*)&wa[0] = *(const LAS f32x4*)(LO + t2 * RW_LOS + 8 * kg); *(f32x4*)&wa[4] = *(const LAS f32x4*)(LO + t2 * RW_LOS + 8 * kg + 4);
      *(f32x4*)&av[0] = *(const LAS f32x4*)(LO + 64 * RW_LOS + t2 * RW_LOS + 8 * kg); *(f32x4*)&av[4] = *(const LAS f32x4*)(LO + 64 * RW_LOS + t2 * RW_LOS + 8 * kg + 4);
      *(f32x4*)&gg[0] = *(const LAS f32x4*)(LO + 128 * RW_LOS + t2 * RW_LOS + 8 * kg); *(f32x4*)&gg[4] = *(const LAS f32x4*)(LO + 128 * RW_LOS + t2 * RW_LOS + 8 * kg + 4);
      float ssq = 0.f, kkr[8]; float p_w0[8], p_a0[8], p_kk[8], p_ka[8], p_rk[8];
      *(f32x4*)&p_w0[0] = *(const f32x4*)(a.in[16] + cb); *(f32x4*)&p_w0[4] = *(const f32x4*)(a.in[16] + cb + 4);
      *(f32x4*)&p_a0[0] = *(const f32x4*)(a.in[18] + cb); *(f32x4*)&p_a0[4] = *(const f32x4*)(a.in[18] + cb + 4);
      *(f32x4*)&p_kk[0] = *(const f32x4*)(a.in[21] + cb); *(f32x4*)&p_kk[4] = *(const f32x4*)(a.in[21] + cb + 4);
      *(f32x4*)&p_ka[0] = *(const f32x4*)(a.in[22] + cb); *(f32x4*)&p_ka[4] = *(const f32x4*)(a.in[22] + cb + 4);
      *(f32x4*)&p_rk[0] = *(const f32x4*)(a.in[23] + cb); *(f32x4*)&p_rk[4] = *(const f32x4*)(a.in[23] + cb + 4);
#pragma unroll
      for (int i = 0; i < 8; ++i) { const float wp = wa[i] + p_w0[i]; const float w = -__logf(1.0f + __expf(-wp)) - 0.5f; lw[i] = -__expf(w);
          const float aa = sigmoidf_(av[i] + p_a0[i]);
          kkr[i] = kx[i] * p_kk[i]; ssq += kkr[i] * kkr[i];
          kp[i] = kx[i] * (1.0f + (aa - 1.0f) * p_ka[i]); be[i] = aa;
          rkt += rr[i] * kp[i] * p_rk[i]; }
      ssq += __shfl_xor(ssq, 1); ssq += __shfl_xor(ssq, 2); ssq += __shfl_xor(ssq, 4);
      rkt += __shfl_xor(rkt, 1); rkt += __shfl_xor(rkt, 2); rkt += __shfl_xor(rkt, 4);
      const float rn = rsq_(ssq + 1e-12f);
#pragma unroll
      for (int i = 0; i < 8; ++i) { const float kk = kkr[i] * rn; al[i] = -kk; be[i] = kk * be[i]; }
#pragma unroll
      for (int i = 0; i < 8; ++i) CUM[t2 * 64 + 8 * kg + i] = lw[i];
    }
    __syncthreads();
    { const int k = lane, pt = wid; float s = 0.f; float cv[8];
#pragma unroll
      for (int i = 0; i < 8; ++i) { s += CUM[(8 * pt + i) * 64 + k]; cv[i] = s; }
      PART[pt * 64 + k] = s;
      __syncthreads();
      float off = 0.f;
#pragma unroll
      for (int p = 0; p < 8; ++p) { const float v = PART[p * 64 + k]; if (p < pt) off += v; }
#pragma unroll
      for (int i = 0; i < 8; ++i) CUM[(8 * pt + i) * 64 + k] = cv[i] + off;
    }
    __syncthreads();
    { float cu[8], cl[8], e[8];
      *(f32x4*)&cu[0] = *(const LAS f32x4*)(CUM + t2 * 64 + 8 * kg); *(f32x4*)&cu[4] = *(const LAS f32x4*)(CUM + t2 * 64 + 8 * kg + 4);
      *(f32x4*)&cl[0] = *(const LAS f32x4*)(CUM + 63 * 64 + 8 * kg); *(f32x4*)&cl[4] = *(const LAS f32x4*)(CUM + 63 * 64 + 8 * kg + 4);
#pragma unroll
      for (int i = 0; i < 8; ++i) e[i] = al[i] * __expf(cu[i] - lw[i]);
      *(LAS u32x4*)(AT + t2 * LST + 8 * kg) = pack8(e);
      float en[8];
#pragma unroll
      for (int i = 0; i < 8; ++i) en[i] = __expf(-cu[i]);
#pragma unroll
      for (int i = 0; i < 8; ++i) e[i] = be[i] * en[i];
      *(LAS u32x4*)(BD + t2 * LST + 8 * kg) = pack8(e);
#pragma unroll
      for (int i = 0; i < 8; ++i) e[i] = kp[i] * en[i];
      *(LAS u32x4*)(KD + t2 * LST + 8 * kg) = pack8(e);
      if (MODE == 1) {
#pragma unroll
          for (int i = 0; i < 8; ++i) e[i] = rr[i] * __expf(cu[i]);
          *(LAS u32x4*)(RT + t2 * LST + 8 * kg) = pack8(e);
      } else {
#pragma unroll
          for (int i = 0; i < 8; ++i) { const float ed = __expf(cl[i] - cu[i]); BTT[(8 * kg + i) * LST + t2] = (bf16_t)f2bf(be[i] * ed); KTT[(8 * kg + i) * LST + t2] = (bf16_t)f2bf(kp[i] * ed); }
          if (t2 == 63) {
#pragma unroll
              for (int i = 0; i < 8; ++i) ((float*)(a.ws + WS_RGAM))[(size_t)item * 64 + 8 * kg + i] = __expf(cl[i]); }
      }
#pragma unroll
      for (int i = 0; i < 8; ++i) VT[(8 * kg + i) * LST + t2] = (bf16_t)f2bf(vx[i]);
    }
    __syncthreads();
    { const int tt = wid >> 1;
#pragma unroll
      for (int q = 0; q < 2; ++q) { const int st = 2 * (wid & 1) + q;
          f32x4 ab = {0.f, 0.f, 0.f, 0.f}, ak = {0.f, 0.f, 0.f, 0.f}, rb = {0.f, 0.f, 0.f, 0.f}, rk = {0.f, 0.f, 0.f, 0.f};
          if (st <= tt) {
#pragma unroll
              for (int ks = 0; ks < 2; ++ks) { const int ao = (16 * st + fr) * LST + 32 * ks + 8 * fq, bo = (16 * tt + fr) * LST + 32 * ks + 8 * fq;
                  const bf16x8 xb = *(const LAS bf16x8*)(BD + ao), xk = *(const LAS bf16x8*)(KD + ao), ya = *(const LAS bf16x8*)(AT + bo);
                  ab = mfma16(xb, ya, ab); ak = mfma16(xk, ya, ak);
                  if (MODE == 1) { const bf16x8 yr = *(const LAS bf16x8*)(RT + bo); rb = mfma16(xb, yr, rb); rk = mfma16(xk, yr, rk); } }
              const int t = 16 * tt + fr;
#pragma unroll
              for (int j = 0; j < 4; ++j) { const int s = 16 * st + 4 * fq + j; if (s >= t) { ab[j] = 0.f; ak[j] = 0.f; } if (s > t) { rb[j] = 0.f; rk[j] = 0.f; } }
              if (st == tt) *(LAS f32x4*)(NABF + tt * 256 + fr * 16 + 4 * fq) = ab;
          }
          const int o = (16 * tt + fr) * LST + 16 * st + 4 * fq;
          *(LAS s16x4*)(NAB + o) = pack4(ab); *(LAS s16x4*)(AK + o) = pack4(ak);
          if (MODE == 1) { *(LAS s16x4*)(ARB + o) = pack4(rb); *(LAS s16x4*)(ARK + o) = pack4(rk); } }
    }
    __syncthreads();
    f32x4 R[4];
    if (wid == 0) { const int blk = fq, j = fr; float Tc[16];
#pragma unroll
        for (int i = 0; i < 16; ++i) { float acc = (i == j) ? 1.0f : 0.0f;
#pragma unroll
            for (int m = 0; m < 16; ++m) if (m < i) acc += NABF[blk * 256 + i * 16 + m] * Tc[m];
            Tc[i] = acc; TII[blk * 256 + i * 16 + j] = (bf16_t)f2bf(acc); }
    }
    if (wid >= 4) { const int vt = wid - 4;
#pragma unroll
        for (int I = 0; I < 4; ++I) { f32x4 acc = {0.f, 0.f, 0.f, 0.f};
#pragma unroll
            for (int ks = 0; ks < 2; ++ks) { const bf16x8 x = *(const LAS bf16x8*)(AK + (16 * I + fr) * LST + 32 * ks + 8 * fq), y = *(const LAS bf16x8*)(VT + (16 * vt + fr) * LST + 32 * ks + 8 * fq); acc = mfma16(x, y, acc); }
            R[I] = acc; }
    } else {
#pragma unroll
        for (int I = 0; I < 4; ++I)
#pragma unroll
            for (int j = 0; j < 4; ++j) R[I][j] = bf2f(AT[(16 * I + 4 * fq + j) * LST + 16 * wid + fr]);
    }
    __syncthreads();
    s16x4 Xb[4];
#pragma unroll
    for (int I = 0; I < 4; ++I) { f32x4 acc = R[I];
#pragma unroll
        for (int J = 0; J < 4; ++J) if (J < I) acc = mfma16k16(*(const LAS s16x4*)(NAB + (16 * I + fr) * LST + 16 * J + 4 * fq), Xb[J], acc);
        const f32x4 z = {0.f, 0.f, 0.f, 0.f};
        const f32x4 x = mfma16k16(*(const LAS s16x4*)(TII + I * 256 + fr * 16 + 4 * fq), pack4(acc), z);
        Xb[I] = pack4(x); }
    s16x4 Vf[4];
    if (wid >= 4) {
#pragma unroll
        for (int J = 0; J < 4; ++J) Vf[J] = *(const LAS s16x4*)(VT + (16 * (wid - 4) + fr) * LST + 16 * J + 4 * fq); }
    if (MODE == 0) {
#pragma unroll
        for (int kt = 0; kt < 4; ++kt) { f32x4 acc = {0.f, 0.f, 0.f, 0.f};
#pragma unroll
            for (int J = 0; J < 4; ++J) acc = mfma16k16(*(const LAS s16x4*)(BTT + (16 * kt + fr) * LST + 16 * J + 4 * fq), Xb[J], acc);
            if (wid >= 4) {
#pragma unroll
                for (int J = 0; J < 4; ++J) acc = mfma16k16(*(const LAS s16x4*)(KTT + (16 * kt + fr) * LST + 16 * J + 4 * fq), Vf[J], acc);
                *(s16x4*)((bf16_t*)(a.ws + WS_RN) + (size_t)item * 4096 + ((kt * 4 + (wid - 4)) * 64 + lane) * 4) = pack4(acc);
            } else { bf16_t* RM = (bf16_t*)(a.ws + WS_RM) + (size_t)item * 4096;
#pragma unroll
                for (int j = 0; j < 4; ++j) RM[(16 * kt + 4 * fq + j) * 64 + 16 * wid + fr] = (bf16_t)f2bf(acc[j]); } }
        __syncthreads();
    } else {
        LAS bf16_t* RH = (LAS bf16_t*)(lds + RW_RH); LAS float* YL = (LAS float*)(lds + RW_YL);
        f32x4 yh[4];
#pragma unroll
        for (int tt = 0; tt < 4; ++tt) { f32x4 acc = {0.f, 0.f, 0.f, 0.f};
            if (wid < 4) {
#pragma unroll
                for (int j = 0; j < 4; ++j) acc[j] = bf2f(RT[(16 * tt + 4 * fq + j) * LST + 16 * wid + fr]); }
#pragma unroll
            for (int J = 0; J < 4; ++J) if (J <= tt) acc = mfma16k16(*(const LAS s16x4*)(ARB + (16 * tt + fr) * LST + 16 * J + 4 * fq), Xb[J], acc);
            if (wid >= 4) {
#pragma unroll
                for (int J = 0; J < 4; ++J) if (J <= tt) acc = mfma16k16(*(const LAS s16x4*)(ARK + (16 * tt + fr) * LST + 16 * J + 4 * fq), Vf[J], acc);
                yh[tt] = acc;
            } else {
#pragma unroll
                for (int j = 0; j < 4; ++j) RH[(16 * tt + 4 * fq + j) * LST + 16 * wid + fr] = (bf16_t)f2bf(acc[j]); } }
        __syncthreads();
        if (wid >= 4) { const int vt = wid - 4; s16x4 S0[4];
#pragma unroll
            for (int kt = 0; kt < 4; ++kt) S0[kt] = *(const s16x4*)((const bf16_t*)(a.ws + WS_RN) + (size_t)item * 4096 + ((kt * 4 + vt) * 64 + lane) * 4);
#pragma unroll
            for (int tt = 0; tt < 4; ++tt) { f32x4 acc = yh[tt];
#pragma unroll
                for (int kt = 0; kt < 4; ++kt) acc = mfma16k16(*(const LAS s16x4*)(RH + (16 * tt + fr) * LST + 16 * kt + 4 * fq), S0[kt], acc);
#pragma unroll
                for (int j = 0; j < 4; ++j) YL[(16 * tt + 4 * fq + j) * RW_YLS + 16 * vt + fr] = acc[j]; } }
        __syncthreads();
        { const int cb = l * 384 + 64 * h + 8 * kg; float y[8];
          *(f32x4*)&y[0] = *(const LAS f32x4*)(YL + t2 * RW_YLS + 8 * kg); *(f32x4*)&y[4] = *(const LAS f32x4*)(YL + t2 * RW_YLS + 8 * kg + 4);
          float sm = 0.f;
#pragma unroll
          for (int i = 0; i < 8; ++i) sm += y[i];
          sm += __shfl_xor(sm, 1); sm += __shfl_xor(sm, 2); sm += __shfl_xor(sm, 4);
          const float mean = sm * (1.0f / 64.0f); float vr = 0.f;
#pragma unroll
          for (int i = 0; i < 8; ++i) { y[i] -= mean; vr += y[i] * y[i]; }
          vr += __shfl_xor(vr, 1); vr += __shfl_xor(vr, 2); vr += __shfl_xor(vr, 4);
          const float rs = rsq_(vr * (1.0f / 64.0f) + 64e-5f); float o[8]; float p_lw[8], p_lb[8], p_be[8];
          *(f32x4*)&p_lw[0] = *(const f32x4*)(a.in[24] + cb); *(f32x4*)&p_lw[4] = *(const f32x4*)(a.in[24] + cb + 4);
          *(f32x4*)&p_lb[0] = *(const f32x4*)(a.in[25] + cb); *(f32x4*)&p_lb[4] = *(const f32x4*)(a.in[25] + cb + 4);
          *(f32x4*)&p_be[0] = *(const f32x4*)(a.in[26] + l * 1024 + 640 + 64 * h + 8 * kg); *(f32x4*)&p_be[4] = *(const f32x4*)(a.in[26] + l * 1024 + 640 + 64 * h + 8 * kg + 4);
#pragma unroll
          for (int i = 0; i < 8; ++i) o[i] = ((y[i] * rs * p_lw[i] + p_lb[i]) + rkt * vx[i]) * gg[i] * p_be[i];
          *(u32x4*)((bf16_t*)(a.ws + WS_HY) + row * D_ + 640 + 64 * h + 8 * kg) = pack8(o); }
        __syncthreads();
    }
    }
}
__device__ __forceinline__ void rwkv_scan(const Args& a, int bh, int vt, int lane) {
    const int fr = lane & 15, fq = lane >> 4;
    const bf16_t* RM = (const bf16_t*)(a.ws + WS_RM); bf16_t* RN = (bf16_t*)(a.ws + WS_RN); const float* GAM = (const float*)(a.ws + WS_RGAM);
    f32x4 S[4];
#pragma unroll
    for (int k = 0; k < 4; ++k) S[k] = (f32x4){0.f, 0.f, 0.f, 0.f};
    s16x4 Mn[4][4]; s16x4 Nn[4]; f32x4 gn[4];
#define RWS_LOAD(cc) { const size_t it_ = (size_t)bh * 32 + (cc); _Pragma("unroll") for (int kt = 0; kt < 4; ++kt) { _Pragma("unroll") for (int k2 = 0; k2 < 4; ++k2) Mn[kt][k2] = *(const s16x4*)(RM + it_ * 4096 + (16 * kt + fr) * 64 + 16 * k2 + 4 * fq); \
            Nn[kt] = *(const s16x4*)(RN + it_ * 4096 + ((kt * 4 + vt) * 64 + lane) * 4); gn[kt] = *(const f32x4*)(GAM + it_ * 64 + 16 * kt + 4 * fq); } }
    RWS_LOAD(0)
#pragma unroll 1
    for (int c = 0; c < 32; ++c) { const size_t item = (size_t)bh * 32 + c;
        s16x4 Mf[4][4]; s16x4 Nf[4]; f32x4 gam[4];
#pragma unroll
        for (int kt = 0; kt < 4; ++kt) { Nf[kt] = Nn[kt]; gam[kt] = gn[kt];
#pragma unroll
            for (int k2 = 0; k2 < 4; ++k2) Mf[kt][k2] = Mn[kt][k2]; }
        if (c < 31) RWS_LOAD(c + 1)
        s16x4 Sb[4];
#pragma unroll
        for (int k = 0; k < 4; ++k) { Sb[k] = pack4(S[k]); *(s16x4*)(RN + item * 4096 + ((k * 4 + vt) * 64 + lane) * 4) = Sb[k]; }
#pragma unroll
        for (int kt = 0; kt < 4; ++kt) { const u32x2 nw = __builtin_bit_cast(u32x2, Nf[kt]);
            f32x4 acc = gam[kt] * S[kt] + (f32x4){bflo(nw.x), bfhi(nw.x), bflo(nw.y), bfhi(nw.y)};
#pragma unroll
            for (int k2 = 0; k2 < 4; ++k2) acc = mfma16k16(Mf[kt][k2], Sb[k2], acc);
            S[kt] = acc; }
    }
#undef RWS_LOAD
}
constexpr int RG_US = 264;
constexpr int RG_U = 0, RG_LA = 33792, RG_LB = 67584, RG_AG = 101376;
constexpr int RG_YS = 260, RG_YB = 0, RG_AG1 = 66560;
__device__ __forceinline__ float rg_em(float x2) { return (x2 > -0.25f) ? -x2 * (1.0f + 0.5f * x2 * (1.0f + (1.0f / 3.0f) * x2 * (1.0f + 0.25f * x2 * (1.0f + 0.2f * x2)))) : 1.0f - __expf(x2); }
__device__ __forceinline__ void rg2_mode0(const Args& a, int l, int item, LAS unsigned char* lds) {
    const int tid = otid(), wid = tid >> 6, lane = tid & 63, fr = lane & 15, fq = lane >> 4;
    const int c = item & 31, b = item >> 5; const size_t row0 = (size_t)b * T_ + 64 * c;
    const bf16_t* P = (const bf16_t*)(a.ws + WS_P);
    LAS bf16_t* U = (LAS bf16_t*)(lds + RG_U); LAS bf16_t* LA = (LAS bf16_t*)(lds + RG_LA); LAS bf16_t* LB = (LAS bf16_t*)(lds + RG_LB); LAS float* AG = (LAS float*)(lds + RG_AG);
    const int ch = tid & 255, hf = tid >> 8, t0 = 32 * hf;
    { const float cw0 = a.in[7][(l * 4 + 0) * 256 + ch], cw1 = a.in[7][(l * 4 + 1) * 256 + ch], cw2 = a.in[7][(l * 4 + 2) * 256 + ch], cw3 = a.in[7][(l * 4 + 3) * 256 + ch], cb = a.in[8][l * 256 + ch];
      float xm3 = 0.f, xm2 = 0.f, xm1 = 0.f;
      if (c > 0 || hf > 0) { xm3 = bf2f(P[(row0 + t0 - 3) * PS_ + PAX + ch]); xm2 = bf2f(P[(row0 + t0 - 2) * PS_ + PAX + ch]); xm1 = bf2f(P[(row0 + t0 - 1) * PS_ + PAX + ch]); }
      unsigned short xr[32];
#pragma unroll
      for (int i = 0; i < 32; ++i) xr[i] = P[(row0 + t0 + i) * PS_ + PAX + ch];
#pragma unroll
      for (int i = 0; i < 32; ++i) { const float xc = bf2f(xr[i]); const float u = cb + cw0 * xm3 + cw1 * xm2 + cw2 * xm1 + cw3 * xc; xm3 = xm2; xm2 = xm1; xm1 = xc;
          U[(t0 + i) * RG_US + ch] = (bf16_t)f2bf(u); } }
    __syncthreads();
    { const int g = wid >> 1; const bf16_t* WT = (const bf16_t*)(a.ws + WS_RGW) + (size_t)(l * 4 + g) * 2 * 4096;
#pragma unroll
      for (int q = 0; q < 2; ++q) { const int tt = 2 * (wid & 1) + q;
          bf16x8 ua[2];
#pragma unroll
          for (int ks = 0; ks < 2; ++ks) ua[ks] = *(const LAS bf16x8*)(U + (16 * tt + fr) * RG_US + 64 * g + 32 * ks + 8 * fq);
#pragma unroll
          for (int jt = 0; jt < 4; ++jt) { f32x4 ar = {0.f, 0.f, 0.f, 0.f}, ai = {0.f, 0.f, 0.f, 0.f};
#pragma unroll
              for (int ks = 0; ks < 2; ++ks) { const bf16x8 wr = *(const bf16x8*)(WT + (16 * jt + fr) * 64 + 32 * ks + 8 * fq), wi = *(const bf16x8*)(WT + 4096 + (16 * jt + fr) * 64 + 32 * ks + 8 * fq);
                  ar = mfma16(ua[ks], wr, ar); ai = mfma16(ua[ks], wi, ai); }
              const int chj = 64 * g + 16 * jt + fr;
              const float rb = a.in[10][l * 256 + chj], ib = a.in[12][l * 256 + chj], sp8 = -8.0f * __logf(1.0f + __expf(-a.in[13][l * 256 + chj]));
#pragma unroll
              for (int j = 0; j < 4; ++j) { const int t = 16 * tt + 4 * fq + j;
                  const float r = sigmoidf_(ar[j] + rb), ig = sigmoidf_(ai[j] + ib);
                  const float log_a = bf2f((unsigned short)f2bf(r * sp8));
                  float mult = __builtin_amdgcn_sqrtf(rg_em(2.0f * log_a)); if (c == 0 && t == 0) mult = 1.0f;
                  const float u = bf2f(U[t * RG_US + chj]);
                  LA[t * RG_US + chj] = (bf16_t)f2bf(log_a); LB[t * RG_US + chj] = (bf16_t)f2bf(mult * ig * u); } } }
    }
    __syncthreads();
    { bf16_t* GLA = (bf16_t*)(a.ws + WS_RGL); bf16_t* GLB = (bf16_t*)(a.ws + WS_RGB);
      float h = 0.f, sl = 0.f;
#pragma unroll 8
      for (int i = 0; i < 32; ++i) { const unsigned short la = LA[(t0 + i) * RG_US + ch], lb = LB[(t0 + i) * RG_US + ch];
          GLA[(row0 + t0 + i) * 256 + ch] = la; GLB[(row0 + t0 + i) * 256 + ch] = lb;
          const float lg = bf2f(la); sl += lg; h = __expf(lg) * h + bf2f(lb); }
      AG[(hf * 256 + ch) * 2] = sl; AG[(hf * 256 + ch) * 2 + 1] = h;
      __syncthreads();
      if (hf == 0) { const float s1 = AG[(256 + ch) * 2], h1 = AG[(256 + ch) * 2 + 1]; float* AGG = (float*)(a.ws + WS_RGA);
          AGG[(b * 32 + c) * 256 + ch] = __expf(sl + s1); AGG[65536 + (b * 32 + c) * 256 + ch] = __expf(s1) * h + h1; } }
    __syncthreads();
}
__device__ __forceinline__ void rg2_mode1(const Args& a, int l, int item, LAS unsigned char* lds) {
    const int tid = otid();
    const int c = item & 31, b = item >> 5; const size_t row0 = (size_t)b * T_ + 64 * c;
    const bf16_t* P = (const bf16_t*)(a.ws + WS_P); const bf16_t* GLA = (const bf16_t*)(a.ws + WS_RGL); const bf16_t* GLB = (const bf16_t*)(a.ws + WS_RGB);
    LAS float* YB = (LAS float*)(lds + RG_YB); LAS float* AG = (LAS float*)(lds + RG_AG1);
    const int ch = tid & 255, hf = tid >> 8, t0 = 32 * hf;
    unsigned short la[32], lb[32], ya[32];
#pragma unroll
    for (int i = 0; i < 32; ++i) { la[i] = GLA[(row0 + t0 + i) * 256 + ch]; lb[i] = GLB[(row0 + t0 + i) * 256 + ch]; ya[i] = P[(row0 + t0 + i) * PS_ + PAY + ch]; }
    const float carry = ((const float*)(a.ws + WS_RGA))[2 * 65536 + (b * 32 + c) * 256 + ch];
    float av[32];
    { float h = 0.f, sl = 0.f;
#pragma unroll
      for (int i = 0; i < 32; ++i) { const float lg = bf2f(la[i]); sl += lg; av[i] = __expf(lg); h = av[i] * h + bf2f(lb[i]); }
      if (hf == 0) { AG[ch * 2] = sl; AG[ch * 2 + 1] = h; } }
    __syncthreads();
    { float h = carry; if (hf == 1) h = __expf(AG[ch * 2]) * carry + AG[ch * 2 + 1];
#pragma unroll
      for (int i = 0; i < 32; ++i) { h = av[i] * h + bf2f(lb[i]); YB[(t0 + i) * RG_YS + ch] = h * gelu_tanh(bf2f(ya[i])); } }
    __syncthreads();
    { const int t = tid >> 3, gs = tid & 7, cbase = 32 * gs; float y[32]; float ss = 0.f;
#pragma unroll
      for (int q = 0; q < 8; ++q) { *(f32x4*)&y[4 * q] = *(const LAS f32x4*)(YB + t * RG_YS + cbase + 4 * q); }
#pragma unroll
      for (int i = 0; i < 32; ++i) ss += y[i] * y[i];
      ss += __shfl_xor(ss, 1);
      const float rs = rsq_(ss * (1.0f / 64.0f) + 1e-6f);
      bf16_t* Y = (bf16_t*)(a.ws + WS_HY) + (row0 + t) * D_ + cbase; const float* be = a.in[26] + l * 1024 + cbase;
#pragma unroll
      for (int q = 0; q < 4; ++q) { float o[8]; const f32x4 b0 = *(const f32x4*)(be + 8 * q), b1 = *(const f32x4*)(be + 8 * q + 4);
#pragma unroll
          for (int i = 0; i < 8; ++i) o[i] = y[8 * q + i] * rs * (i < 4 ? b0[i] : b1[i - 4]);
          *(u32x4*)(Y + 8 * q) = pack8(o); } }
    __syncthreads();
}
__device__ __forceinline__ float shiftmix(const bf16_t* P, size_t row, int tglob, int col, float mu) {
    const float cur = bf2f(P[row * PS_ + PC + col]); const float prev = (tglob > 0) ? bf2f(P[(row - 1) * PS_ + PC + col]) : 0.f; return cur + (prev - cur) * mu; }
__device__ __forceinline__ void rwkv_seq(const Args& a, int l, int bh, LAS unsigned char* lds) {
    const int tid = otid(), wid = tid >> 6, lane = tid & 63, h = bh % 6, b = bh / 6;
    const bf16_t* P = (const bf16_t*)(a.ws + WS_P); bf16_t* Y = (bf16_t*)(a.ws + WS_HY);
    LAS float* LIN = (LAS float*)lds;
    LAS float* VEC = (LAS float*)(lds + 32768);
    LAS float* YL = (LAS float*)(lds + 90112);
    const float* mu = a.in[15] + l * 1408;
    float S[64];
#pragma unroll
    for (int k = 0; k < 64; ++k) S[k] = 0.f;
    const int t = tid >> 4, jg = tid & 15;
#pragma unroll 1
    for (int tb = 0; tb < T_; tb += 32) {
        const size_t row = (size_t)b * T_ + tb + t; const int tglob = tb + t;
#pragma unroll 4
        for (int i = 0; i < 16; ++i) { const int col = 16 * jg + i; const float ps = shiftmix(P, row, tglob, 1152 + col, mu[1152 + col]);
            float v; if (col < 64) { const float e = __expf(2.0f * ps); v = 1.0f - 2.0f / (e + 1.0f); } else if (col < 128) v = ps; else v = sigmoidf_(ps);
            LIN[t * 256 + col] = v; }
        __syncthreads();
        { const int cb = l * 384 + 64 * h + 4 * jg;
          f32x4 wacc = *(const f32x4*)(a.in[16] + cb), aacc = *(const f32x4*)(a.in[18] + cb), gacc = {0.f, 0.f, 0.f, 0.f};
          const float* wu = a.in[17] + (size_t)l * 64 * 384 + 64 * h + 4 * jg; const float* au = a.in[19] + (size_t)l * 64 * 384 + 64 * h + 4 * jg; const float* gu = a.in[20] + (size_t)l * 128 * 384 + 64 * h + 4 * jg;
#pragma unroll 4
          for (int i = 0; i < 64; ++i) { const float x = LIN[t * 256 + i]; wacc += x * *(const f32x4*)(wu + (size_t)i * 384); }
#pragma unroll 4
          for (int i = 0; i < 64; ++i) { const float x = LIN[t * 256 + 64 + i]; aacc += x * *(const f32x4*)(au + (size_t)i * 384); }
#pragma unroll 4
          for (int i = 0; i < 128; ++i) { const float x = LIN[t * 256 + 128 + i]; gacc += x * *(const f32x4*)(gu + (size_t)i * 384); }
          float kk[4], kp[4], aa[4], dec[4], rr[4], vv[4]; float ssq = 0.f;
#pragma unroll
          for (int j = 0; j < 4; ++j) { const int hc = 64 * h + 4 * jg + j;
              const float wp = wacc[j]; const float w = -log1pf(__expf(-wp)) - 0.5f; dec[j] = __expf(-__expf(w));
              aa[j] = sigmoidf_(aacc[j]);
              rr[j] = shiftmix(P, row, tglob, hc, mu[hc]); const float kx = shiftmix(P, row, tglob, 384 + hc, mu[384 + hc]); vv[j] = shiftmix(P, row, tglob, 768 + hc, mu[768 + hc]);
              kk[j] = kx * a.in[21][l * 384 + hc]; ssq += kk[j] * kk[j];
              kp[j] = kx * (1.0f + (aa[j] - 1.0f) * a.in[22][l * 384 + hc]); }
          ssq += __shfl_xor(ssq, 1); ssq += __shfl_xor(ssq, 2); ssq += __shfl_xor(ssq, 4); ssq += __shfl_xor(ssq, 8);
          const float rn = 1.0f / sqrtf(ssq + 1e-12f);
#pragma unroll
          for (int j = 0; j < 4; ++j) { const int jj = 4 * jg + j; const float kn = kk[j] * rn;
              VEC[(t * 7 + 0) * 64 + jj] = kn; VEC[(t * 7 + 1) * 64 + jj] = dec[j]; VEC[(t * 7 + 2) * 64 + jj] = kp[j]; VEC[(t * 7 + 3) * 64 + jj] = kn * aa[j];
              VEC[(t * 7 + 4) * 64 + jj] = rr[j]; VEC[(t * 7 + 5) * 64 + jj] = vv[j]; VEC[(t * 7 + 6) * 64 + jj] = gacc[j]; } }
        __syncthreads();
        if (wid == 0) {
#pragma unroll 1
            for (int ts = 0; ts < 32; ++ts) { const LAS f32x4* V4 = (const LAS f32x4*)(VEC + ts * 7 * 64);
                const float vv = VEC[(ts * 7 + 5) * 64 + lane]; float sa = 0.f;
#pragma unroll
                for (int k4 = 0; k4 < 16; ++k4) { const f32x4 q = V4[k4]; sa += S[4 * k4] * q.x; sa += S[4 * k4 + 1] * q.y; sa += S[4 * k4 + 2] * q.z; sa += S[4 * k4 + 3] * q.w; }
                sa = -sa; float y = 0.f;
#pragma unroll
                for (int k4 = 0; k4 < 16; ++k4) { const f32x4 w = V4[16 + k4], kp = V4[32 + k4], ka = V4[48 + k4], r = V4[64 + k4];
                    S[4 * k4] = S[4 * k4] * w.x + sa * ka.x + vv * kp.x; S[4 * k4 + 1] = S[4 * k4 + 1] * w.y + sa * ka.y + vv * kp.y;
                    S[4 * k4 + 2] = S[4 * k4 + 2] * w.z + sa * ka.z + vv * kp.z; S[4 * k4 + 3] = S[4 * k4 + 3] * w.w + sa * ka.w + vv * kp.w;
                    y += S[4 * k4] * r.x; y += S[4 * k4 + 1] * r.y; y += S[4 * k4 + 2] * r.z; y += S[4 * k4 + 3] * r.w; }
                YL[ts * 64 + lane] = y; }
        }
        __syncthreads();
        { const int cb = l * 384 + 64 * h + 4 * jg; const f32x4 y4 = *(const LAS f32x4*)(YL + t * 64 + 4 * jg);
          float sm = (y4.x + y4.y) + (y4.z + y4.w); sm += __shfl_xor(sm, 1); sm += __shfl_xor(sm, 2); sm += __shfl_xor(sm, 4); sm += __shfl_xor(sm, 8);
          const float mean = sm * (1.0f / 64.0f); const f32x4 d = y4 - mean;
          float vr = (d.x * d.x + d.y * d.y) + (d.z * d.z + d.w * d.w); vr += __shfl_xor(vr, 1); vr += __shfl_xor(vr, 2); vr += __shfl_xor(vr, 4); vr += __shfl_xor(vr, 8);
          const float rs = 1.0f / sqrtf(vr * (1.0f / 64.0f) + 64e-5f);
          const f32x4 rk = *(const f32x4*)(a.in[23] + cb), lw = *(const f32x4*)(a.in[24] + cb), lb = *(const f32x4*)(a.in[25] + cb), be = *(const f32x4*)(a.in[26] + l * 1024 + 640 + 64 * h + 4 * jg);
          float bs = 0.f; float r4[4], v4[4], g4[4];
#pragma unroll
          for (int j = 0; j < 4; ++j) { const int jj = 4 * jg + j; r4[j] = VEC[(t * 7 + 4) * 64 + jj]; v4[j] = VEC[(t * 7 + 5) * 64 + jj]; g4[j] = VEC[(t * 7 + 6) * 64 + jj]; bs += r4[j] * VEC[(t * 7 + 2) * 64 + jj] * rk[j]; }
          bs += __shfl_xor(bs, 1); bs += __shfl_xor(bs, 2); bs += __shfl_xor(bs, 4); bs += __shfl_xor(bs, 8);
          float o[4];
#pragma unroll
          for (int j = 0; j < 4; ++j) o[j] = ((d[j] * rs * lw[j] + lb[j]) + bs * v4[j]) * g4[j] * be[j];
          u32x2 w2; w2.x = pk2(o[0], o[1]); w2.y = pk2(o[2], o[3]);
          *(u32x2*)(Y + row * D_ + 640 + 64 * h + 4 * jg) = w2; }
        __syncthreads();
    }
}
__global__ void __launch_bounds__(512, 2) mk_fwd(Args a) {
    extern __shared__ __attribute__((aligned(16))) unsigned char shm[];
    LAS unsigned char* lds = (LAS unsigned char*)shm;
    cg::grid_group grid = cg::this_grid();
    if (a.ph_hi > 1000) grid.sync();
    { volatile LAS unsigned* stw = (volatile LAS unsigned*)(lds + LDS_BYTES - 16); if (threadIdx.x < 4) stw[threadIdx.x] = 0u; }
    __syncthreads();
    XcdBarrier xb = xcd_barrier_post((unsigned*)(a.ws + WS_BAR), (volatile LAS unsigned*)(lds + LDS_BYTES - 16));
    const int tid = otid(), wid = tid >> 6, lane = tid & 63, G = gridDim.x;
    unsigned char* ws = a.ws;
    bf16_t* Pb = (bf16_t*)(ws + WS_P); bf16_t* HY = (bf16_t*)(ws + WS_HY); float* MOD = (float*)(ws + WS_MOD);
#ifdef MK_PROBE
    unsigned long long t_prev = __builtin_amdgcn_s_memrealtime(), t_acc = 0;
#define PH_STAMP(n) { grid.sync(); const unsigned long long t_now = __builtin_amdgcn_s_memrealtime(); if ((MK_PROBE >> (n)) & 1) t_acc += t_now - t_prev; t_prev = t_now; }
#else
#define PH_STAMP(n)
#endif
#ifndef MK_SUB
#define MK_SUB 0
#endif
#ifndef MK_REP
#define MK_REP 0
#endif
#define PH_BEGIN(n) if (a.ph_lo <= (n) && (n) < a.ph_hi) { const int ph_cur = (n); (void)ph_cur; if ((n) > a.ph_lo) xcd_barrier(xb); for (int rep_ = 0; rep_ < (((MK_REP >> (n)) & 1) ? 2 : 1); ++rep_) {
#define PH_END } PH_STAMP(ph_cur) }
    PH_BEGIN(0) phase_pro(a, lds); PH_END
#pragma unroll
    for (int l = 0; l < 2; ++l) {
        const int p0 = 1 + 9 * l;
        const float* xin = (l == 0) ? a.in[0] : a.out;
        const float* modl = MOD + (size_t)l * 8 * 6144;
        PH_BEGIN(p0 + 0) phase_norm(xin, a.in[2] + l * D_, modl + 0, modl + 1024, HY); PH_END
        PH_BEGIN(p0 + 1) { pg8::Gemm g{HY, (const bf16_t*)(ws + WS_WIN + l * SZ_WIN), M_, PS_, D_}; pg8::StaticOrder S; S.init(M_, PS_, G, blockIdx.x); EpiP E{Pb, PS_};
                  pg8::gemm_phase<EpiP, pg8::StaticOrder>(lds, g, S, E, nullptr); } PH_END
        PH_BEGIN(p0 + 2) { for (int r_ = 0; r_ < ((MK_SUB & 1) ? 2 : 1); ++r_) for (int it = blockIdx.x; it < 1536; it += G) hgrn_item<0>(a, l, it, lds);
                  for (int r_ = 0; r_ < ((MK_SUB & 2) ? 2 : 1); ++r_) for (int it = blockIdx.x; it < 256; it += G) rwkv_chunk<0>(a, l, it, lds);
                  for (int r_ = 0; r_ < ((MK_SUB & 4) ? 2 : 1); ++r_) for (int it = blockIdx.x; it < 256; it += G) rg2_mode0(a, l, it, lds); } PH_END
        PH_BEGIN(p0 + 3) { const int t3 = otid();
                  if (t3 < 64) { if ((int)blockIdx.x < 192) rwkv_scan(a, blockIdx.x >> 2, blockIdx.x & 3, t3); }
                  else { for (int e = blockIdx.x * 448 + (t3 - 64); e < 48 * 4096; e += G * 448) hgrn_scan(a, e);
                         for (int e = blockIdx.x * 448 + (t3 - 64); e < 2048; e += G * 448) rg_carry(a, e); } } PH_END
        PH_BEGIN(p0 + 4) { for (int r_ = 0; r_ < ((MK_SUB & 1) ? 2 : 1); ++r_) for (int it = blockIdx.x; it < 1536; it += G) hgrn_item<1>(a, l, it, lds);
                  for (int r_ = 0; r_ < ((MK_SUB & 2) ? 2 : 1); ++r_) for (int it = blockIdx.x; it < 256; it += G) rwkv_chunk<1>(a, l, it, lds);
                  for (int r_ = 0; r_ < ((MK_SUB & 4) ? 2 : 1); ++r_) for (int it = blockIdx.x; it < 256; it += G) rg2_mode1(a, l, it, lds); } PH_END
        PH_BEGIN(p0 + 5) { pg8::Gemm g{HY, (const bf16_t*)(ws + WS_WOUT + l * SZ_WOUT), M_, D_, D_}; pg8::StaticOrder S; S.init(M_, D_, G, blockIdx.x); EpiRes E{xin, a.out, modl + 2048};
                  pg8::gemm_phase<EpiRes, pg8::StaticOrder>(lds, g, S, E, nullptr); } PH_END
        PH_BEGIN(p0 + 6) phase_norm(a.out, a.in[3] + l * D_, modl + 3072, modl + 4096, HY); PH_END
        PH_BEGIN(p0 + 7) { pg8::Gemm g{HY, (const bf16_t*)(ws + WS_WGU + l * SZ_WGU), M_, NGU_, D_}; pg8::StaticOrder S; S.init(M_, NGU_, G, blockIdx.x); EpiSwi E{Pb};
                  pg8::gemm_phase<EpiSwi, pg8::StaticOrder>(lds, g, S, E, nullptr); } PH_END
        PH_BEGIN(p0 + 8) { pg8::Gemm g{Pb, (const bf16_t*)(ws + WS_WD + l * SZ_WD), M_, D_, FF_}; pg8::StaticOrder S; S.init(M_, D_, G, blockIdx.x); EpiRes E{a.out, a.out, modl + 5120};
                  pg8::gemm_phase<EpiRes, pg8::StaticOrder>(lds, g, S, E, nullptr); } PH_END
    }
    PH_BEGIN(19) phase_final(a.out, a.in[31]); PH_END
#ifdef MK_PROBE
    if (blockIdx.x == 0 && threadIdx.x == 0) a.out[0] = (float)t_acc * 0.01f;
#endif
}
#ifndef MK_MULTI
#define MK_MULTI 0
#endif
extern "C" void kernel_launch(void* const* d_in, const int* in_sizes, int n_in, void* d_out, int out_size, void* d_ws, size_t ws_size, hipStream_t stream) {
    static int grid = 0;
    if (!grid) {
        if (n_in != 32 || ws_size < WS_END) { fprintf(stderr, "kernel_launch: bad args n_in %d ws %zu need %zu\n", n_in, ws_size, (size_t)WS_END); return; }
        hipFuncSetAttribute((const void*)mk_fwd, hipFuncAttributeMaxDynamicSharedMemorySize, LDS_BYTES);
        int dev = 0, cus = 0, per_cu = 0; hipGetDevice(&dev); hipDeviceGetAttribute(&cus, hipDeviceAttributeMultiprocessorCount, dev);
        hipOccupancyMaxActiveBlocksPerMultiprocessor(&per_cu, mk_fwd, 512, LDS_BYTES);
        if (per_cu < 1) { fprintf(stderr, "kernel_launch: occupancy 0\n"); per_cu = 1; }
        grid = cus;
    }
    Args a{}; for (int i = 0; i < 32; ++i) a.in[i] = (const float*)d_in[i];
    a.out = (float*)d_out; a.ws = (unsigned char*)d_ws;
#if MK_MULTI
    for (int ph = 0; ph < 20; ++ph) { a.ph_lo = ph; a.ph_hi = ph + 1; hipLaunchKernelGGL(mk_fwd, dim3(grid), dim3(512), LDS_BYTES, stream, a); }
#else
    a.ph_lo = 0; a.ph_hi = 20; void* args[] = {&a};
    if (hipMemsetAsync((char*)d_ws + WS_BAR, 0, XCD_BAR_WORDS * 4, stream) != hipSuccess) { fprintf(stderr, "memset failed\n"); return; }
    hipError_t e = hipLaunchCooperativeKernel((const void*)mk_fwd, dim3(grid), dim3(512), args, LDS_BYTES, stream);
    if (e != hipSuccess) fprintf(stderr, "cooperative launch failed: %s (grid %d)\n", hipGetErrorString(e), grid);
#endif
}
```

```cpp
#include <hip/hip_runtime.h>
#include <hip/hip_cooperative_groups.h>
#include <cstdio>
#include <cstdint>
namespace cg = cooperative_groups;
__device__ __forceinline__ int otid() { int t = threadIdx.x; asm volatile("" : "+v"(t)); return t; }
namespace pg8 {
#define PG8_LAS __attribute__((address_space(3)))
typedef unsigned short bf16_t;
typedef short bf16x8 __attribute__((ext_vector_type(8)));
typedef float f32x4 __attribute__((ext_vector_type(4)));
typedef unsigned u32x4 __attribute__((ext_vector_type(4)));
constexpr int BM = 256, BK = 64, HALF = 128, HTB = HALF * BK * 2  , STAGE_BYTES = 8 * HTB, NXCD = 8, WGM = 8;

__host__ __device__ __forceinline__ int lds_byte(int r, int c) { const int st = (r >> 4) * 2 + (c >> 5), rr = r & 15, cc = c & 31, ob = rr * 64 + cc * 2; return st * 1024 + (ob ^ (((ob >> 9) & 1) << 5)); }
__host__ __device__ __forceinline__ void stage_rc(int b, int& R, int& C) { const int st = b / 1024, sb = b % 1024, swz = sb ^ (((sb >> 9) & 1) << 5); R = (st >> 1) * 16 + swz / 64; C = (st & 1) * 32 + (swz % 64) / 2; }
__host__ __device__ __forceinline__ int perm32(int rho) { const int n = rho >> 4, i = rho & 15; return 8 * (i >> 2) + 4 * n + (i & 3); }

struct Unit { int pm, pn; };
struct Gemm { const bf16_t* A; const bf16_t* Bt; int M, N, K; };

struct StaticOrder {
    int nM, nN, nwg, G, c;
    __host__ __device__ void init(int M, int N, int G_, int c_) { nM = M / BM; nN = N / BM; nwg = nM * nN; G = G_; c = c_; }
    __host__ __device__ bool next(int i, Unit& u) const {
        const long L = (long)i * G + c; if (L >= nwg) return false;
        int wgid = (int)L; { const int q = nwg / NXCD, r = nwg % NXCD, xcd = wgid % NXCD, off = wgid / NXCD; wgid = (xcd < r ? xcd * (q + 1) : r * (q + 1) + (xcd - r) * q) + off; }
        const int nig = WGM * nN, gid = wgid / nig, fm = gid * WGM, gsz = (nM - fm) < WGM ? (nM - fm) : WGM;
        u.pm = fm + ((wgid % nig) % gsz); u.pn = (wgid % nig) / gsz; return true;
    }
    __device__ __forceinline__ void a_ready(const Unit&) const {}
    __device__ __forceinline__ void done(const Unit&) const {}
};
__device__ __forceinline__ unsigned cvt_pk_bf16(float lo, float hi) { unsigned r; asm volatile("v_cvt_pk_bf16_f32 %0, %1, %2" : "=v"(r) : "v"(lo), "v"(hi)); return r; }
template <class Epi, class Sched, bool STAMP = false>
__device__ __forceinline__ void gemm_phase(PG8_LAS unsigned char* lds, const Gemm g, const Sched& S, const Epi& E, unsigned long long* stamps) {
    const int tid = otid(), wid = __builtin_amdgcn_readfirstlane(tid >> 6), lane = tid & 63, wr = wid >> 2, wc = wid & 3, fr = lane & 15, fq = lane >> 4;
    const int K = g.K, nt = K / BK;
    unsigned voffA[2], voffB[2];
#pragma unroll
    for (int i = 0; i < 2; ++i) { int R, C; stage_rc(tid * 16 + i * 8192, R, C); const int Rb = Epi::PERM ? ((R & ~31) + perm32(R & 31)) : R;
        voffA[i] = (unsigned)(R * K + C) * 2u; voffB[i] = (unsigned)(Rb * K + C) * 2u; }
    const size_t kstep = (size_t)(BK * 2);
    const size_t hstep = (size_t)HALF * K * 2;
    const size_t tstep = 2 * hstep;
    const unsigned ldsw = (unsigned)wid * 1024u;
    const int aoff = lds_byte(wr * 64 + fr, fq * 8), boff = lds_byte(wc * 32 + fr, fq * 8);
#define PG8_SA(b, h) (((b) * 2 + (h)) * HTB)
#define PG8_SB(b, h) ((4 + (b) * 2 + (h)) * HTB)
#define PG8_STAGE(bufoff, gbase, voff) do { _Pragma("unroll") for (int _i = 0; _i < 2; ++_i) \
        __builtin_amdgcn_global_load_lds((const unsigned*)((const char*)(gbase) + (voff)[_i]), (PG8_LAS unsigned*)(lds + (bufoff) + ldsw + _i * 8192), 16, 0, 0); } while (0)
#define PG8_LDA(dst, b, h) do { _Pragma("unroll") for (int m = 0; m < 4; ++m) _Pragma("unroll") for (int k = 0; k < 2; ++k) dst[m][k] = *(const PG8_LAS bf16x8*)(lds + PG8_SA(b, h) + aoff + m * 2048 + k * 1024); } while (0)
#define PG8_LDB(dst, b, h) do { _Pragma("unroll") for (int n = 0; n < 2; ++n) _Pragma("unroll") for (int k = 0; k < 2; ++k) dst[n][k] = *(const PG8_LAS bf16x8*)(lds + PG8_SB(b, h) + boff + n * 2048 + k * 1024); } while (0)
#define PG8_MMA(ai, bj, At, Bt) do { __builtin_amdgcn_s_setprio(1); _Pragma("unroll") for (int m = 0; m < 4; ++m) _Pragma("unroll") for (int n = 0; n < 2; ++n) _Pragma("unroll") for (int k = 0; k < 2; ++k) \
        acc[ai][bj][m][n] = __builtin_amdgcn_mfma_f32_16x16x32_bf16(Bt[n][k], At[m][k], acc[ai][bj][m][n], 0, 0, 0); __builtin_amdgcn_s_setprio(0); } while (0)
#define PG8_WAIT_V(n) asm volatile("s_waitcnt vmcnt(" #n ")" ::: "memory")
#define PG8_WAIT_L(n) asm volatile("s_waitcnt lgkmcnt(" #n ")" ::: "memory")
#define PG8_BAR __builtin_amdgcn_s_barrier()
#define PG8_SCHED __builtin_amdgcn_sched_barrier(0)
    Unit cur, nxt; int ui = 0;
    if (!S.next(0, cur)) return;
    f32x4 acc[2][2][4][2];
#pragma unroll
    for (int a = 0; a < 2; ++a)
#pragma unroll
        for (int b = 0; b < 2; ++b)
#pragma unroll
            for (int m = 0; m < 4; ++m)
#pragma unroll
                for (int n = 0; n < 2; ++n) acc[a][b][m][n] = (f32x4){0.f, 0.f, 0.f, 0.f};
    bf16x8 At[4][2], B0[2][2], B1[2][2];
    const char* cA = (const char*)g.A + (size_t)cur.pm * tstep; const char* cB = (const char*)g.Bt + (size_t)cur.pn * tstep;
    S.a_ready(cur);
    PG8_STAGE(PG8_SB(0, 0), cB, voffB); PG8_STAGE(PG8_SA(0, 0), cA, voffA); PG8_STAGE(PG8_SB(0, 1), cB + hstep, voffB); PG8_STAGE(PG8_SA(0, 1), cA + hstep, voffA);
    if (wr == 1) PG8_BAR;
    PG8_WAIT_V(4); PG8_BAR;
    PG8_STAGE(PG8_SB(1, 0), cB + kstep, voffB); PG8_STAGE(PG8_SA(1, 0), cA + kstep, voffA); PG8_STAGE(PG8_SB(1, 1), cB + hstep + kstep, voffB);
    PG8_WAIT_V(6); PG8_BAR;
    for (;;) {
        const bool has_next = S.next(ui + 1, nxt);
        const char* nA = has_next ? (const char*)g.A + (size_t)nxt.pm * tstep : cA; const char* nB = has_next ? (const char*)g.Bt + (size_t)nxt.pn * tstep : cB;
        for (int t = 0; t < nt; t += 2) {
            const bool last = (t == nt - 2);
            const char* a1 = cA + (size_t)(t + 1) * kstep;
            const char* a2 = last ? nA : cA + (size_t)(t + 2) * kstep; const char* b2 = last ? nB : cB + (size_t)(t + 2) * kstep;
            const char* a3 = a2 + kstep; const char* b3 = b2 + kstep;
            if (last && has_next) S.a_ready(nxt);
            PG8_LDB(B0, 0, 0); PG8_SCHED; PG8_LDA(At, 0, 0); PG8_STAGE(PG8_SA(1, 1), a1 + hstep, voffA);
            PG8_WAIT_L(8); PG8_BAR; PG8_WAIT_L(0); PG8_MMA(0, 0, At, B0); PG8_BAR; PG8_SCHED;
            PG8_LDB(B1, 0, 1); PG8_STAGE(PG8_SB(0, 0), b2, voffB);
            PG8_BAR; PG8_WAIT_L(0); PG8_MMA(0, 1, At, B1); PG8_BAR;
            PG8_LDA(At, 0, 1); PG8_STAGE(PG8_SA(0, 0), a2, voffA);
            PG8_BAR; PG8_WAIT_L(0); PG8_MMA(1, 0, At, B0); PG8_BAR; PG8_SCHED;
            PG8_STAGE(PG8_SB(0, 1), b2 + hstep, voffB);
            PG8_WAIT_V(6); PG8_BAR; PG8_MMA(1, 1, At, B1); PG8_BAR;
            PG8_LDB(B0, 1, 0); PG8_SCHED; PG8_LDA(At, 1, 0); PG8_STAGE(PG8_SA(0, 1), a2 + hstep, voffA);
            PG8_WAIT_L(8); PG8_BAR; PG8_WAIT_L(0); PG8_MMA(0, 0, At, B0); PG8_BAR; PG8_SCHED;
            PG8_LDB(B1, 1, 1); PG8_STAGE(PG8_SB(1, 0), b3, voffB);
            PG8_BAR; PG8_WAIT_L(0); PG8_MMA(0, 1, At, B1); PG8_BAR;
            PG8_LDA(At, 1, 1); PG8_STAGE(PG8_SA(1, 0), a3, voffA);
            PG8_BAR; PG8_WAIT_L(0); PG8_MMA(1, 0, At, B0); PG8_BAR; PG8_SCHED;
            PG8_STAGE(PG8_SB(1, 1), b3 + hstep, voffB);
            PG8_WAIT_V(6); PG8_BAR; PG8_MMA(1, 1, At, B1); PG8_BAR;
        }
        if constexpr (!Epi::AFTER_DRAIN) { E(acc, cur, wr, wc, fr, fq); S.done(cur); }
        if (!has_next) break;
#pragma unroll
        for (int a = 0; a < 2; ++a)
#pragma unroll
            for (int b = 0; b < 2; ++b)
#pragma unroll
                for (int m = 0; m < 4; ++m)
#pragma unroll
                    for (int n = 0; n < 2; ++n) acc[a][b][m][n] = (f32x4){0.f, 0.f, 0.f, 0.f};
        cur = nxt; cA = nA; cB = nB; ++ui;
    }
    PG8_WAIT_V(0);
    if (wr == 0) PG8_BAR;
    PG8_BAR;
    if constexpr (Epi::AFTER_DRAIN) { E.fused(acc, cur, wr, wc, fr, fq, lds, wid, lane); S.done(cur); }
#undef PG8_SA
#undef PG8_SB
#undef PG8_STAGE
#undef PG8_LDA
#undef PG8_LDB
#undef PG8_MMA
#undef PG8_WAIT_V
#undef PG8_WAIT_L
#undef PG8_BAR
#undef PG8_SCHED
}
}
using pg8::bf16_t; using pg8::bf16x8; using pg8::f32x4; using pg8::u32x4;
#define LAS __attribute__((address_space(3)))
typedef float f32x2 __attribute__((ext_vector_type(2)));
typedef unsigned u32x2 __attribute__((ext_vector_type(2)));
typedef short s16x4 __attribute__((ext_vector_type(4)));

constexpr int M_ = 16384, D_ = 1024, T_ = 2048, NB_ = 8, PS_ = 3584, PW_ = 3456, FF_ = 2816, NGU_ = 5632;
constexpr int PAX = 0, PAY = 256, PBQ = 512, PBF = 896, PBV = 1280, PBG = 1664, PC = 2048;
constexpr int LDS_BYTES = 144 * 1024;
constexpr size_t SZ_WIN = (size_t)PS_ * D_ * 2, SZ_WOUT = (size_t)D_ * D_ * 2, SZ_WGU = (size_t)NGU_ * D_ * 2, SZ_WD = (size_t)D_ * FF_ * 2;
constexpr size_t WS_WIN = 0, WS_WOUT = WS_WIN + 2 * SZ_WIN, WS_WGU = WS_WOUT + 2 * SZ_WOUT, WS_WD = WS_WGU + 2 * SZ_WGU;
constexpr size_t WS_MOD = WS_WD + 2 * SZ_WD;
constexpr size_t WS_P = WS_MOD + 2 * 8 * 6144 * 4;
constexpr size_t WS_HY = WS_P + (size_t)M_ * PS_ * 2;
constexpr size_t WS_RGA = WS_HY + (size_t)M_ * D_ * 2;
constexpr size_t WS_HKV = WS_RGA + 3 * 8 * 32 * 256 * 4;
constexpr size_t WS_HDEC = WS_HKV + (size_t)1536 * 4096 * 2;
constexpr size_t WS_RM = WS_HDEC + (size_t)1536 * 64 * 4;
constexpr size_t WS_RN = WS_RM + (size_t)1536 * 4096 * 2;
constexpr size_t WS_RGAM = WS_RN + (size_t)1536 * 4096 * 2;
constexpr size_t WS_LORA = WS_RGAM + (size_t)1536 * 64 * 4;
constexpr size_t WS_RGW = WS_LORA + (size_t)2 * 98304 * 2;
constexpr size_t WS_RGL = WS_RGW + 65536 * 2;
constexpr size_t WS_RGB = WS_RGL + (size_t)M_ * 256 * 2;
constexpr size_t WS_BAR = WS_RGB + (size_t)M_ * 256 * 2;
constexpr size_t WS_END = WS_BAR + 16384;

struct Args { const float* in[32]; float* out; unsigned char* ws; int ph_lo, ph_hi; };

typedef __bf16 bf16n2 __attribute__((ext_vector_type(2)));
__device__ __forceinline__ unsigned pk2(float lo, float hi) { bf16n2 v; v.x = (__bf16)lo; v.y = (__bf16)hi; return __builtin_bit_cast(unsigned, v); }
__device__ __forceinline__ unsigned f2bf(float f) { return pk2(f, f) & 0xffffu; }
__device__ __forceinline__ float bf2f(unsigned short b) { return __builtin_bit_cast(float, ((unsigned)b) << 16); }
__device__ __forceinline__ float bflo(unsigned w) { return __builtin_bit_cast(float, w << 16); }
__device__ __forceinline__ float bfhi(unsigned w) { return __builtin_bit_cast(float, w & 0xffff0000u); }
__device__ __forceinline__ float wave_sum(float v) {
#pragma unroll
    for (int o = 1; o < 64; o <<= 1) v += __shfl_xor(v, o);
    return v;
}
__device__ __forceinline__ float rcp_(float x) { return __builtin_amdgcn_rcpf(x); }
__device__ __forceinline__ float rsq_(float x) { return __builtin_amdgcn_rsqf(x); }
__device__ __forceinline__ float sigmoidf_(float x) { return rcp_(1.0f + __expf(-x)); }
#define LDS_WAIT() asm volatile("s_waitcnt lgkmcnt(0)" ::: "memory")

struct EpiP {
    static constexpr bool PERM = true, AFTER_DRAIN = false;
    bf16_t* O; int ldc;
    __device__ __forceinline__ void operator()(const f32x4 (&acc)[2][2][4][2], const pg8::Unit& u, int wr, int wc, int fr, int fq) const {
        const int row0 = u.pm * 256 + wr * 64 + fr, col0 = u.pn * 256 + wc * 32 + 8 * fq;
#pragma unroll
        for (int ai = 0; ai < 2; ++ai)
#pragma unroll
            for (int m = 0; m < 4; ++m) { bf16_t* rowp = O + (size_t)(row0 + ai * 128 + m * 16) * ldc + col0;
#pragma unroll
                for (int bj = 0; bj < 2; ++bj) { const f32x4 v0 = acc[ai][bj][m][0], v1 = acc[ai][bj][m][1]; u32x4 w;
                    w.x = pg8::cvt_pk_bf16(v0[0], v0[1]); w.y = pg8::cvt_pk_bf16(v0[2], v0[3]); w.z = pg8::cvt_pk_bf16(v1[0], v1[1]); w.w = pg8::cvt_pk_bf16(v1[2], v1[3]);
                    *(u32x4*)(rowp + bj * 128) = w; } }
    }
};
struct EpiRes {
    static constexpr bool PERM = false, AFTER_DRAIN = false;
    const float* base; float* out; const float* gate;
    __device__ __forceinline__ void operator()(const f32x4 (&acc)[2][2][4][2], const pg8::Unit& u, int wr, int wc, int fr, int fq) const {
        const int row0 = u.pm * 256 + wr * 64 + fr, col0 = u.pn * 256 + wc * 32 + 4 * fq, b = u.pm >> 3;
        f32x4 gv[2][2];
#pragma unroll
        for (int bj = 0; bj < 2; ++bj)
#pragma unroll
            for (int n = 0; n < 2; ++n) gv[bj][n] = *(const f32x4*)(gate + (size_t)b * 6144 + col0 + bj * 128 + n * 16);
#pragma unroll
        for (int ai = 0; ai < 2; ++ai)
#pragma unroll
            for (int m = 0; m < 4; ++m) { const size_t ro = (size_t)(row0 + ai * 128 + m * 16) * 1024 + col0;
#pragma unroll
                for (int bj = 0; bj < 2; ++bj)
#pragma unroll
                    for (int n = 0; n < 2; ++n) { const f32x4 bv = *(const f32x4*)(base + ro + bj * 128 + n * 16);
                        *(f32x4*)(out + ro + bj * 128 + n * 16) = bv + gv[bj][n] * acc[ai][bj][m][n]; } }
    }
};
struct EpiSwi {
    static constexpr bool PERM = true, AFTER_DRAIN = false;
    bf16_t* O;
    __device__ __forceinline__ void operator()(const f32x4 (&acc)[2][2][4][2], const pg8::Unit& u, int wr, int wc, int fr, int fq) const {
        const int row0 = u.pm * 256 + wr * 64 + fr, col0 = u.pn * 128 + wc * 32 + 8 * fq;
#pragma unroll
        for (int ai = 0; ai < 2; ++ai)
#pragma unroll
            for (int m = 0; m < 4; ++m) { bf16_t* rowp = O + (size_t)(row0 + ai * 128 + m * 16) * FF_ + col0; float o[8];
#pragma unroll
                for (int n = 0; n < 2; ++n)
#pragma unroll
                    for (int i = 0; i < 4; ++i) { const float g = acc[ai][0][m][n][i], up = acc[ai][1][m][n][i]; o[4 * n + i] = g * sigmoidf_(g) * up; }
                u32x4 w; w.x = pg8::cvt_pk_bf16(o[0], o[1]); w.y = pg8::cvt_pk_bf16(o[2], o[3]); w.z = pg8::cvt_pk_bf16(o[4], o[5]); w.w = pg8::cvt_pk_bf16(o[6], o[7]);
                *(u32x4*)rowp = w; }
    }
};

__device__ __forceinline__ void transpose_item(const float* W, int K, int N, bf16_t* WT, int mode, LAS float* scr, int item, int lane) {
    const int nblk = N / 32, kb = item / nblk, nb = item % nblk, k0 = 64 * kb, n0 = 32 * nb;
    { const int rk = lane >> 3, c4 = lane & 7; f32x4 v[8];
#pragma unroll
      for (int i = 0; i < 8; ++i) v[i] = *(const f32x4*)(W + (size_t)(k0 + 8 * i + rk) * N + n0 + 4 * c4);
#pragma unroll
      for (int i = 0; i < 8; ++i) { LAS float* d = scr + (8 * i + rk) * 33 + 4 * c4; d[0] = v[i].x; d[1] = v[i].y; d[2] = v[i].z; d[3] = v[i].w; } }
    LDS_WAIT(); asm volatile("" ::: "memory");
    const int c = lane & 7;
#pragma unroll
    for (int j = 0; j < 4; ++j) { const int nl = (lane >> 3) + 8 * j, n = n0 + nl; const LAS float* s = scr + (8 * c) * 33 + nl;
        const int row = (mode == 0) ? n : (256 * (n >> 7) + (n & 127) + (mode == 2 ? 128 : 0));
        u32x4 o; o.x = pk2(s[0 * 33], s[1 * 33]); o.y = pk2(s[2 * 33], s[3 * 33]); o.z = pk2(s[4 * 33], s[5 * 33]); o.w = pk2(s[6 * 33], s[7 * 33]);
        *(u32x4*)(WT + (size_t)row * K + k0 + 8 * c) = o; }
    LDS_WAIT(); asm volatile("" ::: "memory");
}
__device__ __forceinline__ void phase_pro(const Args& a, LAS unsigned char* lds) {
    const int tid = otid(), wid = tid >> 6, lane = tid & 63;
    unsigned char* ws = a.ws;
    LAS float* CS = (LAS float*)lds;
    LAS float* RED = (LAS float*)(lds + 32768);
    if ((int)blockIdx.x < 192) {
        for (int i = tid; i < 8192; i += 512) { const float cv = a.in[1][i]; CS[i] = cv * sigmoidf_(cv); }
        __syncthreads();
    }
    for (int item = blockIdx.x; item < 192; item += gridDim.x) {
        const int l = item / 96, cgp = item % 96, col = cgp * 64 + lane;
        const float* aw = a.in[4] + (size_t)l * 1024 * 6144;
        float acc[8];
#pragma unroll
        for (int b = 0; b < 8; ++b) acc[b] = 0.f;
#pragma unroll 1
        for (int k0 = wid * 128; k0 < wid * 128 + 128; k0 += 32) { float w[32];
#pragma unroll
            for (int j = 0; j < 32; ++j) w[j] = aw[(size_t)(k0 + j) * 6144 + col];
#pragma unroll
            for (int j = 0; j < 32; ++j) {
#pragma unroll
                for (int b = 0; b < 8; ++b) acc[b] += CS[b * 1024 + k0 + j] * w[j]; } }
#pragma unroll
        for (int b = 0; b < 8; ++b) RED[(wid * 8 + b) * 64 + lane] = acc[b];
        __syncthreads();
        { const int b = wid; float s = 0.f;
#pragma unroll
          for (int w = 0; w < 8; ++w) s += RED[(w * 8 + b) * 64 + lane];
          ((float*)(ws + WS_MOD))[(size_t)(l * 8 + b) * 6144 + col] = s + a.in[5][l * 6144 + col]; }
        __syncthreads();
    }
    LAS float* scr = (LAS float*)(lds + 65536 + wid * 8448);
    const int gw = blockIdx.x * 8 + wid, NGW = gridDim.x * 8;
    constexpr int I_IN = 16 * (PW_ / 32), I_OUT = 16 * 32, I_G = 16 * (FF_ / 32), I_D = (FF_ / 64) * 32, I_L = I_IN + I_OUT + 2 * I_G + I_D;
    for (int it = gw; it < 2 * I_L; it += NGW) {
        const int l = it / I_L; int r = it % I_L;
        if (r < I_IN) { transpose_item(a.in[6] + (size_t)l * D_ * PW_, D_, PW_, (bf16_t*)(ws + WS_WIN + l * SZ_WIN), 0, scr, r, lane); continue; } r -= I_IN;
        if (r < I_OUT) { transpose_item(a.in[27] + (size_t)l * D_ * D_, D_, D_, (bf16_t*)(ws + WS_WOUT + l * SZ_WOUT), 0, scr, r, lane); continue; } r -= I_OUT;
        if (r < I_G) { transpose_item(a.in[28] + (size_t)l * D_ * FF_, D_, FF_, (bf16_t*)(ws + WS_WGU + l * SZ_WGU), 1, scr, r, lane); continue; } r -= I_G;
        if (r < I_G) { transpose_item(a.in[29] + (size_t)l * D_ * FF_, D_, FF_, (bf16_t*)(ws + WS_WGU + l * SZ_WGU), 2, scr, r, lane); continue; } r -= I_G;
        transpose_item(a.in[30] + (size_t)l * FF_ * D_, FF_, D_, (bf16_t*)(ws + WS_WD + l * SZ_WD), 0, scr, r, lane);
    }
    for (int e = blockIdx.x * 512 + tid; e < 2 * 98304; e += gridDim.x * 512) { const int l = e / 98304; int r = e % 98304; float v;
        if (r < 24576) { const int cidx = r >> 6, i = r & 63; v = a.in[17][((size_t)l * 64 + i) * 384 + cidx]; }
        else if (r < 49152) { const int r2 = r - 24576, cidx = r2 >> 6, i = r2 & 63; v = a.in[19][((size_t)l * 64 + i) * 384 + cidx]; }
        else { const int r2 = r - 49152, cidx = r2 >> 7, i = r2 & 127; v = a.in[20][((size_t)l * 128 + i) * 384 + cidx]; }
        ((bf16_t*)(ws + WS_LORA))[e] = (bf16_t)f2bf(v); }
    for (int e = blockIdx.x * 512 + tid; e < 65536; e += gridDim.x * 512) { const int i = e & 63, j = (e >> 6) & 63, gate = (e >> 12) & 1, lg = e >> 13;
        ((bf16_t*)(ws + WS_RGW))[e] = (bf16_t)f2bf(a.in[gate ? 11 : 9][((size_t)lg * 64 + i) * 64 + j]); }
    for (int i = blockIdx.x * 512 + tid; i < 2 * 16384; i += gridDim.x * 512) { const int l = i >> 14, e = i & 16383;
        *(u32x4*)(ws + WS_WIN + l * SZ_WIN + (size_t)PW_ * D_ * 2 + (size_t)e * 16) = (u32x4){0u, 0u, 0u, 0u}; }
}
__device__ __forceinline__ void phase_norm(const float* xin, const float* gain, const float* sh, const float* sc, bf16_t* H) {
    const int tid = otid(), wid = tid >> 6, lane = tid & 63, gw = blockIdx.x * 8 + wid, NGW = gridDim.x * 8;
    for (int row = gw; row < M_; row += 2 * NGW) { const int row2 = row + NGW; const bool has2 = row2 < M_;
        const f32x4* xr = (const f32x4*)(xin + (size_t)row * D_) + lane; const f32x4* xr2 = (const f32x4*)(xin + (size_t)(has2 ? row2 : row) * D_) + lane;
        f32x4 v[4], v2[4]; float ss = 0.f, ss2 = 0.f;
#pragma unroll
        for (int j = 0; j < 4; ++j) { v[j] = xr[64 * j]; v2[j] = xr2[64 * j]; }
#pragma unroll
        for (int j = 0; j < 4; ++j) { ss += (v[j].x * v[j].x + v[j].y * v[j].y) + (v[j].z * v[j].z + v[j].w * v[j].w); ss2 += (v2[j].x * v2[j].x + v2[j].y * v2[j].y) + (v2[j].z * v2[j].z + v2[j].w * v2[j].w); }
#pragma unroll
        for (int o = 1; o < 64; o <<= 1) { ss += __shfl_xor(ss, o); ss2 += __shfl_xor(ss2, o); }
        const float rs = rsq_(ss * (1.0f / D_) + 1e-6f), rs2 = rsq_(ss2 * (1.0f / D_) + 1e-6f); const int b = row >> 11, b2 = (has2 ? row2 : row) >> 11;
#pragma unroll
        for (int j = 0; j < 4; ++j) { const int col = 4 * lane + 256 * j;
            const f32x4 g = *(const f32x4*)(gain + col);
            { const f32x4 s1 = *(const f32x4*)(sc + (size_t)b * 6144 + col), s0 = *(const f32x4*)(sh + (size_t)b * 6144 + col);
              const f32x4 h = v[j] * rs * g * (s1 + 1.0f) + s0; u32x2 w; w.x = pk2(h.x, h.y); w.y = pk2(h.z, h.w); *(u32x2*)(H + (size_t)row * D_ + col) = w; }
            if (has2) { const f32x4 s1 = *(const f32x4*)(sc + (size_t)b2 * 6144 + col), s0 = *(const f32x4*)(sh + (size_t)b2 * 6144 + col);
              const f32x4 h = v2[j] * rs2 * g * (s1 + 1.0f) + s0; u32x2 w; w.x = pk2(h.x, h.y); w.y = pk2(h.z, h.w); *(u32x2*)(H + (size_t)row2 * D_ + col) = w; } }
    }
}
__device__ __forceinline__ void phase_final(float* x, const float* gain) {
    const int tid = otid(), wid = tid >> 6, lane = tid & 63, gw = blockIdx.x * 8 + wid, NGW = gridDim.x * 8;
    for (int row = gw; row < M_; row += 2 * NGW) { const int row2 = row + NGW; const bool has2 = row2 < M_;
        f32x4* xr = (f32x4*)(x + (size_t)row * D_) + lane; f32x4* xr2 = (f32x4*)(x + (size_t)(has2 ? row2 : row) * D_) + lane; f32x4 v[4], v2[4]; float ss = 0.f, ss2 = 0.f;
#pragma unroll
        for (int j = 0; j < 4; ++j) { v[j] = xr[64 * j]; v2[j] = xr2[64 * j]; }
#pragma unroll
        for (int j = 0; j < 4; ++j) { ss += (v[j].x * v[j].x + v[j].y * v[j].y) + (v[j].z * v[j].z + v[j].w * v[j].w); ss2 += (v2[j].x * v2[j].x + v2[j].y * v2[j].y) + (v2[j].z * v2[j].z + v2[j].w * v2[j].w); }
#pragma unroll
        for (int o = 1; o < 64; o <<= 1) { ss += __shfl_xor(ss, o); ss2 += __shfl_xor(ss2, o); }
        const float rs = rsq_(ss * (1.0f / D_) + 1e-6f), rs2 = rsq_(ss2 * (1.0f / D_) + 1e-6f);
#pragma unroll
        for (int j = 0; j < 4; ++j) { const f32x4 g = *(const f32x4*)(gain + 4 * lane + 256 * j); xr[64 * j] = v[j] * rs * g; if (has2) xr2[64 * j] = v2[j] * rs2 * g; }
    }
}
#define XB_TMO      128
#define XB_XCNT(j)  (256  + 64 * (j))
#define XB_XSUB(j)  (1280 + 64 * (j))
#define XB_XGEN(j)  (2304 + 64 * (j))
#define XB_TOP      3328
#define XB_TOPGEN   3392
#define XCD_BAR_WORDS 3456
#define XB_SPIN_CAP (1u << 18)

__device__ __forceinline__ unsigned xb_ld(unsigned* p)              { return __hip_atomic_load(p, __ATOMIC_RELAXED, __HIP_MEMORY_SCOPE_AGENT); }
__device__ __forceinline__ unsigned xb_add(unsigned* p, unsigned v) { return __hip_atomic_fetch_add(p, v, __ATOMIC_RELAXED, __HIP_MEMORY_SCOPE_AGENT); }
__device__ __forceinline__ unsigned xb_xcc_id() { return (unsigned)__builtin_amdgcn_s_getreg((3 << 11) | 20) & 0xFu; }
#define XB_SPIN(cond, bar) do { unsigned _sp = 0; while (cond) { __builtin_amdgcn_s_sleep(1); \
    if ((++_sp & 255u) == 0u) { if (xb_ld(&(bar)[XB_TMO])) break; if (_sp > XB_SPIN_CAP) { atomicAdd(&(bar)[XB_TMO], 1u); break; } } } } while (0)

struct XcdBarrier {
    unsigned* bar; unsigned x;
    volatile LAS unsigned* st;
};

__device__ __forceinline__ XcdBarrier xcd_barrier_post(unsigned* bar, volatile LAS unsigned* st) {
    XcdBarrier b; b.bar = bar; b.x = xb_xcc_id(); b.st = st;
    if (threadIdx.x == 0) (void)xb_add(&bar[XB_XCNT(b.x)], 1u);
    return b;
}
__device__ __forceinline__ void xcd_barrier_complete(unsigned* bar, unsigned x, unsigned& nloc, unsigned& nx) {
    const unsigned G = gridDim.x * gridDim.y * gridDim.z;
    unsigned sum, cnt, mine, sp = 0u;
    for (;;) {
        sum = 0u; cnt = 0u; mine = 0u;
#pragma unroll
        for (unsigned j = 0; j < 16; ++j) { const unsigned c = xb_ld(&bar[XB_XCNT(j)]); sum += c; cnt += (c > 0u) ? 1u : 0u; mine = (j == x) ? c : mine; }
        if (sum == G) break;
        __builtin_amdgcn_s_sleep(1);
        if ((++sp & 255u) == 0u) { if (xb_ld(&bar[XB_TMO])) break; if (sp > XB_SPIN_CAP) { atomicAdd(&bar[XB_TMO], 1u); break; } }
    }
    nloc = mine > 0u ? mine : 1u; nx = cnt > 0u ? cnt : 1u;
}

__device__ __forceinline__ void xcd_barrier(const XcdBarrier& b) {
    asm volatile("s_waitcnt vmcnt(0)" ::: "memory");
    __syncthreads();
    if (threadIdx.x == 0) {
        unsigned* bar = b.bar;
        __builtin_amdgcn_s_waitcnt(0);
        unsigned nloc = b.st[0], nx = b.st[1];
        if (nloc == 0u) { xcd_barrier_complete(bar, b.x, nloc, nx); b.st[0] = nloc; b.st[1] = nx; }
        const unsigned old = xb_add(&bar[XB_XSUB(b.x)], 1u);
        const unsigned gen = old / nloc;
        if (old + 1u == (gen + 1u) * nloc) {
            __builtin_amdgcn_fence(__ATOMIC_RELEASE, "agent");
            asm volatile("s_waitcnt vmcnt(0)" ::: "memory");
            const unsigned og = xb_add(&bar[XB_TOP], 1u);
            const unsigned tg = og / nx;
            if (og + 1u == (tg + 1u) * nx) xb_add(&bar[XB_TOPGEN], 1u);
            else XB_SPIN(xb_ld(&bar[XB_TOPGEN]) == tg, bar);
            __builtin_amdgcn_fence(__ATOMIC_ACQUIRE, "agent");
            xb_add(&bar[XB_XGEN(b.x)], 1u);
            asm volatile("s_waitcnt vmcnt(0)" ::: "memory");
        } else {
            XB_SPIN(xb_ld(&bar[XB_XGEN(b.x)]) == gen, bar);
            __builtin_amdgcn_fence(__ATOMIC_ACQUIRE, "agent");
            asm volatile("s_waitcnt vmcnt(0)" ::: "memory");
        }
    }
    __syncthreads();
}

__device__ __forceinline__ float gelu_tanh(float x) { const float u = 0.7978845608f * (x + 0.044715f * x * x * x); const float e = __expf(2.0f * u); const float th = 1.0f - 2.0f * rcp_(e + 1.0f); return 0.5f * x * (1.0f + th); }
template <int MODE>
__device__ __forceinline__ void rg_item(const Args& a, int l, int item, int lane) {
    const int g = item & 3, c = (item >> 2) & 31, b = item >> 7, ch = 64 * g + lane, row0 = b * T_ + 64 * c;
    const bf16_t* P = (const bf16_t*)(a.ws + WS_P);
    float* AGG = (float*)(a.ws + WS_RGA);
    float Wr[64], Wi[64];
#pragma unroll
    for (int i = 0; i < 64; ++i) { Wr[i] = a.in[9][((size_t)(l * 4 + g) * 64 + i) * 64 + lane]; Wi[i] = a.in[11][((size_t)(l * 4 + g) * 64 + i) * 64 + lane]; }
    const float cw0 = a.in[7][(l * 4 + 0) * 256 + ch], cw1 = a.in[7][(l * 4 + 1) * 256 + ch], cw2 = a.in[7][(l * 4 + 2) * 256 + ch], cw3 = a.in[7][(l * 4 + 3) * 256 + ch];
    const float cb = a.in[8][l * 256 + ch], rb = a.in[10][l * 256 + ch], ib = a.in[12][l * 256 + ch], lam = a.in[13][l * 256 + ch];
    const float sp = log1pf(__expf(-lam));
    float xm3 = 0.f, xm2 = 0.f, xm1 = 0.f;
    if (c > 0) { xm3 = bf2f(P[(size_t)(row0 - 3) * PS_ + PAX + ch]); xm2 = bf2f(P[(size_t)(row0 - 2) * PS_ + PAX + ch]); xm1 = bf2f(P[(size_t)(row0 - 1) * PS_ + PAX + ch]); }
    float h = 0.f, Ap = 1.f, beta = 0.f;
    if (MODE == 1) { h = AGG[2 * 65536 + (b * 32 + c) * 256 + ch]; beta = a.in[26][l * 1024 + ch]; }
    bf16_t* Y = (bf16_t*)(a.ws + WS_HY);
    unsigned short xn[8], yn[8];
#pragma unroll
    for (int i = 0; i < 8; ++i) { xn[i] = P[(size_t)(row0 + i) * PS_ + PAX + ch]; yn[i] = (MODE == 1) ? P[(size_t)(row0 + i) * PS_ + PAY + ch] : (unsigned short)0; }
#pragma unroll 1
    for (int tg = 0; tg < 8; ++tg) {
        unsigned short xr[8], yr[8];
#pragma unroll
        for (int i = 0; i < 8; ++i) { xr[i] = xn[i]; yr[i] = yn[i]; }
        if (tg < 7) {
#pragma unroll
            for (int i = 0; i < 8; ++i) { xn[i] = P[(size_t)(row0 + 8 * tg + 8 + i) * PS_ + PAX + ch]; if (MODE == 1) yn[i] = P[(size_t)(row0 + 8 * tg + 8 + i) * PS_ + PAY + ch]; } }
#pragma unroll
        for (int i8 = 0; i8 < 8; ++i8) { const int t = 8 * tg + i8;
        const float xc = bf2f(xr[i8]);
        const float u = cb + cw0 * xm3 + cw1 * xm2 + cw2 * xm1 + cw3 * xc;
        xm3 = xm2; xm2 = xm1; xm1 = xc;
        float rp = rb, ip = ib;
#pragma unroll
        for (int i = 0; i < 64; ++i) { const float ui = __builtin_bit_cast(float, __builtin_amdgcn_readlane(__builtin_bit_cast(int, u), i)); rp += ui * Wr[i]; ip += ui * Wi[i]; }
        const float r = sigmoidf_(rp), ig = sigmoidf_(ip);
        const float log_a = -8.0f * r * sp, av = __expf(log_a);
        const float x2 = 2.0f * log_a; const float em = (x2 > -0.25f) ? -x2 * (1.0f + 0.5f * x2 * (1.0f + (1.0f / 3.0f) * x2 * (1.0f + 0.25f * x2 * (1.0f + 0.2f * x2)))) : 1.0f - __expf(x2);
        float mult = __builtin_amdgcn_sqrtf(em); if (c == 0 && t == 0) mult = 1.0f;
        const float bv = mult * ig * u;
        h = av * h + bv;
        if (MODE == 0) Ap *= av;
        else { const float ya = bf2f(yr[i8]); const float y = h * gelu_tanh(ya);
            const float ss = wave_sum(y * y); const float o = y * rsq_(ss * (1.0f / 64.0f) + 1e-6f) * beta;
            Y[(size_t)(row0 + t) * D_ + ch] = (bf16_t)f2bf(o); }
        }
    }
    if (MODE == 0) { AGG[(b * 32 + c) * 256 + ch] = Ap; AGG[65536 + (b * 32 + c) * 256 + ch] = h; }
}
__device__ __forceinline__ void rg_carry(const Args& a, int gid) {
    float* AGG = (float*)(a.ws + WS_RGA); const int b = gid >> 8, ch = gid & 255; float H = 0.f; float Av[32], Bv[32];
#pragma unroll
    for (int c = 0; c < 32; ++c) { const int i = (b * 32 + c) * 256 + ch; Av[c] = AGG[i]; Bv[c] = AGG[65536 + i]; }
#pragma unroll
    for (int c = 0; c < 32; ++c) { const int i = (b * 32 + c) * 256 + ch; AGG[2 * 65536 + i] = H; H = Av[c] * H + Bv[c]; }
}
__device__ __forceinline__ f32x4 mfma16(bf16x8 x, bf16x8 y, f32x4 c) { return __builtin_amdgcn_mfma_f32_16x16x32_bf16(x, y, c, 0, 0, 0); }
constexpr int LST = 72;
template <int MODE>
__device__ __forceinline__ void hgrn_item(const Args& a, int l, int item, LAS unsigned char* lds) {
    const int tid = otid(), wid = tid >> 6, lane = tid & 63, fr = lane & 15, fq = lane >> 4;
    const int c = item & 31, bh = item >> 5, h = bh % 6, b = bh / 6, row0 = b * T_ + 64 * c;
    const bf16_t* P = (const bf16_t*)(a.ws + WS_P);
    bf16_t* KVT = (bf16_t*)(a.ws + WS_HKV) + (size_t)item * 4096;
    LAS float* PART = (LAS float*)lds;
    LAS float* RHO = (LAS float*)(lds + 2048);
    LAS float* BC = (LAS float*)(lds + 4096);
    LAS bf16_t* L0 = (LAS bf16_t*)(lds + 20480);
    LAS bf16_t* L1 = (LAS bf16_t*)(lds + 29696);
    LAS bf16_t* L2 = (LAS bf16_t*)(lds + 38912);
    LAS bf16_t* VT = (LAS bf16_t*)(lds + 48128);
    LAS bf16_t* AM = (LAS bf16_t*)(lds + 57344);
    LAS float* SS = (LAS float*)(lds + 66560);
    const int k = lane, pt = wid;
    const float* hl = a.in[14];
    float lbv = 0.f; if (l == 1) lbv = rcp_(1.0f + __expf(hl[64 * h + k] - hl[384 + 64 * h + k]));
    float bc[8], kvv[8]; float s = 0.f;
#pragma unroll
    for (int i = 0; i < 8; ++i) { const float z = bf2f(P[(size_t)(row0 + 8 * pt + i) * PS_ + PBF + 64 * h + k]);
        const float sg = rcp_(1.0f + __expf(-z)); const float f = fmaxf(lbv + (1.0f - lbv) * sg, 1e-37f);
        s += __logf(f); bc[i] = s; kvv[i] = (1.0f - lbv) * rcp_(1.0f + __expf(z)); }
    PART[pt * 64 + k] = s;
    { unsigned short vv[8];
#pragma unroll
      for (int i = 0; i < 8; ++i) vv[i] = P[(size_t)(row0 + 8 * pt + i) * PS_ + PBV + 64 * h + k];
      u32x4 w; w.x = vv[0] | ((unsigned)vv[1] << 16); w.y = vv[2] | ((unsigned)vv[3] << 16); w.z = vv[4] | ((unsigned)vv[5] << 16); w.w = vv[6] | ((unsigned)vv[7] << 16);
      *(LAS u32x4*)(VT + k * LST + 8 * pt) = w; }
    __syncthreads();
    float off = 0.f, tot = 0.f, rho = 0.f;
#pragma unroll
    for (int p = 0; p < 8; ++p) { const float v = PART[p * 64 + k]; if (p < pt) off += v; if (p < 4) rho += v; tot += v; }
#pragma unroll
    for (int i = 0; i < 8; ++i) bc[i] += off;
    if (MODE == 0) {
        u32x4 w; float e[8];
#pragma unroll
        for (int i = 0; i < 8; ++i) e[i] = kvv[i] * __expf(tot - bc[i]);
        w.x = pk2(e[0], e[1]); w.y = pk2(e[2], e[3]); w.z = pk2(e[4], e[5]); w.w = pk2(e[6], e[7]);
        *(LAS u32x4*)(L0 + k * LST + 8 * pt) = w;
        if (pt == 0) ((float*)(a.ws + WS_HDEC))[(size_t)item * 64 + k] = __expf(tot);
        __syncthreads();
        const int kt = wid >> 1;
#pragma unroll
        for (int q = 0; q < 2; ++q) { const int vt = 2 * (wid & 1) + q; f32x4 acc = {0.f, 0.f, 0.f, 0.f};
#pragma unroll
            for (int ks = 0; ks < 2; ++ks) { const bf16x8 x = *(const LAS bf16x8*)(L0 + (16 * kt + fr) * LST + 32 * ks + 8 * fq), y = *(const LAS bf16x8*)(VT + (16 * vt + fr) * LST + 32 * ks + 8 * fq);
                acc = mfma16(x, y, acc); }
            u32x2 w2; w2.x = pk2(acc[0], acc[1]); w2.y = pk2(acc[2], acc[3]);
            *(u32x2*)(KVT + (16 * vt + fr) * 64 + 16 * kt + 4 * fq) = w2; }
        __syncthreads();
    } else {
#pragma unroll
        for (int i = 0; i < 8; ++i) BC[(8 * pt + i) * 64 + k] = bc[i];
        if (pt == 0) RHO[k] = rho;
        __syncthreads();
        { const int t2 = tid >> 3, kg = tid & 7;
          const u32x4 qw = *(const u32x4*)(P + (size_t)(row0 + t2) * PS_ + PBQ + 64 * h + 8 * kg), zw = *(const u32x4*)(P + (size_t)(row0 + t2) * PS_ + PBF + 64 * h + 8 * kg);
          float q[8], z[8], qp[8], qt[8], kt_[8];
          q[0] = bflo(qw.x); q[1] = bfhi(qw.x); q[2] = bflo(qw.y); q[3] = bfhi(qw.y); q[4] = bflo(qw.z); q[5] = bfhi(qw.z); q[6] = bflo(qw.w); q[7] = bfhi(qw.w);
          z[0] = bflo(zw.x); z[1] = bfhi(zw.x); z[2] = bflo(zw.y); z[3] = bfhi(zw.y); z[4] = bflo(zw.z); z[5] = bfhi(zw.z); z[6] = bflo(zw.w); z[7] = bfhi(zw.w);
#pragma unroll
          for (int i = 0; i < 8; ++i) { const int kk = 8 * kg + i; float lb2 = 0.f; if (l == 1) lb2 = rcp_(1.0f + __expf(hl[64 * h + kk] - hl[384 + 64 * h + kk]));
              const float kvl = (1.0f - lb2) * rcp_(1.0f + __expf(z[i])); const float bcv = BC[t2 * 64 + kk], rh = RHO[kk]; const float qs = q[i] * 0.125f;
              qp[i] = qs * __expf(bcv); qt[i] = qs * __expf(fminf(bcv - rh, 87.0f)); kt_[i] = kvl * __expf(fminf(rh - bcv, 87.0f)); }
          u32x4 w; w.x = pk2(qp[0], qp[1]); w.y = pk2(qp[2], qp[3]); w.z = pk2(qp[4], qp[5]); w.w = pk2(qp[6], qp[7]); *(LAS u32x4*)(L0 + t2 * LST + 8 * kg) = w;
          w.x = pk2(qt[0], qt[1]); w.y = pk2(qt[2], qt[3]); w.z = pk2(qt[4], qt[5]); w.w = pk2(qt[6], qt[7]); *(LAS u32x4*)(L1 + t2 * LST + 8 * kg) = w;
          w.x = pk2(kt_[0], kt_[1]); w.y = pk2(kt_[2], kt_[3]); w.z = pk2(kt_[4], kt_[5]); w.w = pk2(kt_[6], kt_[7]); *(LAS u32x4*)(L2 + t2 * LST + 8 * kg) = w; }
        __syncthreads();
        const int tt = wid >> 1;
#pragma unroll
        for (int q = 0; q < 2; ++q) { const int st = 2 * (wid & 1) + q; f32x4 acc = {0.f, 0.f, 0.f, 0.f};
            if (st <= tt) {
#pragma unroll
                for (int ks = 0; ks < 2; ++ks) { const bf16x8 x = *(const LAS bf16x8*)(L2 + (16 * st + fr) * LST + 32 * ks + 8 * fq), y = *(const LAS bf16x8*)(L1 + (16 * tt + fr) * LST + 32 * ks + 8 * fq);
                    acc = mfma16(x, y, acc); }
                const int t = 16 * tt + fr;
#pragma unroll
                for (int j = 0; j < 4; ++j) { const int sidx = 16 * st + 4 * fq + j; if (sidx > t) acc[j] = 0.f; }
            }
            u32x2 w2; w2.x = pk2(acc[0], acc[1]); w2.y = pk2(acc[2], acc[3]);
            *(LAS u32x2*)(AM + (16 * tt + fr) * LST + 16 * st + 4 * fq) = w2; }
        __syncthreads();
        f32x4 o[2]; float ss = 0.f;
#pragma unroll
        for (int q = 0; q < 2; ++q) { const int vt = 2 * (wid & 1) + q; f32x4 acc = {0.f, 0.f, 0.f, 0.f};
#pragma unroll
            for (int ks = 0; ks < 2; ++ks) { const bf16x8 x = *(const bf16x8*)(KVT + (16 * vt + fr) * 64 + 32 * ks + 8 * fq), y = *(const LAS bf16x8*)(L0 + (16 * tt + fr) * LST + 32 * ks + 8 * fq);
                acc = mfma16(x, y, acc); }
#pragma unroll
            for (int ks = 0; ks < 2; ++ks) { const bf16x8 x = *(const LAS bf16x8*)(VT + (16 * vt + fr) * LST + 32 * ks + 8 * fq), y = *(const LAS bf16x8*)(AM + (16 * tt + fr) * LST + 32 * ks + 8 * fq);
                acc = mfma16(x, y, acc); }
            o[q] = acc; ss += (acc[0] * acc[0] + acc[1] * acc[1]) + (acc[2] * acc[2] + acc[3] * acc[3]); }
        ss += __shfl_xor(ss, 16); ss += __shfl_xor(ss, 32);
        if (fq == 0) SS[wid * 16 + fr] = ss;
        __syncthreads();
        const float tot2 = SS[wid * 16 + fr] + SS[(wid ^ 1) * 16 + fr];
        const float rs = rsq_(tot2 * (1.0f / 64.0f) + 1e-6f);
        bf16_t* Y = (bf16_t*)(a.ws + WS_HY);
#pragma unroll
        for (int q = 0; q < 2; ++q) { const int vt = 2 * (wid & 1) + q, t = 16 * tt + fr, cv = 64 * h + 16 * vt + 4 * fq;
            const u32x2 gw2 = *(const u32x2*)(P + (size_t)(row0 + t) * PS_ + PBG + cv);
            const f32x4 be = *(const f32x4*)(a.in[26] + l * 1024 + 256 + cv);
            float gg[4] = {bflo(gw2.x), bfhi(gw2.x), bflo(gw2.y), bfhi(gw2.y)}; float r[4];
#pragma unroll
            for (int j = 0; j < 4; ++j) r[j] = o[q][j] * rs * (gg[j] * sigmoidf_(gg[j])) * be[j];
            u32x2 w2; w2.x = pk2(r[0], r[1]); w2.y = pk2(r[2], r[3]);
            *(u32x2*)(Y + (size_t)(row0 + t) * D_ + 256 + cv) = w2; }
        __syncthreads();
    }
}
__device__ __forceinline__ void hgrn_scan(const Args& a, int e) {
    bf16_t* KVT = (bf16_t*)(a.ws + WS_HKV); const float* DEC = (const float*)(a.ws + WS_HDEC);
    const int bh = e >> 12, vk = e & 4095, k = vk & 63; float S = 0.f; unsigned short kv[32]; float dc[32];
#pragma unroll
    for (int c = 0; c < 32; ++c) { kv[c] = KVT[((size_t)(bh * 32 + c) << 12) + vk]; dc[c] = DEC[(bh * 32 + c) * 64 + k]; }
#pragma unroll
    for (int c = 0; c < 32; ++c) { KVT[((size_t)(bh * 32 + c) << 12) + vk] = (bf16_t)f2bf(S); S = dc[c] * S + bf2f(kv[c]); }
}
__device__ __forceinline__ f32x4 mfma16k16(s16x4 x, s16x4 y, f32x4 c) { return __builtin_amdgcn_mfma_f32_16x16x16bf16_1k(x, y, c, 0, 0, 0); }
__device__ __forceinline__ s16x4 pack4(f32x4 v) { u32x2 w; w.x = pk2(v[0], v[1]); w.y = pk2(v[2], v[3]); return __builtin_bit_cast(s16x4, w); }
__device__ __forceinline__ void unpack8(const u32x4 w, float* o) { o[0] = bflo(w.x); o[1] = bfhi(w.x); o[2] = bflo(w.y); o[3] = bfhi(w.y); o[4] = bflo(w.z); o[5] = bfhi(w.z); o[6] = bflo(w.w); o[7] = bfhi(w.w); }
__device__ __forceinline__ u32x4 pack8(const float* e) { u32x4 w; w.x = pk2(e[0], e[1]); w.y = pk2(e[2], e[3]); w.z = pk2(e[4], e[5]); w.w = pk2(e[6], e[7]); return w; }
__device__ __forceinline__ void shift8(const bf16_t* P, size_t row, bool has_prev, int col, const float* mu, float* o) {
    const u32x4 cw = *(const u32x4*)(P + row * PS_ + PC + col); u32x4 pw = {0u, 0u, 0u, 0u}; if (has_prev) pw = *(const u32x4*)(P + (row - 1) * PS_ + PC + col);
    float c[8], p[8]; unpack8(cw, c); unpack8(pw, p); const f32x4 m0 = *(const f32x4*)(mu + col), m1 = *(const f32x4*)(mu + col + 4);
#pragma unroll
    for (int i = 0; i < 8; ++i) o[i] = c[i] + (p[i] - c[i]) * (i < 4 ? m0[i] : m1[i - 4]);
}
constexpr int RW_LIN = 0, RW_LINS = 264;
constexpr int RW_RH = 52224, RW_YL = 61440, RW_YLS = 68;
constexpr int RW_CUM = 33792, RW_PART = 50176;
constexpr int RW_LO = 52224, RW_LOS = 68;
constexpr int RW_AT = 52224, RW_BD = 61440, RW_KD = 70656, RW_RT = 79872, RW_BTT = 89088, RW_KTT = 98304, RW_VT = 107520, RW_NAB = 116736, RW_AK = 125952;
constexpr int RW_ARB = RW_BTT, RW_ARK = RW_KTT;
constexpr int RW_NABF = 135168, RW_TII = 139264;
template <int MODE>
__device__ __forceinline__ void rwkv_chunk(const Args& a, int l, int bc, LAS unsigned char* lds) {
    const int tid = otid(), wid = tid >> 6, lane = tid & 63, fr = lane & 15, fq = lane >> 4;
    const int c = bc & 31, b = bc >> 5;
    const size_t row0 = (size_t)b * T_ + 64 * c;
    const bf16_t* P = (const bf16_t*)(a.ws + WS_P);
    const bf16_t* LW = (const bf16_t*)(a.ws + WS_LORA) + (size_t)l * 98304;
    const float* mu = a.in[15] + l * 1408;
    LAS bf16_t* LIN = (LAS bf16_t*)(lds + RW_LIN);
    LAS float* CUM = (LAS float*)(lds + RW_CUM); LAS float* PART = (LAS float*)(lds + RW_PART); LAS float* LO = (LAS float*)(lds + RW_LO);
    LAS bf16_t* AT = (LAS bf16_t*)(lds + RW_AT); LAS bf16_t* BD = (LAS bf16_t*)(lds + RW_BD); LAS bf16_t* KD = (LAS bf16_t*)(lds + RW_KD); LAS bf16_t* RT = (LAS bf16_t*)(lds + RW_RT);
    LAS bf16_t* BTT = (LAS bf16_t*)(lds + RW_BTT); LAS bf16_t* KTT = (LAS bf16_t*)(lds + RW_KTT); LAS bf16_t* VT = (LAS bf16_t*)(lds + RW_VT);
    LAS bf16_t* NAB = (LAS bf16_t*)(lds + RW_NAB); LAS bf16_t* AK = (LAS bf16_t*)(lds + RW_AK); LAS bf16_t* ARB = (LAS bf16_t*)(lds + RW_ARB); LAS bf16_t* ARK = (LAS bf16_t*)(lds + RW_ARK);
    LAS float* NABF = (LAS float*)(lds + RW_NABF); LAS bf16_t* TII = (LAS bf16_t*)(lds + RW_TII);
    const int t2 = tid >> 3, kg = tid & 7; const size_t row = row0 + t2; const bool has_prev = (c > 0) || (t2 > 0);
    { const float cA = (kg < 2) ? 2.0f : 1.0f, cC = (kg < 2) ? -1.0f : 0.0f; const bool ident = (kg == 2 || kg == 3);
#pragma unroll
        for (int q = 0; q < 4; ++q) { float ps[8]; const int col = 32 * kg + 8 * q; shift8(P, row, has_prev, 1152 + col, mu, ps);
#pragma unroll
            for (int i = 0; i < 8; ++i) { const float sg = cA * rcp_(1.0f + __expf(-cA * ps[i])) + cC; ps[i] = ident ? ps[i] : sg; }
            *(LAS u32x4*)(LIN + t2 * RW_LINS + col) = pack8(ps); }
    }
#pragma unroll 1
    for (int h = 0; h < 6; ++h) {
    const int item = ((b * 6 + h) << 5) + c;
    float rr[8], kx[8], vx[8];
    shift8(P, row, has_prev, 64 * h + 8 * kg, mu, rr); shift8(P, row, has_prev, 384 + 64 * h + 8 * kg, mu, kx); shift8(P, row, has_prev, 768 + 64 * h + 8 * kg, mu, vx);
    __syncthreads();
    { const int tt = wid >> 1;
#pragma unroll
      for (int q = 0; q < 2; ++q) { const int ct = 2 * (wid & 1) + q; const int crow = 64 * h + 16 * ct + fr;
          f32x4 aw = {0.f, 0.f, 0.f, 0.f}, aa = {0.f, 0.f, 0.f, 0.f}, ag = {0.f, 0.f, 0.f, 0.f};
#pragma unroll
          for (int ks = 0; ks < 2; ++ks) { const bf16x8 x = *(const LAS bf16x8*)(LIN + (16 * tt + fr) * RW_LINS + 32 * ks + 8 * fq), y = *(const bf16x8*)(LW + (size_t)crow * 64 + 32 * ks + 8 * fq); aw = mfma16(x, y, aw); }
#pragma unroll
          for (int ks = 0; ks < 2; ++ks) { const bf16x8 x = *(const LAS bf16x8*)(LIN + (16 * tt + fr) * RW_LINS + 64 + 32 * ks + 8 * fq), y = *(const bf16x8*)(LW + 24576 + (size_t)crow * 64 + 32 * ks + 8 * fq); aa = mfma16(x, y, aa); }
#pragma unroll
          for (int ks = 0; ks < 4; ++ks) { const bf16x8 x = *(const LAS bf16x8*)(LIN + (16 * tt + fr) * RW_LINS + 128 + 32 * ks + 8 * fq), y = *(const bf16x8*)(LW + 49152 + (size_t)crow * 128 + 32 * ks + 8 * fq); ag = mfma16(x, y, ag); }
#pragma unroll
          for (int j = 0; j < 4; ++j) { const int o = (16 * tt + 4 * fq + j) * RW_LOS + 16 * ct + fr; LO[o] = aw[j]; LO[64 * RW_LOS + o] = aa[j]; LO[2 * 64 * RW_LOS + o] = ag[j]; } }
    }
    __syncthreads();
    float gg[8], lw[8], be[8], al[8], kp[8]; float rkt = 0.f;
    { const int cb = l * 384 + 64 * h + 8 * kg; float wa[8], av[8];
      *(f32x4*)&wa[0] = *(const LAS f32x4*)(LO + t2 * RW_LOS + 8 * kg); *(f32x4*)&wa[4] = *(const LAS f32x4*)(LO + t2 * RW_LOS + 8 * kg + 4);
      *(f32x4*)&av[0] = *(const LAS f32x4*)(LO + 64 * RW_LOS + t2 * RW_LOS + 8 * kg); *(f32x4*)&av[4] = *(const LAS f32x4*)(LO + 64 * RW_LOS + t2 * RW_LOS + 8 * kg + 4);
      *(f32x4*)&gg[0] = *(const LAS f32x4*)(LO + 128 * RW_LOS + t2 * RW_LOS + 8 * kg); *(f32x4*)&gg[4] = *(const LAS f32x4*)(LO + 128 * RW_LOS + t2 * RW_LOS + 8 * kg + 4);
      float ssq = 0.f, kkr[8]; float p_w0[8], p_a0[8], p_kk[8], p_ka[8], p_rk[8];
      *(f32x4*)&p_w0[0] = *(const f32x4*)(a.in[16] + cb); *(f32x4*)&p_w0[4] = *(const f32x4*)(a.in[16] + cb + 4);
      *(f32x4*)&p_a0[0] = *(const f32x4*)(a.in[18] + cb); *(f32x4*)&p_a0[4] = *(const f32x4*)(a.in[18] + cb + 4);
      *(f32x4*)&p_kk[0] = *(const f32x4*)(a.in[21] + cb); *(f32x4*)&p_kk[4] = *(const f32x4*)(a.in[21] + cb + 4);
      *(f32x4*)&p_ka[0] = *(const f32x4*)(a.in[22] + cb); *(f32x4*)&p_ka[4] = *(const f32x4*)(a.in[22] + cb + 4);
      *(f32x4*)&p_rk[0] = *(const f32x4*)(a.in[23] + cb); *(f32x4*)&p_rk[4] = *(const f32x4*)(a.in[23] + cb + 4);
#pragma unroll
      for (int i = 0; i < 8; ++i) { const float wp = wa[i] + p_w0[i]; lw[i] = -0.60653066f * sigmoidf_(wp);
          const float aa = sigmoidf_(av[i] + p_a0[i]);
          kkr[i] = kx[i] * p_kk[i]; ssq += kkr[i] * kkr[i];
          kp[i] = kx[i] * (1.0f + (aa - 1.0f) * p_ka[i]); be[i] = aa;
          rkt += rr[i] * kp[i] * p_rk[i]; }
      ssq += __shfl_xor(ssq, 1); ssq += __shfl_xor(ssq, 2); ssq += __shfl_xor(ssq, 4);
      rkt += __shfl_xor(rkt, 1); rkt += __shfl_xor(rkt, 2); rkt += __shfl_xor(rkt, 4);
      const float rn = rsq_(ssq + 1e-12f);
#pragma unroll
      for (int i = 0; i < 8; ++i) { const float kk = kkr[i] * rn; al[i] = -kk; be[i] = kk * be[i]; }
#pragma unroll
      for (int i = 0; i < 8; ++i) CUM[t2 * 64 + 8 * kg + i] = lw[i];
    }
    __syncthreads();
    { const int k = lane, pt = wid; float s = 0.f; float cv[8];
#pragma unroll
      for (int i = 0; i < 8; ++i) { s += CUM[(8 * pt + i) * 64 + k]; cv[i] = s; }
      PART[pt * 64 + k] = s;
      __syncthreads();
      float off = 0.f;
#pragma unroll
      for (int p = 0; p < 8; ++p) { const float v = PART[p * 64 + k]; if (p < pt) off += v; }
#pragma unroll
      for (int i = 0; i < 8; ++i) CUM[(8 * pt + i) * 64 + k] = cv[i] + off;
    }
    __syncthreads();
    { float cu[8], cl[8], e[8];
      *(f32x4*)&cu[0] = *(const LAS f32x4*)(CUM + t2 * 64 + 8 * kg); *(f32x4*)&cu[4] = *(const LAS f32x4*)(CUM + t2 * 64 + 8 * kg + 4);
      *(f32x4*)&cl[0] = *(const LAS f32x4*)(CUM + 63 * 64 + 8 * kg); *(f32x4*)&cl[4] = *(const LAS f32x4*)(CUM + 63 * 64 + 8 * kg + 4);
#pragma unroll
      for (int i = 0; i < 8; ++i) e[i] = al[i] * __expf(cu[i] - lw[i]);
      *(LAS u32x4*)(AT + t2 * LST + 8 * kg) = pack8(e);
      float en[8];
#pragma unroll
      for (int i = 0; i < 8; ++i) en[i] = __expf(-cu[i]);
#pragma unroll
      for (int i = 0; i < 8; ++i) e[i] = be[i] * en[i];
      *(LAS u32x4*)(BD + t2 * LST + 8 * kg) = pack8(e);
#pragma unroll
      for (int i = 0; i < 8; ++i) e[i] = kp[i] * en[i];
      *(LAS u32x4*)(KD + t2 * LST + 8 * kg) = pack8(e);
      if (MODE == 1) {
#pragma unroll
          for (int i = 0; i < 8; ++i) e[i] = rr[i] * __expf(cu[i]);
          *(LAS u32x4*)(RT + t2 * LST + 8 * kg) = pack8(e);
      } else {
#pragma unroll
          for (int i = 0; i < 8; ++i) { const float ed = __expf(cl[i] - cu[i]); BTT[(8 * kg + i) * LST + t2] = (bf16_t)f2bf(be[i] * ed); KTT[(8 * kg + i) * LST + t2] = (bf16_t)f2bf(kp[i] * ed); }
          if (t2 == 63) {
#pragma unroll
              for (int i = 0; i < 8; ++i) ((float*)(a.ws + WS_RGAM))[(size_t)item * 64 + 8 * kg + i] = __expf(cl[i]); }
      }
#pragma unroll
      for (int i = 0; i < 8; ++i) VT[(8 * kg + i) * LST + t2] = (bf16_t)f2bf(vx[i]);
    }
    __syncthreads();
    { const int tt = wid >> 1;
#pragma unroll
      for (int q = 0; q < 2; ++q) { const int st = 2 * (wid & 1) + q;
          f32x4 ab = {0.f, 0.f, 0.f, 0.f}, ak = {0.f, 0.f, 0.f, 0.f}, rb = {0.f, 0.f, 0.f, 0.f}, rk = {0.f, 0.f, 0.f, 0.f};
          if (st <= tt) {
#pragma unroll
              for (int ks = 0; ks < 2; ++ks) { const int ao = (16 * st + fr) * LST + 32 * ks + 8 * fq, bo = (16 * tt + fr) * LST + 32 * ks + 8 * fq;
                  const bf16x8 xb = *(const LAS bf16x8*)(BD + ao), xk = *(const LAS bf16x8*)(KD + ao), ya = *(const LAS bf16x8*)(AT + bo);
                  ab = mfma16(xb, ya, ab); ak = mfma16(xk, ya, ak);
                  if (MODE == 1) { const bf16x8 yr = *(const LAS bf16x8*)(RT + bo); rb = mfma16(xb, yr, rb); rk = mfma16(xk, yr, rk); } }
              const int t = 16 * tt + fr;
#pragma unroll
              for (int j = 0; j < 4; ++j) { const int s = 16 * st + 4 * fq + j; if (s >= t) { ab[j] = 0.f; ak[j] = 0.f; } if (s > t) { rb[j] = 0.f; rk[j] = 0.f; } }
              if (st == tt) *(LAS f32x4*)(NABF + tt * 256 + fr * 16 + 4 * fq) = ab;
          }
          const int o = (16 * tt + fr) * LST + 16 * st + 4 * fq;
          *(LAS s16x4*)(NAB + o) = pack4(ab); *(LAS s16x4*)(AK + o) = pack4(ak);
          if (MODE == 1) { *(LAS s16x4*)(ARB + o) = pack4(rb); *(LAS s16x4*)(ARK + o) = pack4(rk); } }
    }
    __syncthreads();
    f32x4 R[4];
    if (wid == 0) { const int blk = fq, j = fr; float Tc[16];
#pragma unroll
        for (int i = 0; i < 16; ++i) { float acc = (i == j) ? 1.0f : 0.0f;
#pragma unroll
            for (int m = 0; m < 16; ++m) if (m < i) acc += NABF[blk * 256 + i * 16 + m] * Tc[m];
            Tc[i] = acc; TII[blk * 256 + i * 16 + j] = (bf16_t)f2bf(acc); }
    }
    if (wid >= 4) { const int vt = wid - 4;
#pragma unroll
        for (int I = 0; I < 4; ++I) { f32x4 acc = {0.f, 0.f, 0.f, 0.f};
#pragma unroll
            for (int ks = 0; ks < 2; ++ks) { const bf16x8 x = *(const LAS bf16x8*)(AK + (16 * I + fr) * LST + 32 * ks + 8 * fq), y = *(const LAS bf16x8*)(VT + (16 * vt + fr) * LST + 32 * ks + 8 * fq); acc = mfma16(x, y, acc); }
            R[I] = acc; }
    } else {
#pragma unroll
        for (int I = 0; I < 4; ++I)
#pragma unroll
            for (int j = 0; j < 4; ++j) R[I][j] = bf2f(AT[(16 * I + 4 * fq + j) * LST + 16 * wid + fr]);
    }
    __syncthreads();
    s16x4 Xb[4];
#pragma unroll
    for (int I = 0; I < 4; ++I) { f32x4 acc = R[I];
#pragma unroll
        for (int J = 0; J < 4; ++J) if (J < I) acc = mfma16k16(*(const LAS s16x4*)(NAB + (16 * I + fr) * LST + 16 * J + 4 * fq), Xb[J], acc);
        const f32x4 z = {0.f, 0.f, 0.f, 0.f};
        const f32x4 x = mfma16k16(*(const LAS s16x4*)(TII + I * 256 + fr * 16 + 4 * fq), pack4(acc), z);
        Xb[I] = pack4(x); }
    s16x4 Vf[4];
    if (wid >= 4) {
#pragma unroll
        for (int J = 0; J < 4; ++J) Vf[J] = *(const LAS s16x4*)(VT + (16 * (wid - 4) + fr) * LST + 16 * J + 4 * fq); }
    if (MODE == 0) {
#pragma unroll
        for (int kt = 0; kt < 4; ++kt) { f32x4 acc = {0.f, 0.f, 0.f, 0.f};
#pragma unroll
            for (int J = 0; J < 4; ++J) acc = mfma16k16(*(const LAS s16x4*)(BTT + (16 * kt + fr) * LST + 16 * J + 4 * fq), Xb[J], acc);
            if (wid >= 4) {
#pragma unroll
                for (int J = 0; J < 4; ++J) acc = mfma16k16(*(const LAS s16x4*)(KTT + (16 * kt + fr) * LST + 16 * J + 4 * fq), Vf[J], acc);
                *(s16x4*)((bf16_t*)(a.ws + WS_RN) + (size_t)item * 4096 + ((kt * 4 + (wid - 4)) * 64 + lane) * 4) = pack4(acc);
            } else { bf16_t* RM = (bf16_t*)(a.ws + WS_RM) + (size_t)item * 4096;
#pragma unroll
                for (int j = 0; j < 4; ++j) RM[(16 * kt + 4 * fq + j) * 64 + 16 * wid + fr] = (bf16_t)f2bf(acc[j]); } }
        __syncthreads();
    } else {
        LAS bf16_t* RH = (LAS bf16_t*)(lds + RW_RH); LAS float* YL = (LAS float*)(lds + RW_YL);
        f32x4 yh[4];
#pragma unroll
        for (int tt = 0; tt < 4; ++tt) { f32x4 acc = {0.f, 0.f, 0.f, 0.f};
            if (wid < 4) {
#pragma unroll
                for (int j = 0; j < 4; ++j) acc[j] = bf2f(RT[(16 * tt + 4 * fq + j) * LST + 16 * wid + fr]); }
#pragma unroll
            for (int J = 0; J < 4; ++J) if (J <= tt) acc = mfma16k16(*(const LAS s16x4*)(ARB + (16 * tt + fr) * LST + 16 * J + 4 * fq), Xb[J], acc);
            if (wid >= 4) {
#pragma unroll
                for (int J = 0; J < 4; ++J) if (J <= tt) acc = mfma16k16(*(const LAS s16x4*)(ARK + (16 * tt + fr) * LST + 16 * J + 4 * fq), Vf[J], acc);
                yh[tt] = acc;
            } else {
#pragma unroll
                for (int j = 0; j < 4; ++j) RH[(16 * tt + 4 * fq + j) * LST + 16 * wid + fr] = (bf16_t)f2bf(acc[j]); } }
        __syncthreads();
        if (wid >= 4) { const int vt = wid - 4; s16x4 S0[4];
#pragma unroll
            for (int kt = 0; kt < 4; ++kt) S0[kt] = *(const s16x4*)((const bf16_t*)(a.ws + WS_RN) + (size_t)item * 4096 + ((kt * 4 + vt) * 64 + lane) * 4);
#pragma unroll
            for (int tt = 0; tt < 4; ++tt) { f32x4 acc = yh[tt];
#pragma unroll
                for (int kt = 0; kt < 4; ++kt) acc = mfma16k16(*(const LAS s16x4*)(RH + (16 * tt + fr) * LST + 16 * kt + 4 * fq), S0[kt], acc);
#pragma unroll
                for (int j = 0; j < 4; ++j) YL[(16 * tt + 4 * fq + j) * RW_YLS + 16 * vt + fr] = acc[j]; } }
        __syncthreads();
        { const int cb = l * 384 + 64 * h + 8 * kg; float y[8];
          *(f32x4*)&y[0] = *(const LAS f32x4*)(YL + t2 * RW_YLS + 8 * kg); *(f32x4*)&y[4] = *(const LAS f32x4*)(YL + t2 * RW_YLS + 8 * kg + 4);
          float sm = 0.f;
#pragma unroll
          for (int i = 0; i < 8; ++i) sm += y[i];
          sm += __shfl_xor(sm, 1); sm += __shfl_xor(sm, 2); sm += __shfl_xor(sm, 4);
          const float mean = sm * (1.0f / 64.0f); float vr = 0.f;
#pragma unroll
          for (int i = 0; i < 8; ++i) { y[i] -= mean; vr += y[i] * y[i]; }
          vr += __shfl_xor(vr, 1); vr += __shfl_xor(vr, 2); vr += __shfl_xor(vr, 4);
          const float rs = rsq_(vr * (1.0f / 64.0f) + 64e-5f); float o[8]; float p_lw[8], p_lb[8], p_be[8];
          *(f32x4*)&p_lw[0] = *(const f32x4*)(a.in[24] + cb); *(f32x4*)&p_lw[4] = *(const f32x4*)(a.in[24] + cb + 4);
          *(f32x4*)&p_lb[0] = *(const f32x4*)(a.in[25] + cb); *(f32x4*)&p_lb[4] = *(const f32x4*)(a.in[25] + cb + 4);
          *(f32x4*)&p_be[0] = *(const f32x4*)(a.in[26] + l * 1024 + 640 + 64 * h + 8 * kg); *(f32x4*)&p_be[4] = *(const f32x4*)(a.in[26] + l * 1024 + 640 + 64 * h + 8 * kg + 4);
#pragma unroll
          for (int i = 0; i < 8; ++i) o[i] = ((y[i] * rs * p_lw[i] + p_lb[i]) + rkt * vx[i]) * gg[i] * p_be[i];
          *(u32x4*)((bf16_t*)(a.ws + WS_HY) + row * D_ + 640 + 64 * h + 8 * kg) = pack8(o); }
        __syncthreads();
    }
    }
}
__device__ __forceinline__ void rwkv_scan(const Args& a, int bh, int vt, int lane) {
    const int fr = lane & 15, fq = lane >> 4;
    const bf16_t* RM = (const bf16_t*)(a.ws + WS_RM); bf16_t* RN = (bf16_t*)(a.ws + WS_RN); const float* GAM = (const float*)(a.ws + WS_RGAM);
    f32x4 S[4];
#pragma unroll
    for (int k = 0; k < 4; ++k) S[k] = (f32x4){0.f, 0.f, 0.f, 0.f};
    s16x4 Mn[4][4]; s16x4 Nn[4]; f32x4 gn[4];
#define RWS_LOAD(cc) { const size_t it_ = (size_t)bh * 32 + (cc); _Pragma("unroll") for (int kt = 0; kt < 4; ++kt) { _Pragma("unroll") for (int k2 = 0; k2 < 4; ++k2) Mn[kt][k2] = *(const s16x4*)(RM + it_ * 4096 + (16 * kt + fr) * 64 + 16 * k2 + 4 * fq); \
            Nn[kt] = *(const s16x4*)(RN + it_ * 4096 + ((kt * 4 + vt) * 64 + lane) * 4); gn[kt] = *(const f32x4*)(GAM + it_ * 64 + 16 * kt + 4 * fq); } }
    RWS_LOAD(0)
#pragma unroll 1
    for (int c = 0; c < 32; ++c) { const size_t item = (size_t)bh * 32 + c;
        s16x4 Mf[4][4]; s16x4 Nf[4]; f32x4 gam[4];
#pragma unroll
        for (int kt = 0; kt < 4; ++kt) { Nf[kt] = Nn[kt]; gam[kt] = gn[kt];
#pragma unroll
            for (int k2 = 0; k2 < 4; ++k2) Mf[kt][k2] = Mn[kt][k2]; }
        if (c < 31) RWS_LOAD(c + 1)
        s16x4 Sb[4];
#pragma unroll
        for (int k = 0; k < 4; ++k) { Sb[k] = pack4(S[k]); *(s16x4*)(RN + item * 4096 + ((k * 4 + vt) * 64 + lane) * 4) = Sb[k]; }
#pragma unroll
        for (int kt = 0; kt < 4; ++kt) { const u32x2 nw = __builtin_bit_cast(u32x2, Nf[kt]);
            f32x4 acc = gam[kt] * S[kt] + (f32x4){bflo(nw.x), bfhi(nw.x), bflo(nw.y), bfhi(nw.y)};
#pragma unroll
            for (int k2 = 0; k2 < 4; ++k2) acc = mfma16k16(Mf[kt][k2], Sb[k2], acc);
            S[kt] = acc; }
    }
#undef RWS_LOAD
}
constexpr int RG_US = 264;
constexpr int RG_U = 0, RG_LA = 33792, RG_LB = 67584, RG_AG = 101376;
constexpr int RG_YS = 260, RG_YB = 0, RG_AG1 = 66560;
__device__ __forceinline__ float rg_em(float x2) { return (x2 > -0.25f) ? -x2 * (1.0f + 0.5f * x2 * (1.0f + (1.0f / 3.0f) * x2 * (1.0f + 0.25f * x2 * (1.0f + 0.2f * x2)))) : 1.0f - __expf(x2); }
__device__ __forceinline__ void rg2_mode0(const Args& a, int l, int item, LAS unsigned char* lds) {
    const int tid = otid(), wid = tid >> 6, lane = tid & 63, fr = lane & 15, fq = lane >> 4;
    const int c = item & 31, b = item >> 5; const size_t row0 = (size_t)b * T_ + 64 * c;
    const bf16_t* P = (const bf16_t*)(a.ws + WS_P);
    LAS bf16_t* U = (LAS bf16_t*)(lds + RG_U); LAS bf16_t* LA = (LAS bf16_t*)(lds + RG_LA); LAS bf16_t* LB = (LAS bf16_t*)(lds + RG_LB); LAS float* AG = (LAS float*)(lds + RG_AG);
    const int ch = tid & 255, hf = tid >> 8, t0 = 32 * hf;
    { const float cw0 = a.in[7][(l * 4 + 0) * 256 + ch], cw1 = a.in[7][(l * 4 + 1) * 256 + ch], cw2 = a.in[7][(l * 4 + 2) * 256 + ch], cw3 = a.in[7][(l * 4 + 3) * 256 + ch], cb = a.in[8][l * 256 + ch];
      float xm3 = 0.f, xm2 = 0.f, xm1 = 0.f;
      if (c > 0 || hf > 0) { xm3 = bf2f(P[(row0 + t0 - 3) * PS_ + PAX + ch]); xm2 = bf2f(P[(row0 + t0 - 2) * PS_ + PAX + ch]); xm1 = bf2f(P[(row0 + t0 - 1) * PS_ + PAX + ch]); }
      unsigned short xr[32];
#pragma unroll
      for (int i = 0; i < 32; ++i) xr[i] = P[(row0 + t0 + i) * PS_ + PAX + ch];
#pragma unroll
      for (int i = 0; i < 32; ++i) { const float xc = bf2f(xr[i]); const float u = cb + cw0 * xm3 + cw1 * xm2 + cw2 * xm1 + cw3 * xc; xm3 = xm2; xm2 = xm1; xm1 = xc;
          U[(t0 + i) * RG_US + ch] = (bf16_t)f2bf(u); } }
    __syncthreads();
    { const int g = wid >> 1; const bf16_t* WT = (const bf16_t*)(a.ws + WS_RGW) + (size_t)(l * 4 + g) * 2 * 4096;
#pragma unroll
      for (int q = 0; q < 2; ++q) { const int tt = 2 * (wid & 1) + q;
          bf16x8 ua[2];
#pragma unroll
          for (int ks = 0; ks < 2; ++ks) ua[ks] = *(const LAS bf16x8*)(U + (16 * tt + fr) * RG_US + 64 * g + 32 * ks + 8 * fq);
#pragma unroll
          for (int jt = 0; jt < 4; ++jt) { f32x4 ar = {0.f, 0.f, 0.f, 0.f}, ai = {0.f, 0.f, 0.f, 0.f};
#pragma unroll
              for (int ks = 0; ks < 2; ++ks) { const bf16x8 wr = *(const bf16x8*)(WT + (16 * jt + fr) * 64 + 32 * ks + 8 * fq), wi = *(const bf16x8*)(WT + 4096 + (16 * jt + fr) * 64 + 32 * ks + 8 * fq);
                  ar = mfma16(ua[ks], wr, ar); ai = mfma16(ua[ks], wi, ai); }
              const int chj = 64 * g + 16 * jt + fr;
              const float rb = a.in[10][l * 256 + chj], ib = a.in[12][l * 256 + chj], sp8 = -8.0f * __logf(1.0f + __expf(-a.in[13][l * 256 + chj]));
#pragma unroll
              for (int j = 0; j < 4; ++j) { const int t = 16 * tt + 4 * fq + j;
                  const float r = sigmoidf_(ar[j] + rb), ig = sigmoidf_(ai[j] + ib);
                  const float log_a = bf2f((unsigned short)f2bf(r * sp8));
                  float mult = __builtin_amdgcn_sqrtf(rg_em(2.0f * log_a)); if (c == 0 && t == 0) mult = 1.0f;
                  const float u = bf2f(U[t * RG_US + chj]);
                  LA[t * RG_US + chj] = (bf16_t)f2bf(log_a); LB[t * RG_US + chj] = (bf16_t)f2bf(mult * ig * u); } } }
    }
    __syncthreads();
    { bf16_t* GLA = (bf16_t*)(a.ws + WS_RGL); bf16_t* GLB = (bf16_t*)(a.ws + WS_RGB);
      float h = 0.f, sl = 0.f;
#pragma unroll 8
      for (int i = 0; i < 32; ++i) { const unsigned short la = LA[(t0 + i) * RG_US + ch], lb = LB[(t0 + i) * RG_US + ch];
          GLA[(row0 + t0 + i) * 256 + ch] = la; GLB[(row0 + t0 + i) * 256 + ch] = lb;
          const float lg = bf2f(la); sl += lg; h = __expf(lg) * h + bf2f(lb); }
      AG[(hf * 256 + ch) * 2] = sl; AG[(hf * 256 + ch) * 2 + 1] = h;
      __syncthreads();
      if (hf == 0) { const float s1 = AG[(256 + ch) * 2], h1 = AG[(256 + ch) * 2 + 1]; float* AGG = (float*)(a.ws + WS_RGA);
          AGG[(b * 32 + c) * 256 + ch] = __expf(sl + s1); AGG[65536 + (b * 32 + c) * 256 + ch] = __expf(s1) * h + h1; } }
    __syncthreads();
}
__device__ __forceinline__ void rg2_mode1(const Args& a, int l, int item, LAS unsigned char* lds) {
    const int tid = otid();
    const int c = item & 31, b = item >> 5; const size_t row0 = (size_t)b * T_ + 64 * c;
    const bf16_t* P = (const bf16_t*)(a.ws + WS_P); const bf16_t* GLA = (const bf16_t*)(a.ws + WS_RGL); const bf16_t* GLB = (const bf16_t*)(a.ws + WS_RGB);
    LAS float* YB = (LAS float*)(lds + RG_YB); LAS float* AG = (LAS float*)(lds + RG_AG1);
    const int ch = tid & 255, hf = tid >> 8, t0 = 32 * hf;
    unsigned short la[32], lb[32], ya[32];
#pragma unroll
    for (int i = 0; i < 32; ++i) { la[i] = GLA[(row0 + t0 + i) * 256 + ch]; lb[i] = GLB[(row0 + t0 + i) * 256 + ch]; ya[i] = P[(row0 + t0 + i) * PS_ + PAY + ch]; }
    const float carry = ((const float*)(a.ws + WS_RGA))[2 * 65536 + (b * 32 + c) * 256 + ch];
    float av[32];
    { float h = 0.f, sl = 0.f;
#pragma unroll
      for (int i = 0; i < 32; ++i) { const float lg = bf2f(la[i]); sl += lg; av[i] = __expf(lg); h = av[i] * h + bf2f(lb[i]); }
      if (hf == 0) { AG[ch * 2] = sl; AG[ch * 2 + 1] = h; } }
    __syncthreads();
    { float h = carry; if (hf == 1) h = __expf(AG[ch * 2]) * carry + AG[ch * 2 + 1];
#pragma unroll
      for (int i = 0; i < 32; ++i) { h = av[i] * h + bf2f(lb[i]); YB[(t0 + i) * RG_YS + ch] = h * gelu_tanh(bf2f(ya[i])); } }
    __syncthreads();
    { const int t = tid >> 3, gs = tid & 7, cbase = 32 * gs; float y[32]; float ss = 0.f;
#pragma unroll
      for (int q = 0; q < 8; ++q) { *(f32x4*)&y[4 * q] = *(const LAS f32x4*)(YB + t * RG_YS + cbase + 4 * q); }
#pragma unroll
      for (int i = 0; i < 32; ++i) ss += y[i] * y[i];
      ss += __shfl_xor(ss, 1);
      const float rs = rsq_(ss * (1.0f / 64.0f) + 1e-6f);
      bf16_t* Y = (bf16_t*)(a.ws + WS_HY) + (row0 + t) * D_ + cbase; const float* be = a.in[26] + l * 1024 + cbase;
#pragma unroll
      for (int q = 0; q < 4; ++q) { float o[8]; const f32x4 b0 = *(const f32x4*)(be + 8 * q), b1 = *(const f32x4*)(be + 8 * q + 4);
#pragma unroll
          for (int i = 0; i < 8; ++i) o[i] = y[8 * q + i] * rs * (i < 4 ? b0[i] : b1[i - 4]);
          *(u32x4*)(Y + 8 * q) = pack8(o); } }
    __syncthreads();
}
constexpr int HG_STRIDE = 69632;
template <int MODE>
__device__ __forceinline__ void hgrn_item2(const Args& a, int l, int it0, int it1, LAS unsigned char* lds) {
    const int tid = otid(), wid = tid >> 6, lane = tid & 63, fr = lane & 15, fq = lane >> 4;
    const bf16_t* P = (const bf16_t*)(a.ws + WS_P);
    const int k = lane, pt = wid;
    const float* hl = a.in[14];
    int itv[2] = {it0, it1}; int hv[2]; size_t row0v[2]; float lbv[2];
    float bc[2][8], kvv[2][8], sv[2];
#pragma unroll
    for (int u = 0; u < 2; ++u) { const int c = itv[u] & 31, bh = itv[u] >> 5; hv[u] = bh % 6; row0v[u] = (size_t)(bh / 6) * T_ + 64 * c;
        lbv[u] = 0.f; if (l == 1) lbv[u] = rcp_(1.0f + __expf(hl[64 * hv[u] + k] - hl[384 + 64 * hv[u] + k])); }
    unsigned short zr[2][8], vr[2][8];
#pragma unroll
    for (int u = 0; u < 2; ++u)
#pragma unroll
        for (int i = 0; i < 8; ++i) { zr[u][i] = P[(row0v[u] + 8 * pt + i) * PS_ + PBF + 64 * hv[u] + k]; vr[u][i] = P[(row0v[u] + 8 * pt + i) * PS_ + PBV + 64 * hv[u] + k]; }
#pragma unroll
    for (int u = 0; u < 2; ++u) { LAS unsigned char* L = lds + u * HG_STRIDE; LAS float* PART = (LAS float*)L; LAS bf16_t* VT = (LAS bf16_t*)(L + 48128);
        float s = 0.f;
#pragma unroll
        for (int i = 0; i < 8; ++i) { const float z = bf2f(zr[u][i]); const float sg = rcp_(1.0f + __expf(-z)); const float f = fmaxf(lbv[u] + (1.0f - lbv[u]) * sg, 1e-37f);
            s += __logf(f); bc[u][i] = s; kvv[u][i] = (1.0f - lbv[u]) * rcp_(1.0f + __expf(z)); }
        sv[u] = s; PART[pt * 64 + k] = s;
        u32x4 w; w.x = vr[u][0] | ((unsigned)vr[u][1] << 16); w.y = vr[u][2] | ((unsigned)vr[u][3] << 16); w.z = vr[u][4] | ((unsigned)vr[u][5] << 16); w.w = vr[u][6] | ((unsigned)vr[u][7] << 16);
        *(LAS u32x4*)(VT + k * LST + 8 * pt) = w; }
    __syncthreads();
    float tot[2], rho[2];
#pragma unroll
    for (int u = 0; u < 2; ++u) { LAS float* PART = (LAS float*)(lds + u * HG_STRIDE); float off = 0.f; tot[u] = 0.f; rho[u] = 0.f;
#pragma unroll
        for (int p = 0; p < 8; ++p) { const float v = PART[p * 64 + k]; if (p < pt) off += v; if (p < 4) rho[u] += v; tot[u] += v; }
#pragma unroll
        for (int i = 0; i < 8; ++i) bc[u][i] += off; }
    if (MODE == 0) {
#pragma unroll
        for (int u = 0; u < 2; ++u) { LAS bf16_t* L0 = (LAS bf16_t*)(lds + u * HG_STRIDE + 20480); float e[8];
#pragma unroll
            for (int i = 0; i < 8; ++i) e[i] = kvv[u][i] * __expf(tot[u] - bc[u][i]);
            *(LAS u32x4*)(L0 + k * LST + 8 * pt) = pack8(e);
            if (pt == 0) ((float*)(a.ws + WS_HDEC))[(size_t)itv[u] * 64 + k] = __expf(tot[u]); }
        __syncthreads();
        const int kt = wid >> 1;
#pragma unroll
        for (int u = 0; u < 2; ++u) { LAS bf16_t* L0 = (LAS bf16_t*)(lds + u * HG_STRIDE + 20480); LAS bf16_t* VT = (LAS bf16_t*)(lds + u * HG_STRIDE + 48128);
            bf16_t* KVT = (bf16_t*)(a.ws + WS_HKV) + (size_t)itv[u] * 4096;
#pragma unroll
            for (int q = 0; q < 2; ++q) { const int vt = 2 * (wid & 1) + q; f32x4 acc = {0.f, 0.f, 0.f, 0.f};
#pragma unroll
                for (int ks = 0; ks < 2; ++ks) { const bf16x8 x = *(const LAS bf16x8*)(L0 + (16 * kt + fr) * LST + 32 * ks + 8 * fq), y = *(const LAS bf16x8*)(VT + (16 * vt + fr) * LST + 32 * ks + 8 * fq); acc = mfma16(x, y, acc); }
                u32x2 w2; w2.x = pk2(acc[0], acc[1]); w2.y = pk2(acc[2], acc[3]);
                *(u32x2*)(KVT + (16 * vt + fr) * 64 + 16 * kt + 4 * fq) = w2; } }
        __syncthreads();
    } else {
#pragma unroll
        for (int u = 0; u < 2; ++u) { LAS float* RHO = (LAS float*)(lds + u * HG_STRIDE + 2048); LAS float* BC = (LAS float*)(lds + u * HG_STRIDE + 4096);
#pragma unroll
            for (int i = 0; i < 8; ++i) BC[(8 * pt + i) * 64 + k] = bc[u][i];
            if (pt == 0) RHO[k] = rho[u]; }
        const int tt = wid >> 1;
        bf16x8 sx[2][2][2]; u32x2 gw2[2][2];
#pragma unroll
        for (int u = 0; u < 2; ++u) { const bf16_t* KVT = (const bf16_t*)(a.ws + WS_HKV) + (size_t)itv[u] * 4096;
#pragma unroll
            for (int q = 0; q < 2; ++q) { const int vt = 2 * (wid & 1) + q;
#pragma unroll
                for (int ks = 0; ks < 2; ++ks) sx[u][q][ks] = *(const bf16x8*)(KVT + (16 * vt + fr) * 64 + 32 * ks + 8 * fq);
                gw2[u][q] = *(const u32x2*)(P + (row0v[u] + 16 * tt + fr) * PS_ + PBG + 64 * hv[u] + 16 * vt + 4 * fq); } }
        const int t2 = tid >> 3, kg = tid & 7;
        u32x4 qw[2], zw[2];
#pragma unroll
        for (int u = 0; u < 2; ++u) { qw[u] = *(const u32x4*)(P + (row0v[u] + t2) * PS_ + PBQ + 64 * hv[u] + 8 * kg); zw[u] = *(const u32x4*)(P + (row0v[u] + t2) * PS_ + PBF + 64 * hv[u] + 8 * kg); }
        __syncthreads();
#pragma unroll
        for (int u = 0; u < 2; ++u) { LAS unsigned char* L = lds + u * HG_STRIDE; LAS float* RHO = (LAS float*)(L + 2048); LAS float* BC = (LAS float*)(L + 4096);
            LAS bf16_t* L0 = (LAS bf16_t*)(L + 20480); LAS bf16_t* L1 = (LAS bf16_t*)(L + 29696); LAS bf16_t* L2 = (LAS bf16_t*)(L + 38912);
            float q[8], z[8], qp[8], qt[8], kt_[8]; unpack8(qw[u], q); unpack8(zw[u], z);
#pragma unroll
            for (int i = 0; i < 8; ++i) { const int kk = 8 * kg + i; float lb2 = 0.f; if (l == 1) lb2 = rcp_(1.0f + __expf(hl[64 * hv[u] + kk] - hl[384 + 64 * hv[u] + kk]));
                const float kvl = (1.0f - lb2) * rcp_(1.0f + __expf(z[i])); const float bcv = BC[t2 * 64 + kk], rh = RHO[kk]; const float qs = q[i] * 0.125f;
                qp[i] = qs * __expf(bcv); qt[i] = qs * __expf(fminf(bcv - rh, 87.0f)); kt_[i] = kvl * __expf(fminf(rh - bcv, 87.0f)); }
            *(LAS u32x4*)(L0 + t2 * LST + 8 * kg) = pack8(qp); *(LAS u32x4*)(L1 + t2 * LST + 8 * kg) = pack8(qt); *(LAS u32x4*)(L2 + t2 * LST + 8 * kg) = pack8(kt_); }
        __syncthreads();
#pragma unroll
        for (int u = 0; u < 2; ++u) { LAS unsigned char* L = lds + u * HG_STRIDE; LAS bf16_t* L1 = (LAS bf16_t*)(L + 29696); LAS bf16_t* L2 = (LAS bf16_t*)(L + 38912); LAS bf16_t* AM = (LAS bf16_t*)(L + 57344);
#pragma unroll
            for (int q = 0; q < 2; ++q) { const int st = 2 * (wid & 1) + q; f32x4 acc = {0.f, 0.f, 0.f, 0.f};
                if (st <= tt) {
#pragma unroll
                    for (int ks = 0; ks < 2; ++ks) { const bf16x8 x = *(const LAS bf16x8*)(L2 + (16 * st + fr) * LST + 32 * ks + 8 * fq), y = *(const LAS bf16x8*)(L1 + (16 * tt + fr) * LST + 32 * ks + 8 * fq); acc = mfma16(x, y, acc); }
                    const int t = 16 * tt + fr;
#pragma unroll
                    for (int j = 0; j < 4; ++j) { const int sidx = 16 * st + 4 * fq + j; if (sidx > t) acc[j] = 0.f; } }
                u32x2 w2; w2.x = pk2(acc[0], acc[1]); w2.y = pk2(acc[2], acc[3]);
                *(LAS u32x2*)(AM + (16 * tt + fr) * LST + 16 * st + 4 * fq) = w2; } }
        __syncthreads();
        f32x4 o[2][2];
#pragma unroll
        for (int u = 0; u < 2; ++u) { LAS unsigned char* L = lds + u * HG_STRIDE; LAS bf16_t* L0 = (LAS bf16_t*)(L + 20480); LAS bf16_t* VT = (LAS bf16_t*)(L + 48128); LAS bf16_t* AM = (LAS bf16_t*)(L + 57344); LAS float* SS = (LAS float*)(L + 66560);
            float ss = 0.f;
#pragma unroll
            for (int q = 0; q < 2; ++q) { const int vt = 2 * (wid & 1) + q; f32x4 acc = {0.f, 0.f, 0.f, 0.f};
#pragma unroll
                for (int ks = 0; ks < 2; ++ks) { const bf16x8 y = *(const LAS bf16x8*)(L0 + (16 * tt + fr) * LST + 32 * ks + 8 * fq); acc = mfma16(sx[u][q][ks], y, acc); }
#pragma unroll
                for (int ks = 0; ks < 2; ++ks) { const bf16x8 x = *(const LAS bf16x8*)(VT + (16 * vt + fr) * LST + 32 * ks + 8 * fq), y = *(const LAS bf16x8*)(AM + (16 * tt + fr) * LST + 32 * ks + 8 * fq); acc = mfma16(x, y, acc); }
                o[u][q] = acc; ss += (acc[0] * acc[0] + acc[1] * acc[1]) + (acc[2] * acc[2] + acc[3] * acc[3]); }
            ss += __shfl_xor(ss, 16); ss += __shfl_xor(ss, 32);
            if (fq == 0) SS[wid * 16 + fr] = ss; }
        __syncthreads();
        bf16_t* Y = (bf16_t*)(a.ws + WS_HY);
#pragma unroll
        for (int u = 0; u < 2; ++u) { LAS float* SS = (LAS float*)(lds + u * HG_STRIDE + 66560);
            const float tot2 = SS[wid * 16 + fr] + SS[(wid ^ 1) * 16 + fr]; const float rs = rsq_(tot2 * (1.0f / 64.0f) + 1e-6f);
#pragma unroll
            for (int q = 0; q < 2; ++q) { const int vt = 2 * (wid & 1) + q, t = 16 * tt + fr, cv = 64 * hv[u] + 16 * vt + 4 * fq;
                const f32x4 be = *(const f32x4*)(a.in[26] + l * 1024 + 256 + cv);
                float gg[4] = {bflo(gw2[u][q].x), bfhi(gw2[u][q].x), bflo(gw2[u][q].y), bfhi(gw2[u][q].y)}; float r[4];
#pragma unroll
                for (int j = 0; j < 4; ++j) r[j] = o[u][q][j] * rs * (gg[j] * sigmoidf_(gg[j])) * be[j];
                u32x2 w2; w2.x = pk2(r[0], r[1]); w2.y = pk2(r[2], r[3]);
                *(u32x2*)(Y + (row0v[u] + t) * D_ + 256 + cv) = w2; } }
        __syncthreads();
    }
}
__device__ __forceinline__ float shiftmix(const bf16_t* P, size_t row, int tglob, int col, float mu) {
    const float cur = bf2f(P[row * PS_ + PC + col]); const float prev = (tglob > 0) ? bf2f(P[(row - 1) * PS_ + PC + col]) : 0.f; return cur + (prev - cur) * mu; }
__device__ __forceinline__ void rwkv_seq(const Args& a, int l, int bh, LAS unsigned char* lds) {
    const int tid = otid(), wid = tid >> 6, lane = tid & 63, h = bh % 6, b = bh / 6;
    const bf16_t* P = (const bf16_t*)(a.ws + WS_P); bf16_t* Y = (bf16_t*)(a.ws + WS_HY);
    LAS float* LIN = (LAS float*)lds;
    LAS float* VEC = (LAS float*)(lds + 32768);
    LAS float* YL = (LAS float*)(lds + 90112);
    const float* mu = a.in[15] + l * 1408;
    float S[64];
#pragma unroll
    for (int k = 0; k < 64; ++k) S[k] = 0.f;
    const int t = tid >> 4, jg = tid & 15;
#pragma unroll 1
    for (int tb = 0; tb < T_; tb += 32) {
        const size_t row = (size_t)b * T_ + tb + t; const int tglob = tb + t;
#pragma unroll 4
        for (int i = 0; i < 16; ++i) { const int col = 16 * jg + i; const float ps = shiftmix(P, row, tglob, 1152 + col, mu[1152 + col]);
            float v; if (col < 64) { const float e = __expf(2.0f * ps); v = 1.0f - 2.0f / (e + 1.0f); } else if (col < 128) v = ps; else v = sigmoidf_(ps);
            LIN[t * 256 + col] = v; }
        __syncthreads();
        { const int cb = l * 384 + 64 * h + 4 * jg;
          f32x4 wacc = *(const f32x4*)(a.in[16] + cb), aacc = *(const f32x4*)(a.in[18] + cb), gacc = {0.f, 0.f, 0.f, 0.f};
          const float* wu = a.in[17] + (size_t)l * 64 * 384 + 64 * h + 4 * jg; const float* au = a.in[19] + (size_t)l * 64 * 384 + 64 * h + 4 * jg; const float* gu = a.in[20] + (size_t)l * 128 * 384 + 64 * h + 4 * jg;
#pragma unroll 4
          for (int i = 0; i < 64; ++i) { const float x = LIN[t * 256 + i]; wacc += x * *(const f32x4*)(wu + (size_t)i * 384); }
#pragma unroll 4
          for (int i = 0; i < 64; ++i) { const float x = LIN[t * 256 + 64 + i]; aacc += x * *(const f32x4*)(au + (size_t)i * 384); }
#pragma unroll 4
          for (int i = 0; i < 128; ++i) { const float x = LIN[t * 256 + 128 + i]; gacc += x * *(const f32x4*)(gu + (size_t)i * 384); }
          float kk[4], kp[4], aa[4], dec[4], rr[4], vv[4]; float ssq = 0.f;
#pragma unroll
          for (int j = 0; j < 4; ++j) { const int hc = 64 * h + 4 * jg + j;
              const float wp = wacc[j]; const float w = -log1pf(__expf(-wp)) - 0.5f; dec[j] = __expf(-__expf(w));
              aa[j] = sigmoidf_(aacc[j]);
              rr[j] = shiftmix(P, row, tglob, hc, mu[hc]); const float kx = shiftmix(P, row, tglob, 384 + hc, mu[384 + hc]); vv[j] = shiftmix(P, row, tglob, 768 + hc, mu[768 + hc]);
              kk[j] = kx * a.in[21][l * 384 + hc]; ssq += kk[j] * kk[j];
              kp[j] = kx * (1.0f + (aa[j] - 1.0f) * a.in[22][l * 384 + hc]); }
          ssq += __shfl_xor(ssq, 1); ssq += __shfl_xor(ssq, 2); ssq += __shfl_xor(ssq, 4); ssq += __shfl_xor(ssq, 8);
          const float rn = 1.0f / sqrtf(ssq + 1e-12f);
#pragma unroll
          for (int j = 0; j < 4; ++j) { const int jj = 4 * jg + j; const float kn = kk[j] * rn;
              VEC[(t * 7 + 0) * 64 + jj] = kn; VEC[(t * 7 + 1) * 64 + jj] = dec[j]; VEC[(t * 7 + 2) * 64 + jj] = kp[j]; VEC[(t * 7 + 3) * 64 + jj] = kn * aa[j];
              VEC[(t * 7 + 4) * 64 + jj] = rr[j]; VEC[(t * 7 + 5) * 64 + jj] = vv[j]; VEC[(t * 7 + 6) * 64 + jj] = gacc[j]; } }
        __syncthreads();
        if (wid == 0) {
#pragma unroll 1
            for (int ts = 0; ts < 32; ++ts) { const LAS f32x4* V4 = (const LAS f32x4*)(VEC + ts * 7 * 64);
                const float vv = VEC[(ts * 7 + 5) * 64 + lane]; float sa = 0.f;
#pragma unroll
                for (int k4 = 0; k4 < 16; ++k4) { const f32x4 q = V4[k4]; sa += S[4 * k4] * q.x; sa += S[4 * k4 + 1] * q.y; sa += S[4 * k4 + 2] * q.z; sa += S[4 * k4 + 3] * q.w; }
                sa = -sa; float y = 0.f;
#pragma unroll
                for (int k4 = 0; k4 < 16; ++k4) { const f32x4 w = V4[16 + k4], kp = V4[32 + k4], ka = V4[48 + k4], r = V4[64 + k4];
                    S[4 * k4] = S[4 * k4] * w.x + sa * ka.x + vv * kp.x; S[4 * k4 + 1] = S[4 * k4 + 1] * w.y + sa * ka.y + vv * kp.y;
                    S[4 * k4 + 2] = S[4 * k4 + 2] * w.z + sa * ka.z + vv * kp.z; S[4 * k4 + 3] = S[4 * k4 + 3] * w.w + sa * ka.w + vv * kp.w;
                    y += S[4 * k4] * r.x; y += S[4 * k4 + 1] * r.y; y += S[4 * k4 + 2] * r.z; y += S[4 * k4 + 3] * r.w; }
                YL[ts * 64 + lane] = y; }
        }
        __syncthreads();
        { const int cb = l * 384 + 64 * h + 4 * jg; const f32x4 y4 = *(const LAS f32x4*)(YL + t * 64 + 4 * jg);
          float sm = (y4.x + y4.y) + (y4.z + y4.w); sm += __shfl_xor(sm, 1); sm += __shfl_xor(sm, 2); sm += __shfl_xor(sm, 4); sm += __shfl_xor(sm, 8);
          const float mean = sm * (1.0f / 64.0f); const f32x4 d = y4 - mean;
          float vr = (d.x * d.x + d.y * d.y) + (d.z * d.z + d.w * d.w); vr += __shfl_xor(vr, 1); vr += __shfl_xor(vr, 2); vr += __shfl_xor(vr, 4); vr += __shfl_xor(vr, 8);
          const float rs = 1.0f / sqrtf(vr * (1.0f / 64.0f) + 64e-5f);
          const f32x4 rk = *(const f32x4*)(a.in[23] + cb), lw = *(const f32x4*)(a.in[24] + cb), lb = *(const f32x4*)(a.in[25] + cb), be = *(const f32x4*)(a.in[26] + l * 1024 + 640 + 64 * h + 4 * jg);
          float bs = 0.f; float r4[4], v4[4], g4[4];
#pragma unroll
          for (int j = 0; j < 4; ++j) { const int jj = 4 * jg + j; r4[j] = VEC[(t * 7 + 4) * 64 + jj]; v4[j] = VEC[(t * 7 + 5) * 64 + jj]; g4[j] = VEC[(t * 7 + 6) * 64 + jj]; bs += r4[j] * VEC[(t * 7 + 2) * 64 + jj] * rk[j]; }
          bs += __shfl_xor(bs, 1); bs += __shfl_xor(bs, 2); bs += __shfl_xor(bs, 4); bs += __shfl_xor(bs, 8);
          float o[4];
#pragma unroll
          for (int j = 0; j < 4; ++j) o[j] = ((d[j] * rs * lw[j] + lb[j]) + bs * v4[j]) * g4[j] * be[j];
          u32x2 w2; w2.x = pk2(o[0], o[1]); w2.y = pk2(o[2], o[3]);
          *(u32x2*)(Y + row * D_ + 640 + 64 * h + 4 * jg) = w2; }
        __syncthreads();
    }
}
__global__ void __launch_bounds__(512, 2) mk_fwd(Args a) {
    extern __shared__ __attribute__((aligned(16))) unsigned char shm[];
    LAS unsigned char* lds = (LAS unsigned char*)shm;
    cg::grid_group grid = cg::this_grid();
    if (a.ph_hi > 1000) grid.sync();
    { volatile LAS unsigned* stw = (volatile LAS unsigned*)(lds + LDS_BYTES - 16); if (threadIdx.x < 4) stw[threadIdx.x] = 0u; }
    __syncthreads();
    XcdBarrier xb = xcd_barrier_post((unsigned*)(a.ws + WS_BAR), (volatile LAS unsigned*)(lds + LDS_BYTES - 16));
    const int tid = otid(), wid = tid >> 6, lane = tid & 63, G = gridDim.x;
    unsigned char* ws = a.ws;
    bf16_t* Pb = (bf16_t*)(ws + WS_P); bf16_t* HY = (bf16_t*)(ws + WS_HY); float* MOD = (float*)(ws + WS_MOD);
#ifdef MK_PROBE
    unsigned long long t_prev = __builtin_amdgcn_s_memrealtime(), t_acc = 0;
#define PH_STAMP(n) { grid.sync(); const unsigned long long t_now = __builtin_amdgcn_s_memrealtime(); if ((MK_PROBE >> (n)) & 1) t_acc += t_now - t_prev; t_prev = t_now; }
#else
#define PH_STAMP(n)
#endif
#ifndef MK_SUB
#define MK_SUB 0
#endif
#ifndef MK_REP
#define MK_REP 0
#endif
#define PH_BEGIN(n) if (a.ph_lo <= (n) && (n) < a.ph_hi) { const int ph_cur = (n); (void)ph_cur; if ((n) > a.ph_lo) xcd_barrier(xb); for (int rep_ = 0; rep_ < (((MK_REP >> (n)) & 1) ? 2 : 1); ++rep_) {
#define PH_END } PH_STAMP(ph_cur) }
    PH_BEGIN(0) phase_pro(a, lds); PH_END
#pragma unroll
    for (int l = 0; l < 2; ++l) {
        const int p0 = 1 + 9 * l;
        const float* xin = (l == 0) ? a.in[0] : a.out;
        const float* modl = MOD + (size_t)l * 8 * 6144;
        PH_BEGIN(p0 + 0) phase_norm(xin, a.in[2] + l * D_, modl + 0, modl + 1024, HY); PH_END
        PH_BEGIN(p0 + 1) { pg8::Gemm g{HY, (const bf16_t*)(ws + WS_WIN + l * SZ_WIN), M_, PS_, D_}; pg8::StaticOrder S; S.init(M_, PS_, G, blockIdx.x); EpiP E{Pb, PS_};
                  pg8::gemm_phase<EpiP, pg8::StaticOrder>(lds, g, S, E, nullptr); } PH_END
        PH_BEGIN(p0 + 2) { for (int r_ = 0; r_ < ((MK_SUB & 1) ? 2 : 1); ++r_) for (int it = blockIdx.x; it < 1536; it += 2 * G) { if (it + G < 1536) hgrn_item2<0>(a, l, it, it + G, lds); else hgrn_item<0>(a, l, it, lds); }
                  for (int r_ = 0; r_ < ((MK_SUB & 2) ? 2 : 1); ++r_) for (int it = blockIdx.x; it < 256; it += G) rwkv_chunk<0>(a, l, it, lds);
                  for (int r_ = 0; r_ < ((MK_SUB & 4) ? 2 : 1); ++r_) for (int it = blockIdx.x; it < 256; it += G) rg2_mode0(a, l, it, lds); } PH_END
        PH_BEGIN(p0 + 3) { const int t3 = otid();
                  if (t3 < 64) { if ((int)blockIdx.x < 192) rwkv_scan(a, blockIdx.x >> 2, blockIdx.x & 3, t3); }
                  else { for (int e = blockIdx.x * 448 + (t3 - 64); e < 48 * 4096; e += G * 448) hgrn_scan(a, e);
                         for (int e = blockIdx.x * 448 + (t3 - 64); e < 2048; e += G * 448) rg_carry(a, e); } } PH_END
        PH_BEGIN(p0 + 4) { for (int r_ = 0; r_ < ((MK_SUB & 1) ? 2 : 1); ++r_) for (int it = blockIdx.x; it < 1536; it += 2 * G) { if (it + G < 1536) hgrn_item2<1>(a, l, it, it + G, lds); else hgrn_item<1>(a, l, it, lds); }
                  for (int r_ = 0; r_ < ((MK_SUB & 2) ? 2 : 1); ++r_) for (int it = blockIdx.x; it < 256; it += G) rwkv_chunk<1>(a, l, it, lds);
                  for (int r_ = 0; r_ < ((MK_SUB & 4) ? 2 : 1); ++r_) for (int it = blockIdx.x; it < 256; it += G) rg2_mode1(a, l, it, lds); } PH_END
        PH_BEGIN(p0 + 5) { pg8::Gemm g{HY, (const bf16_t*)(ws + WS_WOUT + l * SZ_WOUT), M_, D_, D_}; pg8::StaticOrder S; S.init(M_, D_, G, blockIdx.x); EpiRes E{xin, a.out, modl + 2048};
                  pg8::gemm_phase<EpiRes, pg8::StaticOrder>(lds, g, S, E, nullptr); } PH_END
        PH_BEGIN(p0 + 6) phase_norm(a.out, a.in[3] + l * D_, modl + 3072, modl + 4096, HY); PH_END
        PH_BEGIN(p0 + 7) { pg8::Gemm g{HY, (const bf16_t*)(ws + WS_WGU + l * SZ_WGU), M_, NGU_, D_}; pg8::StaticOrder S; S.init(M_, NGU_, G, blockIdx.x); EpiSwi E{Pb};
                  pg8::gemm_phase<EpiSwi, pg8::StaticOrder>(lds, g, S, E, nullptr); } PH_END
        PH_BEGIN(p0 + 8) { pg8::Gemm g{Pb, (const bf16_t*)(ws + WS_WD + l * SZ_WD), M_, D_, FF_}; pg8::StaticOrder S; S.init(M_, D_, G, blockIdx.x); EpiRes E{a.out, a.out, modl + 5120};
                  pg8::gemm_phase<EpiRes, pg8::StaticOrder>(lds, g, S, E, nullptr); } PH_END
    }
    PH_BEGIN(19) phase_final(a.out, a.in[31]); PH_END
#ifdef MK_PROBE
    if (blockIdx.x == 0 && threadIdx.x == 0) a.out[0] = (float)t_acc * 0.01f;
#endif
}
#ifndef MK_MULTI
#define MK_MULTI 0
#endif
extern "C" void kernel_launch(void* const* d_in, const int* in_sizes, int n_in, void* d_out, int out_size, void* d_ws, size_t ws_size, hipStream_t stream) {
    static int grid = 0;
    if (!grid) {
        if (n_in != 32 || ws_size < WS_END) { fprintf(stderr, "kernel_launch: bad args n_in %d ws %zu need %zu\n", n_in, ws_size, (size_t)WS_END); return; }
        hipFuncSetAttribute((const void*)mk_fwd, hipFuncAttributeMaxDynamicSharedMemorySize, LDS_BYTES);
        int dev = 0, cus = 0, per_cu = 0; hipGetDevice(&dev); hipDeviceGetAttribute(&cus, hipDeviceAttributeMultiprocessorCount, dev);
        hipOccupancyMaxActiveBlocksPerMultiprocessor(&per_cu, mk_fwd, 512, LDS_BYTES);
        if (per_cu < 1) { fprintf(stderr, "kernel_launch: occupancy 0\n"); per_cu = 1; }
        grid = cus;
    }
    Args a{}; for (int i = 0; i < 32; ++i) a.in[i] = (const float*)d_in[i];
    a.out = (float*)d_out; a.ws = (unsigned char*)d_ws;
#if MK_MULTI
    for (int ph = 0; ph < 20; ++ph) { a.ph_lo = ph; a.ph_hi = ph + 1; hipLaunchKernelGGL(mk_fwd, dim3(grid), dim3(512), LDS_BYTES, stream, a); }
#else
    a.ph_lo = 0; a.ph_hi = 20; void* args[] = {&a};
    if (hipMemsetAsync((char*)d_ws + WS_BAR, 0, XCD_BAR_WORDS * 4, stream) != hipSuccess) { fprintf(stderr, "memset failed\n"); return; }
    hipError_t e = hipLaunchCooperativeKernel((const void*)mk_fwd, dim3(grid), dim3(512), args, LDS_BYTES, stream);
    if (e != hipSuccess) fprintf(stderr, "cooperative launch failed: %s (grid %d)\n", hipGetErrorString(e), grid);
#endif
}
```
